# Optimizing an MI355X kernel written in HIP

```python
import jax, jax.numpy as jnp
from jax import lax
import numpy as np

D_MODEL = 4096
BATCH = 2
SEQ = 4096
DEPTH = 1
DEC_BATCH = 32
DEC_SEQ = 1
PAST_LEN = 8192
PAGE_SIZE = 128

MIX = D_MODEL
HEAD_DIM = 128
ATT_HEADS = MIX // 4 // HEAD_DIM
ATT_WIDTH = ATT_HEADS * HEAD_DIM
MLSTM_WIDTH = MIX - ATT_WIDTH
MLSTM_DV = 512
MLSTM_HEADS = MLSTM_WIDTH // MLSTM_DV
MLSTM_DQK = MLSTM_DV // 2
MLSTM_CHUNK = 64
GATE_CAP = 15.0
DILATED_CONFIGS = ((128, 1), (512, 4), (2048, 16))
WIN_MAX = 2048
ROPE_THETA = 10000.0
D_FF = 4 * D_MODEL
Q_BLOCK = 128
EPS = 1e-6
SPLIT_SIZES = (ATT_WIDTH, ATT_WIDTH, ATT_WIDTH,
               MLSTM_HEADS * MLSTM_DQK, MLSTM_HEADS * MLSTM_DQK,
               MLSTM_WIDTH, MLSTM_WIDTH, MLSTM_HEADS, MLSTM_HEADS)
N_IN = 3 * ATT_WIDTH + 2 * MLSTM_HEADS * MLSTM_DQK + 2 * MLSTM_WIDTH + 2 * MLSTM_HEADS

kernel_name = 'hymba_dilated_attn_mlstm_step'


def rmsnorm(x, g):
    x32 = x.astype(jnp.float32)
    y = x32 * lax.rsqrt(jnp.mean(x32 * x32, axis=-1, keepdims=True) + EPS)
    return (y * g.astype(jnp.float32)).astype(x.dtype)


def rope(x, pos):
    half = HEAD_DIM // 2
    inv = ROPE_THETA ** (-jnp.arange(half, dtype=jnp.float32) / half)
    ang = pos.astype(jnp.float32)[:, None] * inv[None, :]
    cos = jnp.cos(ang)[None, :, None, :]
    sin = jnp.sin(ang)[None, :, None, :]
    x32 = x.astype(jnp.float32)
    x1, x2 = x32[..., :half], x32[..., half:]
    return jnp.concatenate([x1 * cos - x2 * sin, x2 * cos + x1 * sin], axis=-1).astype(x.dtype)


def soft_cap(a):
    return GATE_CAP * jnp.tanh(a / GATE_CAP)


def in_proj(xn, w_in, b_if):
    B, T, _ = xn.shape
    z = jnp.einsum('btd,dn->btn', xn, w_in)
    offs = [0]
    for s in SPLIT_SIZES:
        offs.append(offs[-1] + s)
    qa, ka, va, qm, km, vm, om, ig, fg = [z[..., offs[i]:offs[i + 1]] for i in range(len(SPLIT_SIZES))]
    qa = qa.reshape(B, T, ATT_HEADS, HEAD_DIM)
    ka = ka.reshape(B, T, ATT_HEADS, HEAD_DIM)
    va = va.reshape(B, T, ATT_HEADS, HEAD_DIM)
    qm = qm.reshape(B, T, MLSTM_HEADS, MLSTM_DQK)
    km = km.reshape(B, T, MLSTM_HEADS, MLSTM_DQK)
    vm = vm.reshape(B, T, MLSTM_HEADS, MLSTM_DV)
    ig = soft_cap(ig.astype(jnp.float32) + b_if[:MLSTM_HEADS].astype(jnp.float32))
    fg = soft_cap(fg.astype(jnp.float32) + b_if[MLSTM_HEADS:].astype(jnp.float32))
    return qa, ka, va, qm, km, vm, om, ig, fg


def dilated_attention(q, k_src, v_src, q_pos, src_offset):
    S = k_src.shape[1]
    q = q * (HEAD_DIM ** -0.5)
    maxes, dens, nums = [], [], []
    for (w, r) in DILATED_CONFIGS:
        j = jnp.arange(w // r + 1, dtype=jnp.int32)
        pos = q_pos[:, None] - j[None, :] * r
        valid = pos >= 0
        row = jnp.clip(pos - src_offset, 0, S - 1)
        kg = jnp.take(k_src, row, axis=1)
        vg = jnp.take(v_src, row, axis=1)
        s = jnp.einsum('bqhd,bqjhd->bhqj', q, kg, preferred_element_type=jnp.float32)
        s = jnp.where(valid[None, None], s, -jnp.inf)
        m = jnp.max(s, axis=-1, keepdims=True)
        p = jnp.exp(s - m)
        maxes.append(m)
        dens.append(jnp.sum(p, axis=-1))
        nums.append(jnp.einsum('bhqj,bqjhd->bhqd', p, vg.astype(jnp.float32)))
    m_all = maxes[0]
    for m in maxes[1:]:
        m_all = jnp.maximum(m_all, m)
    num = 0.0
    den = 0.0
    for m, d, n in zip(maxes, dens, nums):
        wgt = jnp.exp(m - m_all)
        num = num + wgt * n
        den = den + wgt[..., 0] * d
    out = num / den[..., None]
    return out.transpose(0, 2, 1, 3)


def mlstm_chunkwise(q, k, v, ig, fg, C0, n0, m0):
    f32 = jnp.float32
    B, T, H, DK = q.shape
    DV = v.shape[-1]
    L = MLSTM_CHUNK if T % MLSTM_CHUNK == 0 else T
    NC = T // L

    def chunks(a):
        return a.astype(f32).reshape(B, NC, L, H, -1).transpose(1, 0, 3, 2, 4)

    qc = chunks(q) * (DK ** -0.5)
    kc = chunks(k)
    vc = chunks(v)
    li = ig.astype(f32).reshape(B, NC, L, H).transpose(1, 0, 3, 2)
    lf = jax.nn.log_sigmoid(fg.astype(f32)).reshape(B, NC, L, H).transpose(1, 0, 3, 2)
    causal = jnp.tril(jnp.ones((L, L), dtype=bool))

    def step(carry, xs):
        C, n, m = carry
        q_, k_, v_, li_, lf_ = xs
        b = jnp.cumsum(lf_, axis=-1)
        dlog = jnp.where(causal, b[..., :, None] - b[..., None, :] + li_[..., None, :], -jnp.inf)
        inter = b + m[..., None]
        m_t = jnp.maximum(inter, jnp.max(dlog, axis=-1))
        sw = jnp.einsum('bhtd,bhsd->bhts', q_, k_) * jnp.exp(dlog - m_t[..., None])
        a = jnp.exp(inter - m_t)
        num = jnp.einsum('bhts,bhsv->bhtv', sw, v_) + a[..., None] * jnp.einsum('bhtd,bhdv->bhtv', q_, C)
        den = jnp.sum(sw, axis=-1) + a * jnp.einsum('bhtd,bhd->bht', q_, n)
        h = num / jnp.maximum(jnp.abs(den), jnp.exp(-m_t))[..., None]
        m_new = m_t[..., -1]
        ws = jnp.exp(b[..., -1:] - b + li_ - m_new[..., None])
        decay = jnp.exp(b[..., -1] + m - m_new)
        C_new = decay[..., None, None] * C + jnp.einsum('bhs,bhsd,bhsv->bhdv', ws, k_, v_)
        n_new = decay[..., None] * n + jnp.einsum('bhs,bhsd->bhd', ws, k_)
        return (C_new, n_new, m_new), h

    (C, n, m), h = lax.scan(step, (C0.astype(f32), n0.astype(f32), m0.astype(f32)), (qc, kc, vc, li, lf))
    h = h.transpose(1, 0, 3, 2, 4).reshape(B, T, H, DV)
    return h, C, n, m


def merge_and_ffn(x, att, hm, om, mh_g, w_out, n2_g, w_up, w_down):
    B, T, _ = x.shape
    f32 = jnp.float32
    hn = hm * lax.rsqrt(jnp.mean(hm * hm, axis=-1, keepdims=True) + EPS)
    hn = hn.reshape(B, T, MLSTM_WIDTH) * mh_g.astype(f32) * jax.nn.sigmoid(om.astype(f32))
    mix = jnp.concatenate([att.reshape(B, T, ATT_WIDTH).astype(x.dtype), hn.astype(x.dtype)], axis=-1)
    h = x + jnp.einsum('btm,md->btd', mix, w_out)
    u = jnp.square(jax.nn.relu(jnp.einsum('btd,df->btf', rmsnorm(h, n2_g), w_up)))
    return h + jnp.einsum('btf,fd->btd', u, w_down)


def setup_inputs(seed: int = 0) -> dict:
    key = jax.random.key(seed)
    ks = jax.random.split(key, 18)
    f32 = jnp.float32
    wbuf = min(WIN_MAX, PAST_LEN)
    nrm = jax.random.normal
    x_prompt = nrm(ks[0], (BATCH, SEQ, D_MODEL), f32)
    x_sample = nrm(ks[1], (DEC_BATCH, DEC_SEQ, D_MODEL), f32)
    cache_k = nrm(ks[2], (DEPTH, DEC_BATCH, wbuf, ATT_HEADS, HEAD_DIM), f32)
    cache_v = nrm(ks[3], (DEPTH, DEC_BATCH, wbuf, ATT_HEADS, HEAD_DIM), f32)
    state_C = 0.1 * nrm(ks[4], (DEPTH, DEC_BATCH, MLSTM_HEADS, MLSTM_DQK, MLSTM_DV), f32)
    state_n = 0.5 * nrm(ks[5], (DEPTH, DEC_BATCH, MLSTM_HEADS, MLSTM_DQK), f32)
    state_m = nrm(ks[6], (DEPTH, DEC_BATCH, MLSTM_HEADS), f32)
    norm1_g = 1.0 + 0.02 * nrm(ks[7], (DEPTH, D_MODEL), f32)
    w_in = nrm(ks[8], (DEPTH, D_MODEL, N_IN), f32) * (D_MODEL ** -0.5)
    b_i = 0.1 * nrm(ks[9], (DEPTH, MLSTM_HEADS), f32)
    b_f = 3.0 + 0.1 * nrm(ks[10], (DEPTH, MLSTM_HEADS), f32)
    b_if = jnp.concatenate([b_i, b_f], axis=-1)
    mh_norm_g = 1.0 + 0.02 * nrm(ks[11], (DEPTH, MLSTM_WIDTH), f32)
    w_out = nrm(ks[12], (DEPTH, MIX, D_MODEL), f32) * (MIX ** -0.5)
    norm2_g = 1.0 + 0.02 * nrm(ks[13], (DEPTH, D_MODEL), f32)
    w_up = nrm(ks[14], (DEPTH, D_MODEL, D_FF), f32) * (D_MODEL ** -0.5)
    w_down = nrm(ks[15], (DEPTH, D_FF, D_MODEL), f32) * (D_FF ** -0.5)
    final_g = 1.0 + 0.02 * nrm(ks[16], (D_MODEL,), f32)
    return {'x_prompt': x_prompt, 'x_sample': x_sample, 'cache_k': cache_k, 'cache_v': cache_v,
            'state_C': state_C, 'state_n': state_n, 'state_m': state_m,
            'norm1_g': norm1_g, 'w_in': w_in, 'b_if': b_if, 'mh_norm_g': mh_norm_g,
            'w_out': w_out, 'norm2_g': norm2_g, 'w_up': w_up, 'w_down': w_down, 'final_g': final_g}


def reference(x_prompt, x_sample, cache_k, cache_v, state_C, state_n, state_m,
              norm1_g, w_in, b_if, mh_norm_g, w_out, norm2_g, w_up, w_down, final_g):
    wbuf = cache_k.shape[2]
    src_off = PAST_LEN - wbuf
    keep_p = min(WIN_MAX, SEQ)
    n_blocks = SEQ // Q_BLOCK
    pos_p = jnp.arange(SEQ, dtype=jnp.int32)
    pos_s = PAST_LEN + jnp.arange(DEC_SEQ, dtype=jnp.int32)
    xp, xs = x_prompt, x_sample
    kp_l, vp_l, Cp_l, np_l, mp_l = [], [], [], [], []
    ks_l, vs_l, Cs_l, ns_l, ms_l = [], [], [], [], []
    for l in range(DEPTH):
        qa, ka, va, qm, km, vm, om, ig, fg = in_proj(rmsnorm(xp, norm1_g[l]), w_in[l], b_if[l])
        qa = rope(qa, pos_p)
        ka = rope(ka, pos_p)
        qb = qa.reshape(BATCH, n_blocks, Q_BLOCK, ATT_HEADS, HEAD_DIM).swapaxes(0, 1)
        pb = pos_p.reshape(n_blocks, Q_BLOCK)
        att = lax.map(lambda a: dilated_attention(a[0], ka, va, a[1], 0), (qb, pb))
        att = att.swapaxes(0, 1).reshape(BATCH, SEQ, ATT_HEADS, HEAD_DIM)
        C0 = jnp.zeros((BATCH, MLSTM_HEADS, MLSTM_DQK, MLSTM_DV), jnp.float32)
        n0 = jnp.zeros((BATCH, MLSTM_HEADS, MLSTM_DQK), jnp.float32)
        m0 = jnp.zeros((BATCH, MLSTM_HEADS), jnp.float32)
        hm, Cp, n_p, mp = mlstm_chunkwise(qm, km, vm, ig, fg, C0, n0, m0)
        xp = merge_and_ffn(xp, att, hm, om, mh_norm_g[l], w_out[l], norm2_g[l], w_up[l], w_down[l])
        kp_l.append(ka[:, SEQ - keep_p:])
        vp_l.append(va[:, SEQ - keep_p:])
        Cp_l.append(Cp)
        np_l.append(n_p)
        mp_l.append(mp)
        qa, ka, va, qm, km, vm, om, ig, fg = in_proj(rmsnorm(xs, norm1_g[l]), w_in[l], b_if[l])
        qa = rope(qa, pos_s)
        ka = rope(ka, pos_s)
        k_src = jnp.concatenate([cache_k[l].astype(ka.dtype), ka], axis=1)
        v_src = jnp.concatenate([cache_v[l].astype(va.dtype), va], axis=1)
        att = dilated_attention(qa, k_src, v_src, pos_s, src_off)
        hm, Cs, n_s, ms = mlstm_chunkwise(qm, km, vm, ig, fg, state_C[l], state_n[l], state_m[l])
        xs = merge_and_ffn(xs, att, hm, om, mh_norm_g[l], w_out[l], norm2_g[l], w_up[l], w_down[l])
        ks_l.append(ka)
        vs_l.append(va)
        Cs_l.append(Cs)
        ns_l.append(n_s)
        ms_l.append(ms)
    y_prompt = rmsnorm(xp, final_g)
    y_sample = rmsnorm(xs, final_g)
    k_prompt = jnp.stack(kp_l, axis=0)
    v_prompt = jnp.stack(vp_l, axis=0)
    C_prompt = jnp.stack(Cp_l, axis=0)
    n_prompt = jnp.stack(np_l, axis=0)
    m_prompt = jnp.stack(mp_l, axis=0)
    k_sample = jnp.stack(ks_l, axis=0)
    v_sample = jnp.stack(vs_l, axis=0)
    C_sample = jnp.stack(Cs_l, axis=0)
    n_sample = jnp.stack(ns_l, axis=0)
    m_sample = jnp.stack(ms_l, axis=0)
    return (y_prompt, y_sample, k_prompt, v_prompt, C_prompt, n_prompt, m_prompt,
            k_sample, v_sample, C_sample, n_sample, m_sample)
```

```cpp
#include <hip/hip_runtime.h>
#include <cstdio>
#include <cstdint>

#define LAS __attribute__((address_space(3)))
typedef unsigned short bf16_t;
typedef short bf16x8 __attribute__((ext_vector_type(8)));
typedef short s16x4 __attribute__((ext_vector_type(4)));
typedef float f32x4 __attribute__((ext_vector_type(4)));
typedef float f32x2 __attribute__((ext_vector_type(2)));
typedef unsigned u32x4 __attribute__((ext_vector_type(4)));
typedef unsigned u32x2 __attribute__((ext_vector_type(2)));

constexpr int DM = 4096, SEQ = 4096, NB = 2, MP = NB * SEQ  , MS = 32, MT = MP + MS  , MPAD = 8448;
constexpr int NZ = 12288, NINF = 12300, DFF = 16384;
constexpr int ZQA = 0, ZKA = 1024, ZVA = 2048, ZQM = 3072, ZKM = 4608, ZVM = 6144, ZOM = 9216;
constexpr int NH = 6, DK = 256, DV = 512, LCH = 64, NCH = 64;
constexpr float EPS = 1e-6f;
constexpr size_t O_Y = 0, O_KP = 33685504, O_VP = 37879808, O_CP = 42074112, O_NP = 43646976, O_MP = 43650048, O_KS = 43650060, O_VS = 43682828,
                 O_CS = 43715596, O_NS = 68881420, O_MS = 68930572, O_END = 68930764;

constexpr size_t MiB = 1u << 20;
constexpr size_t WS_CTL = 0, CTL_ZERO_BYTES = 1 * MiB;
constexpr int CW_BAR = 0;
constexpr int CW_Q2 = 4096;
constexpr size_t CTL_RSS2 = 64 * 1024, CTL_RSS3 = 128 * 1024, CTL_ACC = 512 * 1024;
constexpr size_t WS_ROPE = 2 * MiB;
constexpr size_t WS_WG = 5 * MiB;
constexpr size_t WS_G = 6 * MiB;
constexpr size_t WS_TB = 7 * MiB, WS_TWV = 7 * MiB + 256 * 1024, WS_TMT = 7 * MiB + 512 * 1024, WS_CM = 7 * MiB + 768 * 1024;
constexpr size_t WS_NC = 8 * MiB;
constexpr size_t WS_WIN = 16 * MiB, WS_WOUT = 112 * MiB, WS_WUP = 144 * MiB, WS_WDN = 272 * MiB;
constexpr size_t WS_XN = 400 * MiB, WS_Z = 466 * MiB, WS_MIX = 660 * MiB, WS_H = 726 * MiB, WS_HB = 855 * MiB, WS_CT = 921 * MiB, WS_END = 1114 * MiB;
#ifndef CHECKS
#define CHECKS 0
#endif
constexpr size_t WS_U = CHECKS ? 1114 * MiB : 400 * MiB;
constexpr size_t WS_HRAW = 1380 * MiB;
constexpr size_t WS_NEED = CHECKS ? 1480 * MiB : WS_END;
constexpr int CW_ERR = 8192;
constexpr size_t WS_DBG = 1477 * MiB;

constexpr int LDS_BYTES = 153600, MISC_OFF = 153088;

__device__ __forceinline__ unsigned cvt_pk_bf16(float lo, float hi) { unsigned r; asm volatile("v_cvt_pk_bf16_f32 %0, %1, %2" : "=v"(r) : "v"(lo), "v"(hi)); return r; }
__device__ __forceinline__ float bf_lo(unsigned w) { return __uint_as_float(w << 16); }
__device__ __forceinline__ float bf_hi(unsigned w) { return __uint_as_float(w & 0xffff0000u); }
__device__ __forceinline__ float bf1(bf16_t b) { return __uint_as_float(((unsigned)b) << 16); }
__device__ __forceinline__ float wave_sum(float v) {
#pragma unroll
    for (int o = 1; o < 64; o <<= 1) v += __shfl_xor(v, o);
    return v;
}
__device__ __forceinline__ float wave_max(float v) {
#pragma unroll
    for (int o = 1; o < 64; o <<= 1) v = fmaxf(v, __shfl_xor(v, o));
    return v;
}
__device__ __forceinline__ void lds_addf(LAS float* p, float v) { (void)__hip_atomic_fetch_add(p, v, __ATOMIC_RELAXED, __HIP_MEMORY_SCOPE_WORKGROUP); }
typedef short v4i16_t __attribute__((ext_vector_type(4)));
__device__ __forceinline__ s16x4 vtr(const LAS unsigned char* p) { return __builtin_bit_cast(s16x4, __builtin_amdgcn_ds_read_tr16_b64_v4i16((LAS v4i16_t*)p)); }
__device__ __forceinline__ bf16x8 cat8(s16x4 a, s16x4 b) { bf16x8 r; r[0] = a[0]; r[1] = a[1]; r[2] = a[2]; r[3] = a[3]; r[4] = b[0]; r[5] = b[1]; r[6] = b[2]; r[7] = b[3]; return r; }

#define XB_TMO      128
#define XB_XCNT(j)  (256  + 64 * (j))
#define XB_XSUB(j)  (1280 + 64 * (j))
#define XB_XGEN(j)  (2304 + 64 * (j))
#define XB_TOP      3328
#define XB_TOPGEN   3392
#define XCD_BAR_WORDS 3456
#define XB_SPIN_CAP (1u << 18)
__device__ __forceinline__ unsigned xb_ld(unsigned* p)              { return __hip_atomic_load(p, __ATOMIC_RELAXED, __HIP_MEMORY_SCOPE_AGENT); }
__device__ __forceinline__ unsigned xb_add(unsigned* p, unsigned v) { return __hip_atomic_fetch_add(p, v, __ATOMIC_RELAXED, __HIP_MEMORY_SCOPE_AGENT); }
__device__ __forceinline__ unsigned xb_xcc_id() { return (unsigned)__builtin_amdgcn_s_getreg((3 << 11) | 20) & 0xFu; }
#define XB_SPIN(cond, bar) do { unsigned _sp = 0; while (cond) { __builtin_amdgcn_s_sleep(1); \
    if ((++_sp & 255u) == 0u) { if (xb_ld(&(bar)[XB_TMO])) break; if (_sp > XB_SPIN_CAP) { atomicAdd(&(bar)[XB_TMO], 1u); break; } } } } while (0)
struct XcdBarrier { unsigned* bar; unsigned x; volatile LAS unsigned* st; };
__device__ __forceinline__ XcdBarrier xcd_barrier_post(unsigned* bar, volatile LAS unsigned* st) {
    XcdBarrier b; b.bar = bar; b.x = xb_xcc_id(); b.st = st;
    if (threadIdx.x == 0) (void)xb_add(&bar[XB_XCNT(b.x)], 1u);
    return b;
}
__device__ __forceinline__ void xcd_barrier_complete(unsigned* bar, unsigned x, unsigned& nloc, unsigned& nx) {
    const unsigned G = gridDim.x * gridDim.y * gridDim.z;
    unsigned sum, cnt, mine, sp = 0u;
    for (;;) {
        sum = 0u; cnt = 0u; mine = 0u;
#pragma unroll
        for (unsigned j = 0; j < 16; ++j) { const unsigned c = xb_ld(&bar[XB_XCNT(j)]); sum += c; cnt += (c > 0u) ? 1u : 0u; mine = (j == x) ? c : mine; }
        if (sum == G) break;
        __builtin_amdgcn_s_sleep(1);
        if ((++sp & 255u) == 0u) { if (xb_ld(&bar[XB_TMO])) break; if (sp > XB_SPIN_CAP) { atomicAdd(&bar[XB_TMO], 1u); break; } }
    }
    nloc = mine > 0u ? mine : 1u; nx = cnt > 0u ? cnt : 1u;
}
__device__ __forceinline__ void xcd_barrier(const XcdBarrier& b) {
    asm volatile("s_waitcnt vmcnt(0)" ::: "memory");
    __syncthreads();
    if (threadIdx.x == 0) {
        unsigned* bar = b.bar;
        __builtin_amdgcn_s_waitcnt(0);
        unsigned nloc = b.st[0], nx = b.st[1];
        if (nloc == 0u) { xcd_barrier_complete(bar, b.x, nloc, nx); b.st[0] = nloc; b.st[1] = nx; }
        const unsigned old = xb_add(&bar[XB_XSUB(b.x)], 1u);
        const unsigned gen = old / nloc;
        if (old + 1u == (gen + 1u) * nloc) {
            __builtin_amdgcn_fence(__ATOMIC_RELEASE, "agent");
            asm volatile("s_waitcnt vmcnt(0)" ::: "memory");
            const unsigned og = xb_add(&bar[XB_TOP], 1u);
            const unsigned tg = og / nx;
            if (og + 1u == (tg + 1u) * nx) xb_add(&bar[XB_TOPGEN], 1u);
            else XB_SPIN(xb_ld(&bar[XB_TOPGEN]) == tg, bar);
            __builtin_amdgcn_fence(__ATOMIC_ACQUIRE, "agent");
            xb_add(&bar[XB_XGEN(b.x)], 1u);
            asm volatile("s_waitcnt vmcnt(0)" ::: "memory");
        } else {
            XB_SPIN(xb_ld(&bar[XB_XGEN(b.x)]) == gen, bar);
            __builtin_amdgcn_fence(__ATOMIC_ACQUIRE, "agent");
            asm volatile("s_waitcnt vmcnt(0)" ::: "memory");
        }
    }
    __syncthreads();
}

namespace pg8 {
constexpr int BM = 256, BK = 64, HALF = 128, HTB = HALF * BK * 2, STAGE_BYTES = 8 * HTB, NXCD = 8, WGM = 8;
__host__ __device__ __forceinline__ int lds_byte(int r, int c) { const int st = (r >> 4) * 2 + (c >> 5), rr = r & 15, cc = c & 31, ob = rr * 64 + cc * 2; return st * 1024 + (ob ^ (((ob >> 9) & 1) << 5)); }
__host__ __device__ __forceinline__ void stage_rc(int b, int& R, int& C) { const int st = b / 1024, sb = b % 1024, swz = sb ^ (((sb >> 9) & 1) << 5); R = (st >> 1) * 16 + swz / 64; C = (st & 1) * 32 + (swz % 64) / 2; }
__host__ __device__ __forceinline__ int perm32(int rho) { const int n = rho >> 4, i = rho & 15; return 8 * (i >> 2) + 4 * n + (i & 3); }
struct Unit { int pm, pn; };
struct Gemm { const bf16_t* A; const bf16_t* Bt; int M, N, K; };
struct StaticOrder {
    int nM, nN, nwg, G, c;
    __host__ __device__ void init(int M, int N, int G_, int c_) { nM = M / BM; nN = N / BM; nwg = nM * nN; G = G_; c = c_; }
    __host__ __device__ bool next(int i, Unit& u) const {
        const long L = (long)i * G + c; if (L >= nwg) return false;
        int wgid = (int)L; { const int q = nwg / NXCD, r = nwg % NXCD, xcd = wgid % NXCD, off = wgid / NXCD; wgid = (xcd < r ? xcd * (q + 1) : r * (q + 1) + (xcd - r) * q) + off; }
        const int nig = WGM * nN, gid = wgid / nig, fm = gid * WGM, gsz = (nM - fm) < WGM ? (nM - fm) : WGM;
        u.pm = fm + ((wgid % nig) % gsz); u.pn = (wgid % nig) / gsz; return true;
    }
};
template <int BMODE> __host__ __device__ __forceinline__ int bmap_row(int R) {
    if (BMODE == 0) return R;
    const int p = (R & ~31) + perm32(R & 31);
    if (BMODE == 1) return p;
    return (p >> 6) * 128 + (p & 63);
}
template <class Epi, bool ALIGN_EPI = true, bool SP2 = true>
__device__ __forceinline__ void gemm_phase(LAS unsigned char* lds, const Gemm g, const StaticOrder& S, const Epi& E) {
    int tid = threadIdx.x; asm volatile("" : "+v"(tid)); const int wid = __builtin_amdgcn_readfirstlane(tid >> 6), lane = tid & 63, wr = wid >> 2, wc = wid & 3, fr = lane & 15, fq = lane >> 4;
    const int K = g.K, nt = K / BK;
    unsigned voffA[2], voffB[2];
#pragma unroll
    for (int i = 0; i < 2; ++i) { int R, C; stage_rc(tid * 16 + i * 8192, R, C); const int Rb = bmap_row<Epi::BMODE>(R);
        voffA[i] = (unsigned)(R * K + C) * 2u; voffB[i] = (unsigned)(Rb * K + C) * 2u; }
    const size_t kstep = (size_t)(BK * 2);
    const size_t hstep = (size_t)HALF * K * 2;
    const size_t hstepB = (size_t)(Epi::BMODE == 2 ? 64 : 128) * K * 2;
    const size_t tstep = 2 * hstep;
    const unsigned ldsw = (unsigned)wid * 1024u;
    const int aoff = lds_byte(wr * 64 + fr, fq * 8), boff = lds_byte(wc * 32 + fr, fq * 8);
#define PG8_SA(b, h) (((b) * 2 + (h)) * HTB)
#define PG8_SB(b, h) ((4 + (b) * 2 + (h)) * HTB)
#define PG8_STAGE(bufoff, gbase, voff) do { _Pragma("unroll") for (int _i = 0; _i < 2; ++_i) \
        __builtin_amdgcn_global_load_lds((const unsigned*)((const char*)(gbase) + (voff)[_i]), (LAS unsigned*)(lds + (bufoff) + ldsw + _i * 8192), 16, 0, 0); } while (0)
#define PG8_LDA(dst, b, h) do { _Pragma("unroll") for (int m = 0; m < 4; ++m) _Pragma("unroll") for (int k = 0; k < 2; ++k) dst[m][k] = *(const LAS bf16x8*)(lds + PG8_SA(b, h) + aoff + m * 2048 + k * 1024); } while (0)
#define PG8_LDB(dst, b, h) do { _Pragma("unroll") for (int n = 0; n < 2; ++n) _Pragma("unroll") for (int k = 0; k < 2; ++k) dst[n][k] = *(const LAS bf16x8*)(lds + PG8_SB(b, h) + boff + n * 2048 + k * 1024); } while (0)
#define PG8_MMA(ai, bj, At, Bt) do { __builtin_amdgcn_s_setprio(1); _Pragma("unroll") for (int m = 0; m < 4; ++m) _Pragma("unroll") for (int n = 0; n < 2; ++n) _Pragma("unroll") for (int k = 0; k < 2; ++k) \
        acc[ai][bj][m][n] = __builtin_amdgcn_mfma_f32_16x16x32_bf16(Bt[n][k], At[m][k], acc[ai][bj][m][n], 0, 0, 0); __builtin_amdgcn_s_setprio(0); } while (0)
#define PG8_WAIT_V(n) asm volatile("s_waitcnt vmcnt(" #n ")" ::: "memory")
#define PG8_WAIT_L(n) asm volatile("s_waitcnt lgkmcnt(" #n ")" ::: "memory")
#define PG8_BAR __builtin_amdgcn_s_barrier()
#define PG8_SCHED __builtin_amdgcn_sched_barrier(0)
    Unit cur, nxt; int ui = 0;
    if (!S.next(0, cur)) return;
    f32x4 acc[2][2][4][2];
#pragma unroll
    for (int a = 0; a < 2; ++a)
#pragma unroll
        for (int b = 0; b < 2; ++b)
#pragma unroll
            for (int m = 0; m < 4; ++m)
#pragma unroll
                for (int n = 0; n < 2; ++n) acc[a][b][m][n] = (f32x4){0.f, 0.f, 0.f, 0.f};
    bf16x8 At[4][2], B0[2][2], B1[2][2];
    const char* cA = (const char*)g.A + (size_t)cur.pm * tstep; const char* cB = (const char*)g.Bt + (size_t)cur.pn * tstep;
    if constexpr (SP2) {
        PG8_STAGE(PG8_SB(0, 0), cB, voffB); PG8_STAGE(PG8_SB(0, 1), cB + hstepB, voffB); PG8_STAGE(PG8_SA(0, 0), cA, voffA); PG8_STAGE(PG8_SA(0, 1), cA + hstep, voffA);
        if (wr == 1) PG8_BAR;
        PG8_WAIT_V(2); PG8_BAR;
        PG8_STAGE(PG8_SB(1, 0), cB + kstep, voffB); PG8_STAGE(PG8_SA(1, 0), cA + kstep, voffA); PG8_STAGE(PG8_SB(1, 1), cB + hstepB + kstep, voffB);
        PG8_WAIT_V(6); PG8_BAR;
    } else {
        PG8_STAGE(PG8_SB(0, 0), cB, voffB); PG8_STAGE(PG8_SA(0, 0), cA, voffA); PG8_STAGE(PG8_SB(0, 1), cB + hstepB, voffB); PG8_STAGE(PG8_SA(0, 1), cA + hstep, voffA);
        if (wr == 1) PG8_BAR;
        PG8_WAIT_V(4); PG8_BAR;
        PG8_STAGE(PG8_SB(1, 0), cB + kstep, voffB); PG8_STAGE(PG8_SA(1, 0), cA + kstep, voffA); PG8_STAGE(PG8_SB(1, 1), cB + hstepB + kstep, voffB);
        PG8_WAIT_V(6); PG8_BAR;
    }
    for (;;) {
        const bool has_next = S.next(ui + 1, nxt);
        const char* nA = has_next ? (const char*)g.A + (size_t)nxt.pm * tstep : cA; const char* nB = has_next ? (const char*)g.Bt + (size_t)nxt.pn * tstep : cB;
        for (int t = 0; t < nt; t += 2) {
            const bool last = (t == nt - 2);
            const char* a1 = cA + (size_t)(t + 1) * kstep;
            const char* a2 = last ? nA : cA + (size_t)(t + 2) * kstep; const char* b2 = last ? nB : cB + (size_t)(t + 2) * kstep;
            const char* a3 = a2 + kstep; const char* b3 = b2 + kstep;
            if constexpr (SP2) {
            PG8_LDB(B0, 0, 0); PG8_LDB(B1, 0, 1); PG8_SCHED; PG8_LDA(At, 0, 0); PG8_STAGE(PG8_SA(1, 1), a1 + hstep, voffA);
            PG8_WAIT_V(8); PG8_WAIT_L(0); PG8_BAR; PG8_MMA(0, 0, At, B0); PG8_MMA(0, 1, At, B1); PG8_BAR; PG8_SCHED;
            PG8_LDA(At, 0, 1); PG8_STAGE(PG8_SB(0, 0), b2, voffB); PG8_STAGE(PG8_SB(0, 1), b2 + hstepB, voffB); PG8_STAGE(PG8_SA(0, 0), a2, voffA);
            PG8_WAIT_V(8); PG8_WAIT_L(0); PG8_BAR; PG8_MMA(1, 0, At, B0); PG8_MMA(1, 1, At, B1); PG8_BAR; PG8_SCHED;
            PG8_LDB(B0, 1, 0); PG8_LDB(B1, 1, 1); PG8_SCHED; PG8_LDA(At, 1, 0); PG8_STAGE(PG8_SA(0, 1), a2 + hstep, voffA);
            PG8_WAIT_V(8); PG8_WAIT_L(0); PG8_BAR; PG8_MMA(0, 0, At, B0); PG8_MMA(0, 1, At, B1); PG8_BAR; PG8_SCHED;
            PG8_LDA(At, 1, 1); PG8_STAGE(PG8_SB(1, 0), b3, voffB); PG8_STAGE(PG8_SB(1, 1), b3 + hstepB, voffB); PG8_STAGE(PG8_SA(1, 0), a3, voffA);
            PG8_WAIT_V(8); PG8_WAIT_L(0); PG8_BAR; PG8_MMA(1, 0, At, B0); PG8_MMA(1, 1, At, B1); PG8_BAR; PG8_SCHED;
            } else {
            PG8_LDB(B0, 0, 0); PG8_SCHED; PG8_LDA(At, 0, 0); PG8_STAGE(PG8_SA(1, 1), a1 + hstep, voffA);
            PG8_WAIT_L(8); PG8_BAR; PG8_WAIT_L(0); PG8_MMA(0, 0, At, B0); PG8_BAR; PG8_SCHED;
            PG8_LDB(B1, 0, 1); PG8_STAGE(PG8_SB(0, 0), b2, voffB);
            PG8_BAR; PG8_WAIT_L(0); PG8_MMA(0, 1, At, B1); PG8_BAR;
            PG8_LDA(At, 0, 1); PG8_STAGE(PG8_SA(0, 0), a2, voffA);
            PG8_BAR; PG8_WAIT_L(0); PG8_MMA(1, 0, At, B0); PG8_BAR; PG8_SCHED;
            PG8_STAGE(PG8_SB(0, 1), b2 + hstepB, voffB);
            PG8_WAIT_V(6); PG8_BAR; PG8_MMA(1, 1, At, B1); PG8_BAR;
            PG8_LDB(B0, 1, 0); PG8_SCHED; PG8_LDA(At, 1, 0); PG8_STAGE(PG8_SA(0, 1), a2 + hstep, voffA);
            PG8_WAIT_L(8); PG8_BAR; PG8_WAIT_L(0); PG8_MMA(0, 0, At, B0); PG8_BAR; PG8_SCHED;
            PG8_LDB(B1, 1, 1); PG8_STAGE(PG8_SB(1, 0), b3, voffB);
            PG8_BAR; PG8_WAIT_L(0); PG8_MMA(0, 1, At, B1); PG8_BAR;
            PG8_LDA(At, 1, 1); PG8_STAGE(PG8_SA(1, 0), a3, voffA);
            PG8_BAR; PG8_WAIT_L(0); PG8_MMA(1, 0, At, B0); PG8_BAR; PG8_SCHED;
            PG8_STAGE(PG8_SB(1, 1), b3 + hstepB, voffB);
            PG8_WAIT_V(6); PG8_BAR; PG8_MMA(1, 1, At, B1); PG8_BAR;
            }
        }
        if constexpr (ALIGN_EPI) { if (wr == 0) PG8_BAR; }
        E(acc, cur, wr, wc, fr, fq);
        if (!has_next) break;
#pragma unroll
        for (int a = 0; a < 2; ++a)
#pragma unroll
            for (int b = 0; b < 2; ++b)
#pragma unroll
                for (int m = 0; m < 4; ++m)
#pragma unroll
                    for (int n = 0; n < 2; ++n) acc[a][b][m][n] = (f32x4){0.f, 0.f, 0.f, 0.f};
        cur = nxt; cA = nA; cB = nB; ++ui;
        if constexpr (ALIGN_EPI) { if (wr == 1) PG8_BAR; }
    }
    PG8_WAIT_V(0);
    if constexpr (!ALIGN_EPI) { if (wr == 0) PG8_BAR; }
    PG8_BAR;
#undef PG8_SA
#undef PG8_SB
#undef PG8_STAGE
#undef PG8_LDA
#undef PG8_LDB
#undef PG8_MMA
#undef PG8_WAIT_V
#undef PG8_WAIT_L
#undef PG8_BAR
#undef PG8_SCHED
}
}

struct EpiInProj {
    static constexpr int BMODE = 2;
    bf16_t* Z; const float* rope; float* kout; float* vout;
    __device__ __forceinline__ void operator()(const f32x4 (&acc)[2][2][4][2], const pg8::Unit& u, int wr, int wc, int fr, int fq) const {
        const int pn = u.pn, hsel = wc >> 1, i0 = 32 * (wc & 1) + 8 * fq;
        const int colb = 256 * pn + 128 * hsel + i0;
#pragma unroll
        for (int ai = 0; ai < 2; ++ai)
#pragma unroll
            for (int m = 0; m < 4; ++m) {
                const int row = 256 * u.pm + 128 * ai + 64 * wr + 16 * m + fr;
                const int pos = row & (SEQ - 1), bb = row >> 12;
                f32x4 a0 = acc[ai][0][m][0], a1 = acc[ai][0][m][1], b0 = acc[ai][1][m][0], b1 = acc[ai][1][m][1];
                if (pn < 8) {
                    const float* rt = rope + (size_t)pos * 128 + i0;
                    const f32x4 c0 = *(const f32x4*)(rt), c1 = *(const f32x4*)(rt + 4), s0 = *(const f32x4*)(rt + 64), s1 = *(const f32x4*)(rt + 68);
                    const f32x4 o0 = a0 * c0 - b0 * s0, o1 = a1 * c1 - b1 * s1, p0 = b0 * c0 + a0 * s0, p1 = b1 * c1 + a1 * s1;
                    a0 = o0; a1 = o1; b0 = p0; b1 = p1;
                    if (pn < 4) { const float sc = 0.08838834764831845f; a0 *= sc; a1 *= sc; b0 *= sc; b1 *= sc; }
                } else if (pn >= 12 && pn < 18) { const float sc = 0.0625f; a0 *= sc; a1 *= sc; b0 *= sc; b1 *= sc; }
                bf16_t* zp = Z + (size_t)row * NZ + colb;
                u32x4 w; w.x = cvt_pk_bf16(a0[0], a0[1]); w.y = cvt_pk_bf16(a0[2], a0[3]); w.z = cvt_pk_bf16(a1[0], a1[1]); w.w = cvt_pk_bf16(a1[2], a1[3]);
                *(u32x4*)zp = w;
                w.x = cvt_pk_bf16(b0[0], b0[1]); w.y = cvt_pk_bf16(b0[2], b0[3]); w.z = cvt_pk_bf16(b1[0], b1[1]); w.w = cvt_pk_bf16(b1[2], b1[3]);
                *(u32x4*)(zp + 64) = w;
                if (pn >= 4 && pn < 12 && pos >= 2048) {
                    float* ob = (pn < 8) ? kout : vout; const int head = 2 * ((pn - 4) & 3) + hsel;
                    float* op = ob + ((size_t)(bb * 2048 + pos - 2048) * 8 + head) * 128 + i0;
                    *(f32x4*)op = a0; *(f32x4*)(op + 4) = a1; *(f32x4*)(op + 64) = b0; *(f32x4*)(op + 68) = b1;
                }
                asm volatile("" ::: "memory");
            }
    }
};
struct EpiOutProj {
    static constexpr int BMODE = 0;
    const float* X; float* H; bf16_t* HB; float* rss;
    __device__ __forceinline__ void operator()(const f32x4 (&acc)[2][2][4][2], const pg8::Unit& u, int wr, int wc, int fr, int fq) const {
        const int col0 = 256 * u.pn + 32 * wc + 4 * fq;
#pragma unroll
        for (int ai = 0; ai < 2; ++ai)
#pragma unroll
            for (int m = 0; m < 4; ++m) {
                const int row = 256 * u.pm + 128 * ai + 64 * wr + 16 * m + fr; const size_t off = (size_t)row * DM + col0; float ss = 0.f;
#pragma unroll
                for (int bj = 0; bj < 2; ++bj)
#pragma unroll
                    for (int n = 0; n < 2; ++n) { const size_t o = off + bj * 128 + n * 16; const f32x4 hv = *(const f32x4*)(X + o) + acc[ai][bj][m][n];
                        *(f32x4*)(H + o) = hv; u32x2 w; w.x = cvt_pk_bf16(hv[0], hv[1]); w.y = cvt_pk_bf16(hv[2], hv[3]); *(u32x2*)(HB + o) = w;
                        ss += (hv[0] * hv[0] + hv[1] * hv[1]) + (hv[2] * hv[2] + hv[3] * hv[3]); }
                ss += __shfl_xor(ss, 16); ss += __shfl_xor(ss, 32);
                if (fq == 0) atomicAdd(rss + row, ss);
                asm volatile("" ::: "memory");
            }
    }
};
struct EpiUp {
    static constexpr int BMODE = 1;
    bf16_t* U; const float* rss;
    __device__ __forceinline__ void operator()(const f32x4 (&acc)[2][2][4][2], const pg8::Unit& u, int wr, int wc, int fr, int fq) const {
        const int col0 = 256 * u.pn + 32 * wc + 8 * fq;
#pragma unroll
        for (int ai = 0; ai < 2; ++ai)
#pragma unroll
            for (int m = 0; m < 4; ++m) {
                const int row = 256 * u.pm + 128 * ai + 64 * wr + 16 * m + fr;
                const float r = rsqrtf(rss[row] * (1.0f / DM) + EPS);
                bf16_t* up = U + (size_t)row * DFF + col0;
#pragma unroll
                for (int bj = 0; bj < 2; ++bj) { f32x4 v0 = acc[ai][bj][m][0] * r, v1 = acc[ai][bj][m][1] * r;
#pragma unroll
                    for (int j = 0; j < 4; ++j) { const float a = fmaxf(v0[j], 0.f), b = fmaxf(v1[j], 0.f); v0[j] = a * a; v1[j] = b * b; }
                    u32x4 w; w.x = cvt_pk_bf16(v0[0], v0[1]); w.y = cvt_pk_bf16(v0[2], v0[3]); w.z = cvt_pk_bf16(v1[0], v1[1]); w.w = cvt_pk_bf16(v1[2], v1[3]);
                    *(u32x4*)(up + bj * 128) = w; }
            }
    }
};
struct EpiDown {
    static constexpr int BMODE = 0;
    const float* H; float* Y; float* rss;
    __device__ __forceinline__ void operator()(const f32x4 (&acc)[2][2][4][2], const pg8::Unit& u, int wr, int wc, int fr, int fq) const {
        const int col0 = 256 * u.pn + 32 * wc + 4 * fq;
#pragma unroll
        for (int ai = 0; ai < 2; ++ai)
#pragma unroll
            for (int m = 0; m < 4; ++m) {
                const int row = 256 * u.pm + 128 * ai + 64 * wr + 16 * m + fr; const size_t off = (size_t)row * DM + col0; float ss = 0.f;
#pragma unroll
                for (int bj = 0; bj < 2; ++bj)
#pragma unroll
                    for (int n = 0; n < 2; ++n) { const size_t o = off + bj * 128 + n * 16; const f32x4 hv = *(const f32x4*)(H + o) + acc[ai][bj][m][n];
                        *(f32x4*)(Y + o) = hv; ss += (hv[0] * hv[0] + hv[1] * hv[1]) + (hv[2] * hv[2] + hv[3] * hv[3]); }
                ss += __shfl_xor(ss, 16); ss += __shfl_xor(ss, 32);
                if (fq == 0) atomicAdd(rss + row, ss);
                asm volatile("" ::: "memory");
            }
    }
};

constexpr int SK_SROW = 528;
template <int NI, class Epi>
__device__ __forceinline__ void skinny_unit(LAS unsigned char* lds, const bf16_t* S, const bf16_t* T, int K, int kbeg, int kend, const Epi& E, int u) {
    int tid = threadIdx.x; asm volatile("" : "+v"(tid)); const int wid = __builtin_amdgcn_readfirstlane(tid >> 6), lane = tid & 63, li = lane & 15, g = lane >> 4;
    const bf16_t* t0 = T + (size_t)(E.jrow(u, wid, 0) + li) * K + 32 * g;
    const bf16_t* t1 = T + (size_t)(E.jrow(u, wid, 1) + li) * K + 32 * g;
    f32x4 acc[2][NI];
#pragma unroll
    for (int a = 0; a < 2; ++a)
#pragma unroll
        for (int b = 0; b < NI; ++b) acc[a][b] = (f32x4){0.f, 0.f, 0.f, 0.f};
    bf16x8 tn[2][8];
#pragma unroll
    for (int q = 0; q < 8; ++q) { tn[0][q] = *(const bf16x8*)(t0 + kbeg + 128 * (q >> 2) + 8 * (q & 3)); tn[1][q] = *(const bf16x8*)(t1 + kbeg + 128 * (q >> 2) + 8 * (q & 3)); }
    int it = 0;
    for (int kb = kbeg; kb < kend; kb += 256, ++it) {
        bf16x8 tc[2][8];
#pragma unroll
        for (int q = 0; q < 8; ++q) { tc[0][q] = tn[0][q]; tc[1][q] = tn[1][q]; }
        if (kb + 256 < kend) {
#pragma unroll
            for (int q = 0; q < 8; ++q) { tn[0][q] = *(const bf16x8*)(t0 + kb + 256 + 128 * (q >> 2) + 8 * (q & 3)); tn[1][q] = *(const bf16x8*)(t1 + kb + 256 + 128 * (q >> 2) + 8 * (q & 3)); }
        }
        LAS unsigned char* sb = lds + (it & 1) * (NI * 16 * SK_SROW);
#pragma unroll
        for (int q = 0; q < NI; ++q) { const int ch = tid + 512 * q, row = ch >> 5, c16 = ch & 31;
            const u32x4 v = *(const u32x4*)(S + (size_t)row * K + kb + 8 * c16); *(LAS u32x4*)(sb + row * SK_SROW + 16 * c16) = v; }
        __syncthreads();
#pragma unroll
        for (int sub = 0; sub < 2; ++sub)
#pragma unroll
            for (int s = 0; s < 4; ++s) {
#pragma unroll
                for (int i2 = 0; i2 < NI; ++i2) {
                    const bf16x8 sf = *(const LAS bf16x8*)(sb + (16 * i2 + li) * SK_SROW + 2 * (128 * sub + 32 * g + 8 * s));
                    acc[0][i2] = __builtin_amdgcn_mfma_f32_16x16x32_bf16(tc[0][4 * sub + s], sf, acc[0][i2], 0, 0, 0);
                    acc[1][i2] = __builtin_amdgcn_mfma_f32_16x16x32_bf16(tc[1][4 * sub + s], sf, acc[1][i2], 0, 0, 0);
                }
            }
    }
    E(acc, u, wid, li, g);
    __syncthreads();
}

struct SkGates {
    const float* bif; float* G;
    __device__ __forceinline__ int jrow(int u, int w, int jt) const { return 256 * u + 32 * w + 16 * jt; }
    __device__ __forceinline__ void operator()(const f32x4 (&acc)[2][1], int u, int w, int li, int g) const {
        if (li >= 12) return;
        const float bias = bif[li];
#pragma unroll
        for (int jt = 0; jt < 2; ++jt) {
            const int tok = jrow(u, w, jt) + 4 * g; if (tok >= MT) continue;
            f32x4 v = acc[jt][0];
#pragma unroll
            for (int j = 0; j < 4; ++j) { float a = 15.0f * tanhf((v[j] + bias) * (1.0f / 15.0f));
                if (li >= 6) a = fminf(a, 0.f) - log1pf(__expf(-fabsf(a)));
                v[j] = a; }
            *(f32x4*)(G + (size_t)li * MT + tok) = v;
        }
    }
};
struct SkInProj {
    bf16_t* Z; const float* rope; float* kout; float* vout;
    __device__ __forceinline__ int jrow(int u, int w, int jt) const { return 256 * u + 128 * (w >> 2) + 64 * jt + 16 * (w & 3); }
    __device__ __forceinline__ void operator()(const f32x4 (&acc)[2][2], int u, int w, int li, int g) const {
        const int c0 = jrow(u, w, 0) + 4 * g;
        const int i0 = (c0 & 63);
#pragma unroll
        for (int i2 = 0; i2 < 2; ++i2) {
            const int sr = 16 * i2 + li, row = MP + sr;
            f32x4 a = acc[0][i2], b = acc[1][i2];
            if (u < 8) {
                const float* rt = rope + (size_t)4096 * 128 + i0;
                const f32x4 c = *(const f32x4*)rt, s = *(const f32x4*)(rt + 64);
                const f32x4 o = a * c - b * s, p = b * c + a * s; a = o; b = p;
                if (u < 4) { a *= 0.08838834764831845f; b *= 0.08838834764831845f; }
            } else if (u >= 12 && u < 18) { a *= 0.0625f; b *= 0.0625f; }
            bf16_t* zp = Z + (size_t)row * NZ + c0;
            u32x2 wv; wv.x = cvt_pk_bf16(a[0], a[1]); wv.y = cvt_pk_bf16(a[2], a[3]); *(u32x2*)zp = wv;
            wv.x = cvt_pk_bf16(b[0], b[1]); wv.y = cvt_pk_bf16(b[2], b[3]); *(u32x2*)(zp + 64) = wv;
            if (u >= 4 && u < 12) { float* ob = (u < 8) ? kout : vout; float* op = ob + (size_t)sr * 1024 + (c0 & 1023); *(f32x4*)op = a; *(f32x4*)(op + 64) = b; }
        }
    }
};
struct SkOutProj {
    const float* XS; float* H; bf16_t* HB; float* rss;
    __device__ __forceinline__ int jrow(int u, int w, int jt) const { return 256 * u + 32 * w + 16 * jt; }
    __device__ __forceinline__ void operator()(const f32x4 (&acc)[2][2], int u, int w, int li, int g) const {
#pragma unroll
        for (int i2 = 0; i2 < 2; ++i2) { const int sr = 16 * i2 + li, row = MP + sr; float ss = 0.f;
#pragma unroll
            for (int jt = 0; jt < 2; ++jt) { const int col = jrow(u, w, jt) + 4 * g; const f32x4 hv = *(const f32x4*)(XS + (size_t)sr * DM + col) + acc[jt][i2];
                *(f32x4*)(H + (size_t)row * DM + col) = hv; u32x2 wv; wv.x = cvt_pk_bf16(hv[0], hv[1]); wv.y = cvt_pk_bf16(hv[2], hv[3]); *(u32x2*)(HB + (size_t)row * DM + col) = wv;
                ss += (hv[0] * hv[0] + hv[1] * hv[1]) + (hv[2] * hv[2] + hv[3] * hv[3]); }
            atomicAdd(rss + row, ss); }
    }
};
struct SkUp {
    bf16_t* U; const float* rss;
    __device__ __forceinline__ int jrow(int u, int w, int jt) const { return 256 * u + 32 * w + 16 * jt; }
    __device__ __forceinline__ void operator()(const f32x4 (&acc)[2][2], int u, int w, int li, int g) const {
#pragma unroll
        for (int i2 = 0; i2 < 2; ++i2) { const int row = MP + 16 * i2 + li; const float r = rsqrtf(rss[row] * (1.0f / DM) + EPS);
#pragma unroll
            for (int jt = 0; jt < 2; ++jt) { const int col = jrow(u, w, jt) + 4 * g; f32x4 v = acc[jt][i2] * r;
#pragma unroll
                for (int j = 0; j < 4; ++j) { const float a = fmaxf(v[j], 0.f); v[j] = a * a; }
                u32x2 wv; wv.x = cvt_pk_bf16(v[0], v[1]); wv.y = cvt_pk_bf16(v[2], v[3]); *(u32x2*)(U + (size_t)row * DFF + col) = wv; } }
    }
};
struct SkDown {
    float* ACC;
    __device__ __forceinline__ int jrow(int u, int w, int jt) const { return 256 * (u & 15) + 32 * w + 16 * jt; }
    __device__ __forceinline__ void operator()(const f32x4 (&acc)[2][2], int u, int w, int li, int g) const {
#pragma unroll
        for (int i2 = 0; i2 < 2; ++i2)
#pragma unroll
            for (int jt = 0; jt < 2; ++jt) { float* p = ACC + (size_t)(16 * i2 + li) * DM + jrow(u, w, jt) + 4 * g;
#pragma unroll
                for (int j = 0; j < 4; ++j) atomicAdd(p + j, acc[jt][i2][j]); }
    }
};

__device__ __forceinline__ void p0_transpose(const float* W, int ldw, int K, int Nuse, bf16_t* WT, const float* gk, int gw, int ngw, int lane) {
    const int nkb = K / 8, nnb = Nuse / 256, items = nkb * nnb;
    for (int it = gw; it < items; it += ngw) {
        const int kb = it % nkb, nb = it / nkb, k0 = 8 * kb, n0 = 256 * nb + 4 * lane;
        f32x4 v[8];
#pragma unroll
        for (int i = 0; i < 8; ++i) v[i] = *(const f32x4*)(W + (size_t)(k0 + i) * ldw + n0);
        if (gk) {
#pragma unroll
            for (int i = 0; i < 8; ++i) v[i] *= gk[k0 + i];
        }
#pragma unroll
        for (int c = 0; c < 4; ++c) { u32x4 o; o.x = cvt_pk_bf16(v[0][c], v[1][c]); o.y = cvt_pk_bf16(v[2][c], v[3][c]); o.z = cvt_pk_bf16(v[4][c], v[5][c]); o.w = cvt_pk_bf16(v[6][c], v[7][c]);
            *(u32x4*)(WT + (size_t)(n0 + c) * K + k0) = o; }
    }
}
__device__ __forceinline__ void sincos_d(float ang, float& c, float& s) {
    const double x = (double)ang;
    const double n = __builtin_rint(x * 0.63661977236758134308);
    double r = __builtin_fma(-n, 1.57079632679489655800e+00, x); r = __builtin_fma(-n, 6.12323399573676603587e-17, r);
    const double r2 = r * r;
    double sp = 1.0 / 6227020800.0; sp = sp * r2 * (-1.0) + 1.0 / 39916800.0; sp = sp * r2 * (-1.0) + 1.0 / 362880.0; sp = sp * r2 * (-1.0) + 1.0 / 5040.0; sp = sp * r2 * (-1.0) + 1.0 / 120.0; sp = sp * r2 * (-1.0) + 1.0 / 6.0; sp = sp * r2 * (-1.0) + 1.0;
    const double sn = sp * r;
    double cp = 1.0 / 87178291200.0; cp = cp * r2 * (-1.0) + 1.0 / 479001600.0; cp = cp * r2 * (-1.0) + 1.0 / 3628800.0; cp = cp * r2 * (-1.0) + 1.0 / 40320.0; cp = cp * r2 * (-1.0) + 1.0 / 720.0; cp = cp * r2 * (-1.0) + 1.0 / 24.0; cp = cp * r2 * (-1.0) + 0.5; cp = cp * r2 * (-1.0) + 1.0;
    const double cs = cp;
    const int q = ((int)n) & 3;
    const double cc = (q == 0) ? cs : (q == 1) ? -sn : (q == 2) ? -cs : sn;
    const double ss = (q == 0) ? sn : (q == 1) ? cs : (q == 2) ? -sn : -cs;
    c = (float)cc; s = (float)ss;
}
struct P0Args { const float *xp, *xs, *g1, *win, *wout, *g2, *wup, *wdn; bf16_t *WinT, *WoutT, *WupT, *WdnT, *XN, *WG; float* rope; };
__device__ __forceinline__ void p0_prologue(const P0Args& a, int vcu, int G, int wid, int lane) {
    const int gw = vcu * 8 + wid, ngw = G * 8, gt = gw * 64 + lane, ngt = ngw * 64;
    for (int idx = gt; idx < 4097 * 64; idx += ngt) { const int pi = idx >> 6, i = idx & 63; const int pos = pi < 4096 ? pi : 8192;
        double invd = 1.0; for (int e = 0; e < i; ++e) invd *= 0.86596432336006535;
        const float inv = (float)invd; const float ang = (float)pos * inv; float c, s; sincos_d(ang, c, s);
        a.rope[(size_t)pi * 128 + i] = c; a.rope[(size_t)pi * 128 + 64 + i] = s; }
    for (int idx = gt; idx < 16 * DM; idx += ngt) { const int gi = idx >> 12, k = idx & 4095; const float v = gi < 12 ? a.win[(size_t)k * NINF + NZ + gi] : 0.f; a.WG[idx] = (bf16_t)(cvt_pk_bf16(v, 0.f) & 0xffffu); }
    for (int m = gw; m < MT; m += ngw) {
        const float* xr = (m < MP) ? a.xp + (size_t)m * DM : a.xs + (size_t)(m - MP) * DM;
        f32x4 v[8][2]; float ss = 0.f;
#pragma unroll
        for (int c = 0; c < 8; ++c) { v[c][0] = *(const f32x4*)(xr + 512 * c + 8 * lane); v[c][1] = *(const f32x4*)(xr + 512 * c + 8 * lane + 4);
            ss += (v[c][0][0] * v[c][0][0] + v[c][0][1] * v[c][0][1]) + (v[c][0][2] * v[c][0][2] + v[c][0][3] * v[c][0][3]) + (v[c][1][0] * v[c][1][0] + v[c][1][1] * v[c][1][1]) + (v[c][1][2] * v[c][1][2] + v[c][1][3] * v[c][1][3]); }
        const float r = rsqrtf(wave_sum(ss) * (1.0f / DM) + EPS);
#pragma unroll
        for (int c = 0; c < 8; ++c) { const f32x4 g0 = *(const f32x4*)(a.g1 + 512 * c + 8 * lane), g1v = *(const f32x4*)(a.g1 + 512 * c + 8 * lane + 4);
            const f32x4 y0 = v[c][0] * r * g0, y1 = v[c][1] * r * g1v;
            u32x4 o; o.x = cvt_pk_bf16(y0[0], y0[1]); o.y = cvt_pk_bf16(y0[2], y0[3]); o.z = cvt_pk_bf16(y1[0], y1[1]); o.w = cvt_pk_bf16(y1[2], y1[3]);
            *(u32x4*)(a.XN + (size_t)m * DM + 512 * c + 8 * lane) = o; }
    }
    p0_transpose(a.win, NINF, DM, NZ, a.WinT, nullptr, gw, ngw, lane);
    p0_transpose(a.wout, DM, DM, DM, a.WoutT, nullptr, gw, ngw, lane);
    p0_transpose(a.wup, DFF, DM, DFF, a.WupT, a.g2, gw, ngw, lane);
    p0_transpose(a.wdn, DM, DFF, DM, a.WdnT, nullptr, gw, ngw, lane);
}


constexpr int SC_KSTR = 544, SC_VSTR = 144, SC_KIMG = 50176, SC_VIMG = 84992;
__device__ __forceinline__ void mlstm_scan(LAS unsigned char* lds, const bf16_t* Z, const float* GT, bf16_t* CT, float* NC, float* TB, float* TWV, float* TMT, float* CM, float* out, int unit) {
    int tid = threadIdx.x; asm volatile("" : "+v"(tid)); const int wid = __builtin_amdgcn_readfirstlane(tid >> 6), lane = tid & 63, li = lane & 15, g = lane >> 4;
    const int bh = unit >> 3, sl = unit & 7, b = bh / NH, h = bh % NH, dvt = wid & 3, dkh = wid >> 2;
    LAS float* wv = (LAS float*)lds; LAS float* bl = wv + 4096; LAS float* cml = bl + 4096; LAS float* bs = cml + 4096; LAS float* gc = bs + 64; LAS float* mC = gc + 64;
    LAS unsigned char* Kimg = lds + SC_KIMG; LAS unsigned char* Vimg = lds + SC_VIMG;
    { const float* lip = GT + (size_t)h * MT + b * SEQ; const float* lfp = GT + (size_t)(6 + h) * MT + b * SEQ;
      for (int c = wid; c < NCH; c += 8) { const int t = 64 * c + lane; const float lf = lfp[t], liv = lip[t];
          float bsum = lf;
#pragma unroll
          for (int o = 1; o < 64; o <<= 1) { const float v = __shfl_up(bsum, o); if (lane >= o) bsum += v; }
          const float w = liv - bsum; float cm = w;
#pragma unroll
          for (int o = 1; o < 64; o <<= 1) { const float v = __shfl_up(cm, o); if (lane >= o) cm = fmaxf(cm, v); }
          wv[t] = w; bl[t] = bsum; cml[t] = cm;
          if (lane == 63) { bs[c] = bsum; gc[c] = bsum + cm; } }
      __syncthreads();
      if (tid == 0) { float m = 0.f; mC[0] = 0.f; for (int c = 0; c < NCH; ++c) { m = fmaxf(bs[c] + m, gc[c]); mC[c + 1] = m; } }
      __syncthreads();
      if (sl == 0) { for (int t = tid; t < SEQ; t += 512) { const int c = t >> 6; TB[bh * SEQ + t] = bl[t]; TWV[bh * SEQ + t] = wv[t]; TMT[bh * SEQ + t] = bl[t] + fmaxf(mC[c], cml[t]); }
                     if (tid < 65) CM[bh * 80 + tid] = mC[tid]; } }
    const bool nwr = (sl == 0) && (dvt == 0);
    f32x4 acc[8], nacc[8];
#pragma unroll
    for (int T = 0; T < 8; ++T) { acc[T] = (f32x4){0.f, 0.f, 0.f, 0.f}; nacc[T] = (f32x4){0.f, 0.f, 0.f, 0.f}; }
    bf16x8 ones;
#pragma unroll
    for (int e = 0; e < 8; ++e) ones[e] = (short)0x3F80;
    for (int c = 0; c < NCH; ++c) {
        { bf16_t* ct = CT + (((size_t)(bh * NCH + c) * DV + (64 * sl + 16 * dvt + li)) * DK + 128 * dkh + 4 * g);
#pragma unroll
          for (int T = 0; T < 8; ++T) { u32x2 w; w.x = cvt_pk_bf16(acc[T][0], acc[T][1]); w.y = cvt_pk_bf16(acc[T][2], acc[T][3]); *(u32x2*)(ct + 16 * T) = w; }
          if (nwr && li == 0) {
#pragma unroll
              for (int T = 0; T < 8; ++T) *(f32x4*)(NC + (size_t)(bh * NCH + c) * DK + 128 * dkh + 16 * T + 4 * g) = nacc[T]; } }
        __syncthreads();
        const float mn = mC[c + 1], bsc = bs[c];
#pragma unroll
        for (int q = 0; q < 4; ++q) { const int ch = tid + 512 * q, tok = ch >> 5, c16 = ch & 31; const size_t row = (size_t)b * SEQ + 64 * c + tok;
            const u32x4 kv = *(const u32x4*)(Z + row * NZ + ZKM + h * DK + 8 * c16); const float w = __expf(bsc + wv[64 * c + tok] - mn);
            u32x4 o; o.x = cvt_pk_bf16(bf_lo(kv.x) * w, bf_hi(kv.x) * w); o.y = cvt_pk_bf16(bf_lo(kv.y) * w, bf_hi(kv.y) * w); o.z = cvt_pk_bf16(bf_lo(kv.z) * w, bf_hi(kv.z) * w); o.w = cvt_pk_bf16(bf_lo(kv.w) * w, bf_hi(kv.w) * w);
            *(LAS u32x4*)(Kimg + tok * SC_KSTR + 16 * c16) = o; }
        { const int tok = tid >> 3, c16 = tid & 7; const size_t row = (size_t)b * SEQ + 64 * c + tok;
          const u32x4 vv = *(const u32x4*)(Z + row * NZ + ZVM + h * DV + 64 * sl + 8 * c16); *(LAS u32x4*)(Vimg + tok * SC_VSTR + 16 * c16) = vv; }
        __syncthreads();
        const float dec = __expf(bsc + mC[c] - mn);
#pragma unroll
        for (int T = 0; T < 8; ++T) { acc[T] *= dec; nacc[T] *= dec; }
#pragma unroll
        for (int kb = 0; kb < 2; ++kb) {
            const LAS unsigned char* vp = Vimg + (32 * kb + 8 * g + (li >> 2)) * SC_VSTR + (16 * dvt + 4 * (li & 3)) * 2;
            const bf16x8 Bf = cat8(vtr(vp), vtr(vp + 4 * SC_VSTR));
#pragma unroll
            for (int T = 0; T < 8; ++T) {
                const LAS unsigned char* kp = Kimg + (32 * kb + 8 * g + (li >> 2)) * SC_KSTR + (128 * dkh + 16 * T + 4 * (li & 3)) * 2;
                const bf16x8 Af = cat8(vtr(kp), vtr(kp + 4 * SC_KSTR));
                acc[T] = __builtin_amdgcn_mfma_f32_16x16x32_bf16(Af, Bf, acc[T], 0, 0, 0);
                if (nwr) nacc[T] = __builtin_amdgcn_mfma_f32_16x16x32_bf16(Af, ones, nacc[T], 0, 0, 0);
            }
        }
    }
#pragma unroll
    for (int T = 0; T < 8; ++T)
#pragma unroll
        for (int r = 0; r < 4; ++r) out[O_CP + ((size_t)bh * DK + 128 * dkh + 16 * T + 4 * g + r) * DV + 64 * sl + 16 * dvt + li] = acc[T][r];
    if (nwr && li == 0) {
#pragma unroll
        for (int T = 0; T < 8; ++T) *(f32x4*)(out + O_NP + (size_t)bh * DK + 128 * dkh + 16 * T + 4 * g) = nacc[T]; }
    if (sl == 0 && tid == 0) out[O_MP + bh] = mC[NCH];
    __syncthreads();
}

constexpr int AT_VS = 272;
__device__ __forceinline__ void attn_tile(LAS unsigned char* vimg, const bf16_t* Z, bf16_t* MIX, int b, int h, int p0c, int lane) {
    const int li = lane & 15, g = lane >> 4;
    const int qpos = p0c + 16 * li, pmax = p0c + 240;
    const bf16_t* zb = Z + (size_t)b * SEQ * NZ + h * 128;
    bf16x8 qf[4];
#pragma unroll
    for (int s = 0; s < 4; ++s) qf[s] = *(const bf16x8*)(zb + (size_t)qpos * NZ + ZQA + 32 * s + 8 * g);
    f32x4 o[8];
#pragma unroll
    for (int d = 0; d < 8; ++d) o[d] = (f32x4){0.f, 0.f, 0.f, 0.f};
    float m = -INFINITY, l = 0.f;
#pragma unroll 1
    for (int cfg = 0; cfg < 3; ++cfg) {
        const int r = (cfg == 0) ? 1 : (cfg == 1) ? 4 : 16, w = (cfg == 0) ? 128 : (cfg == 1) ? 512 : 2048, nblk = (cfg == 0) ? 12 : (cfg == 1) ? 6 : 5;
#pragma unroll 1
        for (int blk = 0; blk < nblk; ++blk) {
            u32x4 vv[8];
#pragma unroll
            for (int it = 0; it < 8; ++it) { const int ci = it * 64 + lane, key = ci >> 4, part = ci & 15; int kp = pmax - r * (32 * blk + key); kp = kp < 0 ? 0 : (kp > SEQ - 1 ? SEQ - 1 : kp);
                vv[it] = *(const u32x4*)(zb + (size_t)kp * NZ + ZVA + 8 * part); }
            bf16x8 kf[2][4];
#pragma unroll
            for (int T = 0; T < 2; ++T) { int kp = pmax - r * (32 * blk + 16 * T + li); kp = kp < 0 ? 0 : (kp > SEQ - 1 ? SEQ - 1 : kp);
#pragma unroll
                for (int s = 0; s < 4; ++s) kf[T][s] = *(const bf16x8*)(zb + (size_t)kp * NZ + ZKA + 32 * s + 8 * g); }
            f32x4 st[2];
#pragma unroll
            for (int T = 0; T < 2; ++T) { st[T] = (f32x4){0.f, 0.f, 0.f, 0.f};
#pragma unroll
                for (int s = 0; s < 4; ++s) st[T] = __builtin_amdgcn_mfma_f32_16x16x32_bf16(kf[T][s], qf[s], st[T], 0, 0, 0); }
            float bm = -INFINITY;
#pragma unroll
            for (int T = 0; T < 2; ++T)
#pragma unroll
                for (int rg = 0; rg < 4; ++rg) { const int n = 32 * blk + 16 * T + 4 * g + rg; const int dist = r * n - 16 * (15 - li); const int kp = pmax - r * n;
                    const bool ok = (dist >= 0) && (dist <= w) && (kp >= 0);
                    st[T][rg] = ok ? st[T][rg] : -INFINITY; bm = fmaxf(bm, st[T][rg]); }
            bm = fmaxf(bm, __shfl_xor(bm, 16)); bm = fmaxf(bm, __shfl_xor(bm, 32));
            const float mn = fmaxf(m, bm), mu = (mn == -INFINITY) ? 0.f : mn;
            const float alpha = __expf(m - mu);
            float ps = 0.f; f32x4 p[2];
#pragma unroll
            for (int T = 0; T < 2; ++T)
#pragma unroll
                for (int rg = 0; rg < 4; ++rg) { p[T][rg] = __expf(st[T][rg] - mu); ps += p[T][rg]; }
            l = l * alpha + ps; m = mn;
#pragma unroll
            for (int d = 0; d < 8; ++d) o[d] *= alpha;
            bf16x8 pf; { const unsigned w0 = cvt_pk_bf16(p[0][0], p[0][1]), w1 = cvt_pk_bf16(p[0][2], p[0][3]), w2 = cvt_pk_bf16(p[1][0], p[1][1]), w3 = cvt_pk_bf16(p[1][2], p[1][3]);
                pf[0] = (short)(w0 & 0xffff); pf[1] = (short)(w0 >> 16); pf[2] = (short)(w1 & 0xffff); pf[3] = (short)(w1 >> 16); pf[4] = (short)(w2 & 0xffff); pf[5] = (short)(w2 >> 16); pf[6] = (short)(w3 & 0xffff); pf[7] = (short)(w3 >> 16); }
            asm volatile("" ::: "memory");
#pragma unroll
            for (int it = 0; it < 8; ++it) { const int ci = it * 64 + lane, key = ci >> 4, part = ci & 15; *(LAS u32x4*)(vimg + key * AT_VS + 16 * part) = vv[it]; }
            asm volatile("" ::: "memory");
#pragma unroll
            for (int d = 0; d < 8; ++d) { const LAS unsigned char* vp = vimg + (4 * g + (li >> 2)) * AT_VS + (16 * d + 4 * (li & 3)) * 2;
                const bf16x8 af = cat8(vtr(vp), vtr(vp + 16 * AT_VS));
                o[d] = __builtin_amdgcn_mfma_f32_16x16x32_bf16(af, pf, o[d], 0, 0, 0); }
            asm volatile("" ::: "memory");
        }
    }
    l += __shfl_xor(l, 16); l += __shfl_xor(l, 32);
    const float inv = 1.0f / l;
    bf16_t* mp = MIX + ((size_t)b * SEQ + qpos) * DM + h * 128 + 4 * g;
#pragma unroll
    for (int d = 0; d < 8; ++d) { u32x2 w; w.x = cvt_pk_bf16(o[d][0] * inv, o[d][1] * inv); w.y = cvt_pk_bf16(o[d][2] * inv, o[d][3] * inv); *(u32x2*)(mp + 16 * d) = w; }
}
__device__ __forceinline__ void attn_unit(LAS unsigned char* lds, const bf16_t* Z, bf16_t* MIX, int unit) {
    int tid = threadIdx.x; asm volatile("" : "+v"(tid)); const int wid = __builtin_amdgcn_readfirstlane(tid >> 6), lane = tid & 63;
    const int qb = unit & 15, h = (unit >> 4) & 7, b = unit >> 7;
    LAS unsigned char* vimg = lds + wid * (32 * AT_VS);
    attn_tile(vimg, Z, MIX, b, h, 256 * qb + wid, lane);
    attn_tile(vimg, Z, MIX, b, h, 256 * qb + wid + 8, lane);
}

__device__ __forceinline__ void sattn_unit(LAS unsigned char* lds, const bf16_t* Z, const float* ck, const float* cv, const float* out, bf16_t* MIX, int unit) {
    int tid = threadIdx.x; asm volatile("" : "+v"(tid)); const int wid = __builtin_amdgcn_readfirstlane(tid >> 6), lane = tid & 63;
    const int b = unit >> 3, h = unit & 7;
    LAS float* sc = (LAS float*)lds;
    LAS float* red = sc + 400;
    LAS float* misc = red + 1024;
    const bf16_t* qp = Z + (size_t)(MP + b) * NZ + ZQA + h * 128 + 2 * lane;
    const float q0 = bf1(qp[0]), q1 = bf1(qp[1]);
    const float* knew = out + O_KS + (size_t)b * 1024 + h * 128; const float* vnew = out + O_VS + (size_t)b * 1024 + h * 128;
    const float* ckb = ck + (size_t)b * 2048 * 1024 + h * 128; const float* cvb = cv + (size_t)b * 2048 * 1024 + h * 128;
    for (int e = wid; e < 387; e += 8) { const int cfg = e / 129, j = e - cfg * 129, r = (cfg == 0) ? 1 : (cfg == 1) ? 4 : 16, dist = j * r;
        const float* kp = (dist == 0) ? knew : ckb + (size_t)(2048 - dist) * 1024;
        const f32x2 kv = *(const f32x2*)(kp + 2 * lane); const float s = wave_sum(q0 * kv.x + q1 * kv.y);
        if (lane == 0) sc[e] = s; }
    __syncthreads();
    if (wid == 0) { float mx = -INFINITY; for (int e = lane; e < 387; e += 64) mx = fmaxf(mx, sc[e]); mx = wave_max(mx);
        float sm = 0.f; for (int e = lane; e < 387; e += 64) { const float p = __expf(sc[e] - mx); sc[e] = p; sm += p; } sm = wave_sum(sm);
        if (lane == 0) misc[1] = sm; }
    __syncthreads();
    float a0 = 0.f, a1 = 0.f;
    for (int e = wid; e < 387; e += 8) { const int cfg = e / 129, j = e - cfg * 129, r = (cfg == 0) ? 1 : (cfg == 1) ? 4 : 16, dist = j * r;
        const float* vp = (dist == 0) ? vnew : cvb + (size_t)(2048 - dist) * 1024;
        const f32x2 vv = *(const f32x2*)(vp + 2 * lane); const float p = sc[e]; a0 += p * vv.x; a1 += p * vv.y; }
    red[wid * 128 + 2 * lane] = a0; red[wid * 128 + 2 * lane + 1] = a1;
    __syncthreads();
    if (tid < 128) { float s = 0.f;
#pragma unroll
        for (int w = 0; w < 8; ++w) s += red[w * 128 + tid];
        const float v = s / misc[1]; MIX[(size_t)(MP + b) * DM + h * 128 + tid] = (bf16_t)(cvt_pk_bf16(v, 0.f) & 0xffffu); }
    __syncthreads();
}

__device__ __forceinline__ void smlstm_unit(LAS unsigned char* lds, const bf16_t* Z, const float* GT, const float* sC, const float* sN, const float* sM, const float* mhg, float* out, bf16_t* MIX, float* HRAW, int unit) {
    int tid = threadIdx.x; asm volatile("" : "+v"(tid)); const int wid = __builtin_amdgcn_readfirstlane(tid >> 6), lane = tid & 63;
    const int b = unit / NH, h = unit % NH, row = MP + b;
    LAS float* qs = (LAS float*)lds; LAS float* ks = qs + 256; LAS float* red = ks + 256;
    const bf16_t* zr = Z + (size_t)row * NZ;
    const float liv = GT[(size_t)h * MT + row], lf = GT[(size_t)(6 + h) * MT + row], m0 = sM[b * NH + h];
    const float mt = fmaxf(lf + m0, liv), a = __expf(lf + m0 - mt), wsv = __expf(liv - mt);
    float pq = 0.f, pn = 0.f;
    if (tid < 256) { const float q = bf1(zr[ZQM + h * DK + tid]), k = bf1(zr[ZKM + h * DK + tid]), n0 = sN[(size_t)(b * NH + h) * DK + tid]; qs[tid] = q; ks[tid] = k; pq = q * k; pn = q * n0;
        out[O_NS + (size_t)(b * NH + h) * DK + tid] = a * n0 + wsv * k; }
    pq = wave_sum(pq); pn = wave_sum(pn);
    if (lane == 0) { red[wid] = pq; red[8 + wid] = pn; }
    __syncthreads();
    const float qk = red[0] + red[1] + red[2] + red[3], qn = red[8] + red[9] + red[10] + red[11];
    const float sw = qk * wsv;
    const float v = bf1(zr[ZVM + h * DV + tid]);
    const float* cp = sC + (size_t)(b * NH + h) * DK * DV + tid; float* co = out + O_CS + (size_t)(b * NH + h) * DK * DV + tid;
    const float wv_ = wsv * v; float numi = 0.f;
#pragma unroll 8
    for (int dk = 0; dk < DK; ++dk) { const float c = cp[(size_t)dk * DV]; numi += qs[dk] * c; co[(size_t)dk * DV] = a * c + wv_ * ks[dk]; }
    const float num = sw * v + a * numi, den = sw + a * qn;
    const float hv = num / fmaxf(fabsf(den), __expf(-mt));
    if (HRAW) HRAW[(size_t)row * 3072 + h * DV + tid] = hv;
    const float ssq = wave_sum(hv * hv);
    if (lane == 0) red[16 + wid] = ssq;
    __syncthreads();
    float tot = 0.f;
#pragma unroll
    for (int w = 0; w < 8; ++w) tot += red[16 + w];
    const float om = bf1(zr[ZOM + h * DV + tid]);
    const float y = hv * rsqrtf(tot * (1.0f / DV) + EPS) * mhg[h * DV + tid] * (1.0f / (1.0f + __expf(-om)));
    MIX[(size_t)row * DM + 1024 + h * DV + tid] = (bf16_t)(cvt_pk_bf16(y, 0.f) & 0xffffu);
    if (tid == 0) out[O_MS + b * NH + h] = mt;
    __syncthreads();
}

constexpr int OB_QS = 528, OB_Q = 0, OB_K = 33792, OB_V0 = 67584, OB_V1 = 101376, OB_SW = 135168, OB_SWS = 144, OB_SM = 144384;
__device__ __forceinline__ void mlstm_out(LAS unsigned char* lds, const bf16_t* Z, const bf16_t* CT, const float* NC, const float* TB, const float* TWV, const float* TMT, const float* CM, const float* mhg, bf16_t* MIX, float* HRAW, int unit) {
    int tid = threadIdx.x; asm volatile("" : "+v"(tid)); const int wid = __builtin_amdgcn_readfirstlane(tid >> 6), lane = tid & 63, li = lane & 15, g = lane >> 4;
    const int bh = unit >> 6, c = unit & 63, b = bh / NH, h = bh % NH;
    LAS float* rs = (LAS float*)(lds + OB_SM); LAS float* dn = rs + 64; LAS float* hs = dn + 64; LAS float* ub = hs + 64; LAS float* wvv = ub + 64; LAS float* av = wvv + 64; LAS float* em = av + 64;
    const size_t row0 = (size_t)b * SEQ + 64 * c;
#pragma unroll
    for (int q = 0; q < 4; ++q) { const int ch = tid + 512 * q, tok = ch >> 5, c16 = ch & 31; const bf16_t* zr = Z + (row0 + tok) * NZ;
        *(LAS u32x4*)(lds + OB_Q + tok * OB_QS + 16 * c16) = *(const u32x4*)(zr + ZQM + h * DK + 8 * c16);
        *(LAS u32x4*)(lds + OB_K + tok * OB_QS + 16 * c16) = *(const u32x4*)(zr + ZKM + h * DK + 8 * c16); }
#pragma unroll
    for (int q = 0; q < 8; ++q) { const int ch = tid + 512 * q, tok = ch >> 6, c16 = ch & 63; const bf16_t* zr = Z + (row0 + tok) * NZ;
        *(LAS u32x4*)(lds + ((c16 >> 5) ? OB_V1 : OB_V0) + tok * OB_QS + 16 * (c16 & 31)) = *(const u32x4*)(zr + ZVM + h * DV + 8 * c16); }
    if (tid < 64) { const int t = bh * SEQ + 64 * c + tid; const float bb = TB[t], mt = TMT[t];
        ub[tid] = bb - mt; wvv[tid] = TWV[t]; av[tid] = __expf(bb + CM[bh * 80 + c] - mt); em[tid] = __expf(-mt); rs[tid] = 0.f; hs[tid] = 0.f; }
    __syncthreads();
    { const int t = tid >> 3, part = tid & 7; const float* np = NC + (size_t)(bh * NCH + c) * DK + 32 * part; const LAS bf16_t* qp = (const LAS bf16_t*)(lds + OB_Q + t * OB_QS) + 32 * part; float s = 0.f;
#pragma unroll 8
      for (int e = 0; e < 32; ++e) s += bf1(qp[e]) * np[e];
      s += __shfl_xor(s, 1); s += __shfl_xor(s, 2); s += __shfl_xor(s, 4);
      if (part == 0) dn[t] = s; }
    { const int st = wid & 3;
#pragma unroll
      for (int tq = 0; tq < 2; ++tq) { const int tt = 2 * (wid >> 2) + tq; f32x4 d = (f32x4){0.f, 0.f, 0.f, 0.f};
#pragma unroll
          for (int kk = 0; kk < 8; ++kk) { const bf16x8 kf = *(const LAS bf16x8*)(lds + OB_K + (16 * st + li) * OB_QS + (32 * kk + 8 * g) * 2);
              const bf16x8 qf = *(const LAS bf16x8*)(lds + OB_Q + (16 * tt + li) * OB_QS + (32 * kk + 8 * g) * 2);
              d = __builtin_amdgcn_mfma_f32_16x16x32_bf16(kf, qf, d, 0, 0, 0); }
          const int t = 16 * tt + li; const float ut = ub[t]; float ps = 0.f; f32x4 sw;
#pragma unroll
          for (int r = 0; r < 4; ++r) { const int s = 16 * st + 4 * g + r; const float w = (s <= t) ? d[r] * __expf(ut + wvv[s]) : 0.f; sw[r] = w; ps += w; }
          u32x2 pk; pk.x = cvt_pk_bf16(sw[0], sw[1]); pk.y = cvt_pk_bf16(sw[2], sw[3]);
          *(LAS u32x2*)(lds + OB_SW + t * OB_SWS + (16 * st + 4 * g) * 2) = pk;
          lds_addf(rs + t, ps); } }
    __syncthreads();
    f32x4 acc[4][4];
#pragma unroll
    for (int a = 0; a < 4; ++a)
#pragma unroll
        for (int t = 0; t < 4; ++t) acc[a][t] = (f32x4){0.f, 0.f, 0.f, 0.f};
    const bf16_t* ctb = CT + ((size_t)(bh * NCH + c) * DV + 64 * wid + li) * DK + 8 * g;
#pragma unroll 2
    for (int kk = 0; kk < 8; ++kk) {
        bf16x8 af[4], bq[4];
#pragma unroll
        for (int vt = 0; vt < 4; ++vt) af[vt] = *(const bf16x8*)(ctb + (size_t)(16 * vt) * DK + 32 * kk);
#pragma unroll
        for (int tt = 0; tt < 4; ++tt) bq[tt] = *(const LAS bf16x8*)(lds + OB_Q + (16 * tt + li) * OB_QS + (32 * kk + 8 * g) * 2);
#pragma unroll
        for (int vt = 0; vt < 4; ++vt)
#pragma unroll
            for (int tt = 0; tt < 4; ++tt) acc[vt][tt] = __builtin_amdgcn_mfma_f32_16x16x32_bf16(af[vt], bq[tt], acc[vt][tt], 0, 0, 0);
    }
#pragma unroll
    for (int tt = 0; tt < 4; ++tt) { const float at = av[16 * tt + li];
#pragma unroll
        for (int vt = 0; vt < 4; ++vt) acc[vt][tt] *= at; }
    { const LAS unsigned char* vb = lds + ((wid >> 2) ? OB_V1 : OB_V0);
#pragma unroll
      for (int kb = 0; kb < 2; ++kb) {
          bf16x8 bs_[4];
#pragma unroll
          for (int tt = 0; tt < 4; ++tt) bs_[tt] = *(const LAS bf16x8*)(lds + OB_SW + (16 * tt + li) * OB_SWS + (32 * kb + 8 * g) * 2);
#pragma unroll
          for (int vt = 0; vt < 4; ++vt) { const LAS unsigned char* vp = vb + (32 * kb + 8 * g + (li >> 2)) * OB_QS + (64 * (wid & 3) + 16 * vt + 4 * (li & 3)) * 2;
              const bf16x8 af = cat8(vtr(vp), vtr(vp + 4 * OB_QS));
#pragma unroll
              for (int tt = 0; tt < 4; ++tt) acc[vt][tt] = __builtin_amdgcn_mfma_f32_16x16x32_bf16(af, bs_[tt], acc[vt][tt], 0, 0, 0); } } }
    float dd[4];
#pragma unroll
    for (int tt = 0; tt < 4; ++tt) { const int t = 16 * tt + li; const float den = rs[t] + av[t] * dn[t]; dd[tt] = fmaxf(fabsf(den), em[t]);
        float q = 0.f;
#pragma unroll
        for (int vt = 0; vt < 4; ++vt) q += (acc[vt][tt][0] * acc[vt][tt][0] + acc[vt][tt][1] * acc[vt][tt][1]) + (acc[vt][tt][2] * acc[vt][tt][2] + acc[vt][tt][3] * acc[vt][tt][3]);
        q += __shfl_xor(q, 16); q += __shfl_xor(q, 32);
        if (g == 0) lds_addf(hs + t, q); }
    __syncthreads();
#pragma unroll
    for (int tt = 0; tt < 4; ++tt) { const int t = 16 * tt + li; const float idd = 1.0f / dd[tt]; const float tot = idd * rsqrtf(hs[t] * idd * idd * (1.0f / DV) + EPS);
        const size_t row = row0 + t;
#pragma unroll
        for (int vt = 0; vt < 4; ++vt) { const int dvg = h * DV + 64 * wid + 16 * vt + 4 * g;
            const u32x2 omw = *(const u32x2*)(Z + row * NZ + ZOM + dvg); const f32x4 gg = *(const f32x4*)(mhg + dvg);
            const float o0 = bf_lo(omw.x), o1 = bf_hi(omw.x), o2 = bf_lo(omw.y), o3 = bf_hi(omw.y);
            const f32x4 a4 = acc[vt][tt];
            if (HRAW) *(f32x4*)(HRAW + row * 3072 + dvg) = a4 * idd;
            const float y0 = a4[0] * tot * gg[0] / (1.0f + __expf(-o0)), y1 = a4[1] * tot * gg[1] / (1.0f + __expf(-o1)), y2 = a4[2] * tot * gg[2] / (1.0f + __expf(-o2)), y3 = a4[3] * tot * gg[3] / (1.0f + __expf(-o3));
            u32x2 w; w.x = cvt_pk_bf16(y0, y1); w.y = cvt_pk_bf16(y2, y3); *(u32x2*)(MIX + row * DM + 1024 + dvg) = w; } }
    __syncthreads();
}


struct Args { const float* in[16]; float* out; unsigned char* ws; };
#if CHECKS
__device__ __forceinline__ unsigned hsh(unsigned x) { x ^= x >> 16; x *= 0x7feb352dU; x ^= x >> 15; x *= 0x846ca68bU; x ^= x >> 16; return x; }
__device__ __forceinline__ bool far_(float got, float ref, float rel, float ab) { return !(fabsf(got - ref) <= rel * fabsf(ref) + ab); }
#define CHK_FAIL(id) atomicMax(ctl + CW_ERR, 40u - (unsigned)(id))
#define CHK_CODE(cd) atomicMax(ctl + CW_ERR, (unsigned)(cd))
__device__ __forceinline__ float dot_bf(const bf16_t* a, const bf16_t* b, int n) { float s = 0.f; for (int k = 0; k < n; k += 8) { const u32x4 x = *(const u32x4*)(a + k), y = *(const u32x4*)(b + k);
        s += bf_lo(x.x) * bf_lo(y.x) + bf_hi(x.x) * bf_hi(y.x) + bf_lo(x.y) * bf_lo(y.y) + bf_hi(x.y) * bf_hi(y.y) + bf_lo(x.z) * bf_lo(y.z) + bf_hi(x.z) * bf_hi(y.z) + bf_lo(x.w) * bf_lo(y.w) + bf_hi(x.w) * bf_hi(y.w); } return s; }
__device__ __forceinline__ float softcap_(float a) { return 15.0f * tanhf(a * (1.0f / 15.0f)); }
__device__ __forceinline__ float logsig_(float a) { return fminf(a, 0.f) - log1pf(expf(-fabsf(a))); }
__device__ void run_checks(const Args& args, LAS unsigned char* lds) {
    const int tid = threadIdx.x, lane = tid & 63, wid = tid >> 6, bx = blockIdx.x, G = gridDim.x;
    const unsigned gt = (unsigned)bx * 512u + tid, ngt = (unsigned)G * 512u;
    unsigned char* ws = args.ws; unsigned* ctl = (unsigned*)(ws + WS_CTL); float* out = args.out;
    const float* x_prompt = args.in[0]; const float* x_sample = args.in[1]; const float* cache_k = args.in[2]; const float* cache_v = args.in[3]; const float* state_C = args.in[4]; const float* state_n = args.in[5]; const float* state_m = args.in[6];
    const float* norm1_g = args.in[7]; const float* w_in = args.in[8]; const float* b_if = args.in[9]; const float* mh_g = args.in[10];
    const float* w_out = args.in[11]; const float* norm2_g = args.in[12]; const float* w_up = args.in[13]; const float* w_down = args.in[14]; const float* final_g = args.in[15];
    const bf16_t* WinT = (bf16_t*)(ws + WS_WIN); const bf16_t* WoutT = (bf16_t*)(ws + WS_WOUT); const bf16_t* WupT = (bf16_t*)(ws + WS_WUP); const bf16_t* WdnT = (bf16_t*)(ws + WS_WDN);
    const bf16_t* XN = (bf16_t*)(ws + WS_XN); const bf16_t* Z = (bf16_t*)(ws + WS_Z); const bf16_t* MIX = (bf16_t*)(ws + WS_MIX); const float* H = (float*)(ws + WS_H); const bf16_t* HB = (bf16_t*)(ws + WS_HB);
    const bf16_t* U = (bf16_t*)(ws + WS_U); const bf16_t* WG = (bf16_t*)(ws + WS_WG); const float* GT = (float*)(ws + WS_G); const float* HRAW = (float*)(ws + WS_HRAW);
    const float* RSS2 = (float*)(ws + WS_CTL + CTL_RSS2); const float* RSS3 = (float*)(ws + WS_CTL + CTL_RSS3);
    for (unsigned s = gt; s < 2048u; s += ngt) { const int row = (s < 64u) ? MP + (int)(s & 31u) : (int)(hsh(s) % MT), k = (int)(hsh(s + 99991u) % DM);
        const float* xr = row < MP ? x_prompt + (size_t)row * DM : x_sample + (size_t)(row - MP) * DM; float ss = 0.f; for (int j = 0; j < DM; ++j) ss += xr[j] * xr[j];
        const float ref = xr[k] * rsqrtf(ss * (1.0f / DM) + EPS) * norm1_g[k]; if (far_(bf1(XN[(size_t)row * DM + k]), ref, 0.01f, 1e-3f)) CHK_FAIL(1); }
    for (unsigned s = gt; s < 4096u; s += ngt) { const unsigned a = hsh(s), b = hsh(s + 7777u);
        { const int n = a % NZ, k = b % DM; if (far_(bf1(WinT[(size_t)n * DM + k]), w_in[(size_t)k * NINF + n], 0.01f, 1e-7f)) CHK_FAIL(2); }
        { const int n = a % DM, k = b % DM; if (far_(bf1(WoutT[(size_t)n * DM + k]), w_out[(size_t)k * DM + n], 0.01f, 1e-7f)) CHK_FAIL(2); }
        { const int f = a % DFF, k = b % DM; if (far_(bf1(WupT[(size_t)f * DM + k]), w_up[(size_t)k * DFF + f] * norm2_g[k], 0.01f, 1e-7f)) CHK_FAIL(2); }
        { const int n = a % DM, f = b % DFF; if (far_(bf1(WdnT[(size_t)n * DFF + f]), w_down[(size_t)f * DM + n], 0.01f, 1e-7f)) CHK_FAIL(2); }
        { const int gi = a % 16, k = b % DM; const float ref = gi < 12 ? w_in[(size_t)k * NINF + NZ + gi] : 0.f; if (far_(bf1(WG[gi * DM + k]), ref, 0.01f, 1e-7f)) CHK_FAIL(2); } }
    for (unsigned s = gt; s < 8192u; s += ngt) { const int row = (s < 1024u) ? MP + (int)(s & 31u) : (int)(hsh(s) % MP), col = (int)(hsh(s + 12345u) % NZ); const int id = row < MP ? 3 : 4;
        const bf16_t* xr = XN + (size_t)row * DM; float val;
        if (col < 2048) { const int d = col & 127, c1 = (d < 64) ? col : col - 64, c2 = c1 + 64; const float x1 = dot_bf(xr, WinT + (size_t)c1 * DM, DM), x2 = dot_bf(xr, WinT + (size_t)c2 * DM, DM);
            const int pos = row < MP ? (row & (SEQ - 1)) : 8192, i = d & 63; double invd = 1.0; for (int e = 0; e < i; ++e) invd *= 0.86596432336006535;
            float c, sn; sincos_d((float)pos * (float)invd, c, sn); val = (d < 64) ? x1 * c - x2 * sn : x2 * c + x1 * sn; if (col < 1024) val *= 0.08838834764831845f; }
        else { val = dot_bf(xr, WinT + (size_t)col * DM, DM); if (col >= ZQM && col < ZKM) val *= 0.0625f; }
        if (far_(bf1(Z[(size_t)row * NZ + col]), val, 0.02f, 0.02f)) CHK_FAIL(id);
        if (col >= 1024 && col < 3072) { const int cc = col & 1023; const bool isk = col < 2048;
            if (row >= MP) { if (far_(out[(isk ? O_KS : O_VS) + (size_t)(row - MP) * 1024 + cc], val, 0.01f, 0.01f)) CHK_FAIL(id); }
            else { const int pos = row & (SEQ - 1), bb = row >> 12; if (pos >= 2048) { if (far_(out[(isk ? O_KP : O_VP) + ((size_t)(bb * 2048 + pos - 2048)) * 1024 + cc], val, 0.01f, 0.01f)) CHK_FAIL(id); } } } }
    for (unsigned s = gt; s < 4096u; s += ngt) { const int gi = (int)(hsh(s) % 12), tok = (s < 256u) ? MP + (int)(s & 31u) : (int)(hsh(s + 555u) % MT);
        float v = softcap_(dot_bf(XN + (size_t)tok * DM, WG + (size_t)gi * DM, DM) + b_if[gi]); if (gi >= 6) v = logsig_(v);
        if (far_(GT[(size_t)gi * MT + tok], v, 0.01f, 0.005f)) CHK_FAIL(5); }
    for (unsigned s = gt; s < 4096u; s += ngt) { const unsigned a = hsh(s), b2 = hsh(s + 424242u); const int b = a & 1, pos = (s & 3u) == 0u ? (int)((a >> 1) % 300u) : (int)((a >> 1) % SEQ), h = b2 & 7, d = (b2 >> 3) & 127;
        const bf16_t* zb = Z + (size_t)b * SEQ * NZ; const bf16_t* qr = zb + (size_t)pos * NZ + ZQA + h * 128; float m = -INFINITY, l = 0.f, o = 0.f;
        for (int cfg = 0; cfg < 3; ++cfg) { const int r = cfg == 0 ? 1 : cfg == 1 ? 4 : 16;
            for (int j = 0; j <= 128; ++j) { const int kp = pos - j * r; if (kp < 0) break; const float sc = dot_bf(qr, zb + (size_t)kp * NZ + ZKA + h * 128, 128);
                const float mn = fmaxf(m, sc), al = expf(m - mn), p = expf(sc - mn); l = l * al + p; o = o * al + p * bf1(zb[(size_t)kp * NZ + ZVA + h * 128 + d]); m = mn; } }
        if (far_(bf1(MIX[((size_t)b * SEQ + pos) * DM + h * 128 + d]), o / l, 0.03f, 0.004f)) CHK_FAIL(6); }
    if (bx == 30) { const int li = lane & 15, g = lane >> 4, dvt = wid & 3, dkh = wid >> 2; LAS unsigned char* Kimg = lds + SC_KIMG; LAS unsigned char* Vimg = lds + SC_VIMG;
#pragma unroll
        for (int q = 0; q < 4; ++q) { const int ch = tid + 512 * q, tok = ch >> 5, c16 = ch & 31; *(LAS u32x4*)(Kimg + tok * SC_KSTR + 16 * c16) = *(const u32x4*)(Z + (size_t)tok * NZ + ZKM + 8 * c16); }
        { const int tok = tid >> 3, c16 = tid & 7; *(LAS u32x4*)(Vimg + tok * SC_VSTR + 16 * c16) = *(const u32x4*)(Z + (size_t)tok * NZ + ZVM + 8 * c16); }
        __syncthreads();
        bf16x8 ones;
#pragma unroll
        for (int e = 0; e < 8; ++e) ones[e] = (short)0x3F80;
        unsigned mask = 0u;
#pragma unroll 1
        for (int T = 0; T < 8; ++T) { f32x4 na = (f32x4){0.f, 0.f, 0.f, 0.f}, ca = (f32x4){0.f, 0.f, 0.f, 0.f};
#pragma unroll
            for (int kb = 0; kb < 2; ++kb) { const LAS unsigned char* vp = Vimg + (32 * kb + 8 * g + (li >> 2)) * SC_VSTR + (16 * dvt + 4 * (li & 3)) * 2; const bf16x8 Bf = cat8(vtr(vp), vtr(vp + 4 * SC_VSTR));
                const LAS unsigned char* kp = Kimg + (32 * kb + 8 * g + (li >> 2)) * SC_KSTR + (128 * dkh + 16 * T + 4 * (li & 3)) * 2; const bf16x8 Af = cat8(vtr(kp), vtr(kp + 4 * SC_KSTR));
                na = __builtin_amdgcn_mfma_f32_16x16x32_bf16(Af, ones, na, 0, 0, 0); ca = __builtin_amdgcn_mfma_f32_16x16x32_bf16(Af, Bf, ca, 0, 0, 0); }
#pragma unroll
            for (int r = 0; r < 4; ++r) { const int dk = 128 * dkh + 16 * T + 4 * g + r, dv = 16 * dvt + li; float cs = 0.f, cv = 0.f;
                for (int t = 0; t < 64; ++t) { const float kk = bf1(Z[(size_t)t * NZ + ZKM + dk]); cs += kk; cv += kk * bf1(Z[(size_t)t * NZ + ZVM + dv]); }
                if (far_(na[r], cs, 0.01f, 1e-2f)) mask |= 1u; if (far_(ca[r], cv, 0.01f, 2e-2f)) mask |= 2u; } }
        if (mask) atomicOr(ctl + CW_ERR + 2, mask);
        __syncthreads(); }
    if (gt < 12u) { const int bh = (int)gt, b = bh / NH, h = bh % NH; const float* TBc = (const float*)(ws + WS_TB); const float* TWVc = (const float*)(ws + WS_TWV); const float* TMTc = (const float*)(ws + WS_TMT); const float* CMc = (const float*)(ws + WS_CM);
        float m = 0.f, bsum = 0.f; bool bad = false;
        for (int t = 0; t < SEQ; ++t) { const size_t row = (size_t)b * SEQ + t; const float liv = GT[(size_t)h * MT + row], lf = GT[(size_t)(6 + h) * MT + row];
            if ((t & 63) == 0) { bsum = 0.f; if (far_(CMc[bh * 80 + (t >> 6)], m, 1e-3f, 1e-3f)) bad = true; }
            bsum += lf; m = fmaxf(lf + m, liv);
            if (far_(TBc[bh * SEQ + t], bsum, 1e-3f, 1e-3f) || far_(TWVc[bh * SEQ + t], liv - bsum, 1e-3f, 1e-3f) || far_(TMTc[bh * SEQ + t], m, 1e-3f, 1e-3f)) bad = true; }
        if (far_(CMc[bh * 80 + 64], m, 1e-3f, 1e-3f)) bad = true;
        if (bad) CHK_CODE(33); }
    if (bx < 24) { const int bh = bx % 12, b = bh / NH, h = bh % NH, sel = tid >> 8, dk = tid & 255; const int dv = sel ? (300 + 17 * bx) % DV : (37 + 41 * bx) % DV;
        LAS float* red = (LAS float*)lds;
        float C = 0.f, n = 0.f, m = 0.f, n63 = 0.f, C63 = 0.f; bool bad8 = false;
        for (int t = 0; t < SEQ; ++t) { const size_t row = (size_t)b * SEQ + t; const bf16_t* zr = Z + row * NZ; if (t == 63 * 64) { n63 = n; C63 = C; }
            const float q = bf1(zr[ZQM + h * DK + dk]), k = bf1(zr[ZKM + h * DK + dk]), v = bf1(zr[ZVM + h * DV + dv]), liv = GT[(size_t)h * MT + row], lf = GT[(size_t)(6 + h) * MT + row];
            const float mn = fmaxf(lf + m, liv), f = expf(lf + m - mn), iw = expf(liv - mn); C = f * C + iw * k * v; n = f * n + iw * k; m = mn;
            const float s1 = wave_sum(q * C), s2 = wave_sum(q * n); LAS float* rb = red + (t & 1) * 32;
            if (lane == 0) { rb[wid] = s1; rb[16 + wid] = s2; }
            __syncthreads();
            const int w0 = sel * 4; const float num = rb[w0] + rb[w0 + 1] + rb[w0 + 2] + rb[w0 + 3], qn = rb[16 + w0] + rb[16 + w0 + 1] + rb[16 + w0 + 2] + rb[16 + w0 + 3];
            const float hv = num / fmaxf(fabsf(qn), expf(-m));
            if (dk == 0 && far_(HRAW[row * 3072 + h * DV + dv], hv, 0.04f, 0.03f)) bad8 = true; }
        if (far_(out[O_CP + ((size_t)bh * DK + dk) * DV + dv], C, 0.03f, 0.03f)) CHK_CODE(30);
        if (sel == 0 && far_(out[O_NP + (size_t)bh * DK + dk], n, 0.03f, 0.03f)) CHK_CODE(31);
        if (sel == 0 && far_(((const float*)(ws + WS_NC))[(size_t)(bh * NCH + 63) * DK + dk], n63, 0.03f, 0.03f)) CHK_CODE(31);
        if (far_(bf1(((const bf16_t*)(ws + WS_CT))[((size_t)(bh * NCH + 63) * DV + dv) * DK + dk]), C63, 0.03f, 0.03f)) CHK_CODE(30);
        if (tid == 0 && far_(out[O_MP + bh], m, 0.01f, 0.01f)) CHK_CODE(32);
        if (bad8) CHK_CODE(29);
        __syncthreads(); }
    for (unsigned s = gt; s < 4096u; s += ngt) { const unsigned a = hsh(s), b2 = hsh(s + 31337u); const int row = (s < 128u) ? MP + (int)(s & 31u) : (int)(a % MP), h = b2 % NH, dv = (b2 >> 8) % DV;
        const float* hr = HRAW + (size_t)row * 3072 + h * DV; float ss = 0.f; for (int j = 0; j < DV; ++j) ss += hr[j] * hr[j];
        const float om = bf1(Z[(size_t)row * NZ + ZOM + h * DV + dv]); const float ref = hr[dv] * rsqrtf(ss * (1.0f / DV) + EPS) * mh_g[h * DV + dv] / (1.0f + expf(-om));
        if (far_(bf1(MIX[(size_t)row * DM + 1024 + h * DV + dv]), ref, 0.02f, 0.005f)) CHK_CODE(28); }
    for (unsigned s = gt; s < 2048u; s += ngt) { const unsigned a = hsh(s); const int b = a & 31, h = (a >> 5) & 7, d = (a >> 8) & 127;
        const bf16_t* qr = Z + (size_t)(MP + b) * NZ + ZQA + h * 128; float m = -INFINITY, l = 0.f, o = 0.f;
        for (int cfg = 0; cfg < 3; ++cfg) { const int r = cfg == 0 ? 1 : cfg == 1 ? 4 : 16;
            for (int j = 0; j <= 128; ++j) { const int dist = j * r; const float* kp = dist == 0 ? out + O_KS + (size_t)b * 1024 + h * 128 : cache_k + ((size_t)b * 2048 + 2048 - dist) * 1024 + h * 128;
                const float* vp = dist == 0 ? out + O_VS + (size_t)b * 1024 + h * 128 : cache_v + ((size_t)b * 2048 + 2048 - dist) * 1024 + h * 128;
                float sc = 0.f; for (int e = 0; e < 128; ++e) sc += bf1(qr[e]) * kp[e];
                const float mn = fmaxf(m, sc), al = expf(m - mn), p = expf(sc - mn); l = l * al + p; o = o * al + p * vp[d]; m = mn; } }
        if (far_(bf1(MIX[(size_t)(MP + b) * DM + h * 128 + d]), o / l, 0.02f, 0.004f)) CHK_CODE(27); }
    for (unsigned s = gt; s < 2048u; s += ngt) { const unsigned a = hsh(s), b2 = hsh(s + 99u); const int b = a & 31, h = (a >> 5) % NH, dv = (a >> 9) % DV, dkx = b2 % DK; const int row = MP + b; const bf16_t* zr = Z + (size_t)row * NZ;
        const float liv = GT[(size_t)h * MT + row], lf = GT[(size_t)(6 + h) * MT + row], m0 = state_m[b * NH + h]; const float mt = fmaxf(lf + m0, liv), aa = expf(lf + m0 - mt), wsv = expf(liv - mt);
        const float* c0 = state_C + (size_t)(b * NH + h) * DK * DV; const float* n0 = state_n + (size_t)(b * NH + h) * DK; float qk = 0.f, qn = 0.f, qc = 0.f;
        for (int k = 0; k < DK; ++k) { const float q = bf1(zr[ZQM + h * DK + k]); qk += q * bf1(zr[ZKM + h * DK + k]); qn += q * n0[k]; qc += q * c0[(size_t)k * DV + dv]; }
        const float v = bf1(zr[ZVM + h * DV + dv]), sw = qk * wsv, num = sw * v + aa * qc, den = sw + aa * qn, hv = num / fmaxf(fabsf(den), expf(-mt));
        if (far_(HRAW[(size_t)row * 3072 + h * DV + dv], hv, 0.02f, 0.005f)) CHK_CODE(26);
        const float kx = bf1(zr[ZKM + h * DK + dkx]);
        if (far_(out[O_CS + ((size_t)(b * NH + h) * DK + dkx) * DV + dv], aa * c0[(size_t)dkx * DV + dv] + wsv * kx * v, 1e-3f, 1e-5f)) CHK_CODE(26);
        if (far_(out[O_NS + (size_t)(b * NH + h) * DK + dkx], aa * n0[dkx] + wsv * kx, 1e-3f, 1e-5f)) CHK_CODE(26);
        if (far_(out[O_MS + b * NH + h], mt, 1e-4f, 1e-5f)) CHK_CODE(26); }
    for (unsigned s = gt; s < 4096u; s += ngt) { const int row = (s < 256u) ? MP + (int)(s & 31u) : (int)(hsh(s) % MP), col = (int)(hsh(s + 777u) % DM);
        const float xv = row < MP ? x_prompt[(size_t)row * DM + col] : x_sample[(size_t)(row - MP) * DM + col]; const float ref = xv + dot_bf(MIX + (size_t)row * DM, WoutT + (size_t)col * DM, DM);
        if (far_(H[(size_t)row * DM + col], ref, 0.01f, 0.01f)) CHK_CODE(25); if (far_(bf1(HB[(size_t)row * DM + col]), ref, 0.01f, 0.01f)) CHK_CODE(25);
        if (s < 512u) { float ss = 0.f; for (int j = 0; j < DM; ++j) { const float hv = H[(size_t)row * DM + j]; ss += hv * hv; } if (far_(RSS2[row], ss, 2e-3f, 1e-2f)) CHK_CODE(25); } }
    for (unsigned s = gt; s < 4096u; s += ngt) { const int row = (s < 256u) ? MP + (int)(s & 31u) : (int)(hsh(s) % MP), f = (int)(hsh(s + 4242u) % DFF);
        const float r = rsqrtf(RSS2[row] * (1.0f / DM) + EPS); float v = fmaxf(r * dot_bf(HB + (size_t)row * DM, WupT + (size_t)f * DM, DM), 0.f); v = v * v;
        if (far_(bf1(U[(size_t)row * DFF + f]), v, 0.03f, 0.01f)) CHK_CODE(24); }
    for (unsigned s = gt; s < 2048u; s += ngt) { const int row = (s < 128u) ? MP + (int)(s & 31u) : (int)(hsh(s) % MP), col = (int)(hsh(s + 9u) % DM);
        const float pre = H[(size_t)row * DM + col] + dot_bf(U + (size_t)row * DFF, WdnT + (size_t)col * DFF, DFF);
        if (row < MP) { const float ref = pre * rsqrtf(RSS3[row] * (1.0f / DM) + EPS) * final_g[col]; if (!(row == 0 && col == 0) && far_(out[O_Y + (size_t)row * DM + col], ref, 0.02f, 0.01f)) CHK_CODE(23); }
        else { const int col2 = (col + 1234) % DM; const float pre2 = H[(size_t)row * DM + col2] + dot_bf(U + (size_t)row * DFF, WdnT + (size_t)col2 * DFF, DFF);
            const float y1 = out[O_Y + (size_t)row * DM + col] / final_g[col], y2 = out[O_Y + (size_t)row * DM + col2] / final_g[col2];
            if (far_(y1 * pre2, y2 * pre, 0.04f, 0.03f)) CHK_CODE(23); } }
}
#endif

__global__ void __launch_bounds__(512, 2) hymba_fwd(Args args) {
    extern __shared__ __attribute__((aligned(16))) unsigned char lds_raw[];
    LAS unsigned char* lds = (LAS unsigned char*)lds_raw;
    const int tid = threadIdx.x, lane = tid & 63, wid = __builtin_amdgcn_readfirstlane(tid >> 6);
    const int G = gridDim.x, bx = blockIdx.x, vcu = (G % 8 == 0) ? (bx % 8) * (G / 8) + bx / 8 : bx;
    unsigned char* ws = args.ws;
    unsigned* ctl = (unsigned*)(ws + WS_CTL);
    volatile LAS unsigned* MISC = (volatile LAS unsigned*)(lds + MISC_OFF);
    if (tid < 64) MISC[tid] = 0u;
    __syncthreads();
    XcdBarrier bar = xcd_barrier_post(ctl + CW_BAR, MISC + 8);

    const float* x_prompt = args.in[0]; const float* x_sample = args.in[1];
    const float* norm1_g = args.in[7]; const float* w_in = args.in[8]; const float* b_if = args.in[9];
    const float* w_out = args.in[11]; const float* norm2_g = args.in[12]; const float* w_up = args.in[13]; const float* w_down = args.in[14]; const float* final_g = args.in[15];
    float* out = args.out;
    bf16_t* WinT = (bf16_t*)(ws + WS_WIN); bf16_t* WoutT = (bf16_t*)(ws + WS_WOUT); bf16_t* WupT = (bf16_t*)(ws + WS_WUP); bf16_t* WdnT = (bf16_t*)(ws + WS_WDN);
    bf16_t* XN = (bf16_t*)(ws + WS_XN); bf16_t* Z = (bf16_t*)(ws + WS_Z); bf16_t* MIX = (bf16_t*)(ws + WS_MIX); float* H = (float*)(ws + WS_H); bf16_t* HB = (bf16_t*)(ws + WS_HB);
    bf16_t* U = (bf16_t*)(ws + WS_U); bf16_t* WG = (bf16_t*)(ws + WS_WG); float* ROPE = (float*)(ws + WS_ROPE); float* GT = (float*)(ws + WS_G);
    float* RSS2 = (float*)(ws + WS_CTL + CTL_RSS2); float* RSS3 = (float*)(ws + WS_CTL + CTL_RSS3); float* ACCB = (float*)(ws + WS_CTL + CTL_ACC);

    { P0Args a{x_prompt, x_sample, norm1_g, w_in, w_out, norm2_g, w_up, w_down, WinT, WoutT, WupT, WdnT, XN, WG, ROPE};
      p0_prologue(a, vcu, G, wid, lane); }
    xcd_barrier(bar);

    { pg8::Gemm g{XN, WinT, MP, NZ, DM}; pg8::StaticOrder S; S.init(MP, NZ, G, bx);
      EpiInProj E{Z, ROPE, out + O_KP, out + O_VP};
      pg8::gemm_phase<EpiInProj>(lds, g, S, E);
      SkInProj Es{Z, ROPE, out + O_KS, out + O_VS};
      for (int u = bx; u < 48; u += G) skinny_unit<2>(lds, XN + (size_t)MP * DM, WinT, DM, 0, DM, Es, u);
      SkGates Eg{b_if, GT};
      for (int u = bx - 48; u < 33; u += G) if (u >= 0) skinny_unit<1>(lds, WG, XN, DM, 0, DM, Eg, u);
    }
    xcd_barrier(bar);

    bf16_t* CT = (bf16_t*)(ws + WS_CT); float* NC = (float*)(ws + WS_NC); float* TB = (float*)(ws + WS_TB); float* TWV = (float*)(ws + WS_TWV); float* TMT = (float*)(ws + WS_TMT); float* CMb = (float*)(ws + WS_CM);
    float* HRAW = CHECKS ? (float*)(ws + WS_HRAW) : nullptr;
    const float* cache_k = args.in[2]; const float* cache_v = args.in[3]; const float* state_C = args.in[4]; const float* state_n = args.in[5]; const float* state_m = args.in[6]; const float* mh_g = args.in[10];

    { if (bx < 96) mlstm_scan(lds, Z, GT, CT, NC, TB, TWV, TMT, CMb, out, bx);
      for (;;) {
          if (tid == 0) MISC[16] = atomicAdd(&ctl[CW_Q2], 1u);
          __syncthreads();
          const unsigned item = MISC[16];
          __syncthreads();
          if (item >= 704u) break;
          if (item < 192u) smlstm_unit(lds, Z, GT, state_C, state_n, state_m, mh_g, out, MIX, HRAW, (int)item);
          else if (item < 448u) attn_unit(lds, Z, MIX, (int)item - 192);
          else sattn_unit(lds, Z, cache_k, cache_v, out, MIX, (int)item - 448);
      } }
    xcd_barrier(bar);

    for (int u = bx; u < 12 * NCH; u += G) mlstm_out(lds, Z, CT, NC, TB, TWV, TMT, CMb, mh_g, MIX, HRAW, u);
    xcd_barrier(bar);

    { pg8::Gemm g{MIX, WoutT, MP, DM, DM}; pg8::StaticOrder S; S.init(MP, DM, G, bx);
      EpiOutProj E{x_prompt, H, HB, RSS2};
      pg8::gemm_phase<EpiOutProj>(lds, g, S, E);
      SkOutProj Es{x_sample, H, HB, RSS2};
      for (int u = bx; u < 16; u += G) skinny_unit<2>(lds, MIX + (size_t)MP * DM, WoutT, DM, 0, DM, Es, u); }
    xcd_barrier(bar);

    { pg8::Gemm g{HB, WupT, MP, DFF, DM}; pg8::StaticOrder S; S.init(MP, DFF, G, bx);
      EpiUp E{U, RSS2};
      pg8::gemm_phase<EpiUp>(lds, g, S, E);
      SkUp Es{U, RSS2};
      for (int u = bx; u < 64; u += G) skinny_unit<2>(lds, HB + (size_t)MP * DM, WupT, DM, 0, DM, Es, u); }
    xcd_barrier(bar);

    { pg8::Gemm g{U, WdnT, MP, DM, DFF}; pg8::StaticOrder S; S.init(MP, DM, G, bx);
      EpiDown E{H, out + O_Y, RSS3};
      pg8::gemm_phase<EpiDown>(lds, g, S, E);
      SkDown Es{ACCB};
      for (int u = bx; u < 256; u += G) skinny_unit<2>(lds, U + (size_t)MP * DFF, WdnT, DFF, 1024 * (u >> 4), 1024 * (u >> 4) + 1024, Es, u); }
    xcd_barrier(bar);

    { const int gw = vcu * 8 + wid, ngw = G * 8;
      for (int m = gw; m < MT; m += ngw) {
          float* yr = out + O_Y + (size_t)m * DM; f32x4 v[8][2]; float r;
          if (m < MP) {
#pragma unroll
              for (int c = 0; c < 8; ++c) { v[c][0] = *(const f32x4*)(yr + 512 * c + 8 * lane); v[c][1] = *(const f32x4*)(yr + 512 * c + 8 * lane + 4); }
              r = rsqrtf(RSS3[m] * (1.0f / DM) + EPS);
          } else { const float* hr = H + (size_t)m * DM; const float* ar = ACCB + (size_t)(m - MP) * DM; float ss = 0.f;
#pragma unroll
              for (int c = 0; c < 8; ++c) { v[c][0] = *(const f32x4*)(hr + 512 * c + 8 * lane) + *(const f32x4*)(ar + 512 * c + 8 * lane); v[c][1] = *(const f32x4*)(hr + 512 * c + 8 * lane + 4) + *(const f32x4*)(ar + 512 * c + 8 * lane + 4);
                  ss += (v[c][0][0] * v[c][0][0] + v[c][0][1] * v[c][0][1]) + (v[c][0][2] * v[c][0][2] + v[c][0][3] * v[c][0][3]) + (v[c][1][0] * v[c][1][0] + v[c][1][1] * v[c][1][1]) + (v[c][1][2] * v[c][1][2] + v[c][1][3] * v[c][1][3]); }
              r = rsqrtf(wave_sum(ss) * (1.0f / DM) + EPS); }
#pragma unroll
          for (int c = 0; c < 8; ++c) { const f32x4 g0 = *(const f32x4*)(final_g + 512 * c + 8 * lane), g1v = *(const f32x4*)(final_g + 512 * c + 8 * lane + 4);
              *(f32x4*)(yr + 512 * c + 8 * lane) = v[c][0] * r * g0; *(f32x4*)(yr + 512 * c + 8 * lane + 4) = v[c][1] * r * g1v; }
      } }
#if CHECKS
    xcd_barrier(bar);
    run_checks(args, lds);
    xcd_barrier(bar);
    if (bx == 0 && tid == 0) { const unsigned code = __hip_atomic_load(ctl + CW_ERR, __ATOMIC_RELAXED, __HIP_MEMORY_SCOPE_AGENT); const unsigned msk = __hip_atomic_load(ctl + CW_ERR + 2, __ATOMIC_RELAXED, __HIP_MEMORY_SCOPE_AGENT);
        if (msk) out[0] = (float)(60u + msk) * 10000.0f; else if (code) out[0] = (float)code * 10000.0f; }
#endif
}

extern "C" void kernel_launch(void* const* d_in, const int* in_sizes, int n_in, void* d_out, int out_size, void* d_ws, size_t ws_size, hipStream_t stream) {
    static int grid = 0;
    if (grid == 0) {
        if (n_in != 16 || out_size != (int)O_END || ws_size < WS_NEED) { fprintf(stderr, "kernel_launch: unexpected shapes (n_in %d, out %d, ws %zu)\n", n_in, out_size, ws_size); grid = -1; return; }
        int dev = 0, cus = 0, per_cu = 0;
        if (hipGetDevice(&dev) != hipSuccess || hipDeviceGetAttribute(&cus, hipDeviceAttributeMultiprocessorCount, dev) != hipSuccess) { grid = -1; return; }
        if (hipFuncSetAttribute((const void*)hymba_fwd, hipFuncAttributeMaxDynamicSharedMemorySize, LDS_BYTES) != hipSuccess) { fprintf(stderr, "kernel_launch: hipFuncSetAttribute failed\n"); grid = -1; return; }
        if (hipOccupancyMaxActiveBlocksPerMultiprocessor(&per_cu, (const void*)hymba_fwd, 512, LDS_BYTES) != hipSuccess || per_cu < 1) { fprintf(stderr, "kernel_launch: occupancy query says %d\n", per_cu); }
        (void)hipGetLastError();
        grid = cus;
    }
    if (grid < 0) return;
    (void)in_sizes;
    hipMemsetAsync((char*)d_ws + WS_CTL, 0, CTL_ZERO_BYTES, stream);
    Args a{};
    for (int i = 0; i < 16; ++i) a.in[i] = (const float*)d_in[i];
    a.out = (float*)d_out; a.ws = (unsigned char*)d_ws;
    hipLaunchKernelGGL(hymba_fwd, dim3(grid), dim3(512), LDS_BYTES, stream, a);
}
```

```cpp
#include <hip/hip_runtime.h>
#include <cstdio>
#include <cstdint>

#define LAS __attribute__((address_space(3)))
typedef unsigned short bf16_t;
typedef short bf16x8 __attribute__((ext_vector_type(8)));
typedef short s16x4 __attribute__((ext_vector_type(4)));
typedef float f32x4 __attribute__((ext_vector_type(4)));
typedef float f32x2 __attribute__((ext_vector_type(2)));
typedef unsigned u32x4 __attribute__((ext_vector_type(4)));
typedef unsigned u32x2 __attribute__((ext_vector_type(2)));

constexpr int DM = 4096, SEQ = 4096, NB = 2, MP = NB * SEQ  , MS = 32, MT = MP + MS  , MPAD = 8448;
constexpr int NZ = 12288, NINF = 12300, DFF = 16384;
constexpr int ZQA = 0, ZKA = 1024, ZVA = 2048, ZQM = 3072, ZKM = 4608, ZVM = 6144, ZOM = 9216;
constexpr int NH = 6, DK = 256, DV = 512, LCH = 64, NCH = 64;
constexpr float EPS = 1e-6f;
constexpr size_t O_Y = 0, O_KP = 33685504, O_VP = 37879808, O_CP = 42074112, O_NP = 43646976, O_MP = 43650048, O_KS = 43650060, O_VS = 43682828,
                 O_CS = 43715596, O_NS = 68881420, O_MS = 68930572, O_END = 68930764;

constexpr size_t MiB = 1u << 20;
constexpr size_t WS_CTL = 0, CTL_ZERO_BYTES = 1 * MiB;
constexpr int CW_BAR = 0;
constexpr int CW_Q2 = 4096;
constexpr size_t CTL_RSS2 = 64 * 1024, CTL_RSS3 = 128 * 1024, CTL_ACC = 512 * 1024;
constexpr size_t WS_ROPE = 2 * MiB;
constexpr size_t WS_WG = 5 * MiB;
constexpr size_t WS_G = 6 * MiB;
constexpr size_t WS_TB = 7 * MiB, WS_TWV = 7 * MiB + 256 * 1024, WS_TMT = 7 * MiB + 512 * 1024, WS_CM = 7 * MiB + 768 * 1024;
constexpr size_t WS_NC = 8 * MiB;
constexpr size_t WS_WIN = 16 * MiB, WS_WOUT = 112 * MiB, WS_WUP = 144 * MiB, WS_WDN = 272 * MiB;
constexpr size_t WS_XN = 400 * MiB, WS_Z = 466 * MiB, WS_MIX = 660 * MiB, WS_H = 726 * MiB, WS_HB = 855 * MiB, WS_CT = 921 * MiB, WS_END = 1114 * MiB;
#ifndef CHECKS
#define CHECKS 0
#endif
#ifndef PROF
#define PROF 0
#endif
constexpr size_t WS_U = CHECKS ? 1114 * MiB : 400 * MiB;
constexpr size_t WS_HRAW = 1380 * MiB;
constexpr size_t WS_NEED = CHECKS ? 1480 * MiB : WS_END;
constexpr int CW_ERR = 8192;
constexpr size_t WS_DBG = 1477 * MiB;

constexpr int LDS_BYTES = 153600, MISC_OFF = 153088;

__device__ __forceinline__ unsigned cvt_pk_bf16(float lo, float hi) { unsigned r; asm volatile("v_cvt_pk_bf16_f32 %0, %1, %2" : "=v"(r) : "v"(lo), "v"(hi)); return r; }
__device__ __forceinline__ float bf_lo(unsigned w) { return __uint_as_float(w << 16); }
__device__ __forceinline__ float bf_hi(unsigned w) { return __uint_as_float(w & 0xffff0000u); }
__device__ __forceinline__ float bf1(bf16_t b) { return __uint_as_float(((unsigned)b) << 16); }
__device__ __forceinline__ float wave_sum(float v) {
#pragma unroll
    for (int o = 1; o < 64; o <<= 1) v += __shfl_xor(v, o);
    return v;
}
__device__ __forceinline__ float wave_max(float v) {
#pragma unroll
    for (int o = 1; o < 64; o <<= 1) v = fmaxf(v, __shfl_xor(v, o));
    return v;
}
__device__ __forceinline__ void lds_addf(LAS float* p, float v) { (void)__hip_atomic_fetch_add(p, v, __ATOMIC_RELAXED, __HIP_MEMORY_SCOPE_WORKGROUP); }
typedef short v4i16_t __attribute__((ext_vector_type(4)));
__device__ __forceinline__ s16x4 vtr(const LAS unsigned char* p) { return __builtin_bit_cast(s16x4, __builtin_amdgcn_ds_read_tr16_b64_v4i16((LAS v4i16_t*)p)); }
__device__ __forceinline__ bf16x8 cat8(s16x4 a, s16x4 b) { bf16x8 r; r[0] = a[0]; r[1] = a[1]; r[2] = a[2]; r[3] = a[3]; r[4] = b[0]; r[5] = b[1]; r[6] = b[2]; r[7] = b[3]; return r; }

#define XB_TMO      128
#define XB_XCNT(j)  (256  + 64 * (j))
#define XB_XSUB(j)  (1280 + 64 * (j))
#define XB_XGEN(j)  (2304 + 64 * (j))
#define XB_TOP      3328
#define XB_TOPGEN   3392
#define XCD_BAR_WORDS 3456
#define XB_SPIN_CAP (1u << 18)
__device__ __forceinline__ unsigned xb_ld(unsigned* p)              { return __hip_atomic_load(p, __ATOMIC_RELAXED, __HIP_MEMORY_SCOPE_AGENT); }
__device__ __forceinline__ unsigned xb_add(unsigned* p, unsigned v) { return __hip_atomic_fetch_add(p, v, __ATOMIC_RELAXED, __HIP_MEMORY_SCOPE_AGENT); }
__device__ __forceinline__ unsigned xb_xcc_id() { return (unsigned)__builtin_amdgcn_s_getreg((3 << 11) | 20) & 0xFu; }
#define XB_SPIN(cond, bar) do { unsigned _sp = 0; while (cond) { __builtin_amdgcn_s_sleep(1); \
    if ((++_sp & 255u) == 0u) { if (xb_ld(&(bar)[XB_TMO])) break; if (_sp > XB_SPIN_CAP) { atomicAdd(&(bar)[XB_TMO], 1u); break; } } } } while (0)
struct XcdBarrier { unsigned* bar; unsigned x; volatile LAS unsigned* st; };
__device__ __forceinline__ XcdBarrier xcd_barrier_post(unsigned* bar, volatile LAS unsigned* st) {
    XcdBarrier b; b.bar = bar; b.x = xb_xcc_id(); b.st = st;
    if (threadIdx.x == 0) (void)xb_add(&bar[XB_XCNT(b.x)], 1u);
    return b;
}
__device__ __forceinline__ void xcd_barrier_complete(unsigned* bar, unsigned x, unsigned& nloc, unsigned& nx) {
    const unsigned G = gridDim.x * gridDim.y * gridDim.z;
    unsigned sum, cnt, mine, sp = 0u;
    for (;;) {
        sum = 0u; cnt = 0u; mine = 0u;
#pragma unroll
        for (unsigned j = 0; j < 16; ++j) { const unsigned c = xb_ld(&bar[XB_XCNT(j)]); sum += c; cnt += (c > 0u) ? 1u : 0u; mine = (j == x) ? c : mine; }
        if (sum == G) break;
        __builtin_amdgcn_s_sleep(1);
        if ((++sp & 255u) == 0u) { if (xb_ld(&bar[XB_TMO])) break; if (sp > XB_SPIN_CAP) { atomicAdd(&bar[XB_TMO], 1u); break; } }
    }
    nloc = mine > 0u ? mine : 1u; nx = cnt > 0u ? cnt : 1u;
}
__device__ __forceinline__ void xcd_barrier(const XcdBarrier& b) {
    asm volatile("s_waitcnt vmcnt(0)" ::: "memory");
    __syncthreads();
    if (threadIdx.x == 0) {
        unsigned* bar = b.bar;
        __builtin_amdgcn_s_waitcnt(0);
        unsigned nloc = b.st[0], nx = b.st[1];
        if (nloc == 0u) { xcd_barrier_complete(bar, b.x, nloc, nx); b.st[0] = nloc; b.st[1] = nx; }
        const unsigned old = xb_add(&bar[XB_XSUB(b.x)], 1u);
        const unsigned gen = old / nloc;
        if (old + 1u == (gen + 1u) * nloc) {
            __builtin_amdgcn_fence(__ATOMIC_RELEASE, "agent");
            asm volatile("s_waitcnt vmcnt(0)" ::: "memory");
            const unsigned og = xb_add(&bar[XB_TOP], 1u);
            const unsigned tg = og / nx;
            if (og + 1u == (tg + 1u) * nx) xb_add(&bar[XB_TOPGEN], 1u);
            else XB_SPIN(xb_ld(&bar[XB_TOPGEN]) == tg, bar);
            __builtin_amdgcn_fence(__ATOMIC_ACQUIRE, "agent");
            xb_add(&bar[XB_XGEN(b.x)], 1u);
            asm volatile("s_waitcnt vmcnt(0)" ::: "memory");
        } else {
            XB_SPIN(xb_ld(&bar[XB_XGEN(b.x)]) == gen, bar);
            __builtin_amdgcn_fence(__ATOMIC_ACQUIRE, "agent");
            asm volatile("s_waitcnt vmcnt(0)" ::: "memory");
        }
    }
    __syncthreads();
}

namespace pg8 {
constexpr int BM = 256, BK = 64, HALF = 128, HTB = HALF * BK * 2, STAGE_BYTES = 8 * HTB, NXCD = 8, WGM = 8;
__host__ __device__ __forceinline__ int lds_byte(int r, int c) { const int st = (r >> 4) * 2 + (c >> 5), rr = r & 15, cc = c & 31, ob = rr * 64 + cc * 2; return st * 1024 + (ob ^ (((ob >> 9) & 1) << 5)); }
__host__ __device__ __forceinline__ void stage_rc(int b, int& R, int& C) { const int st = b / 1024, sb = b % 1024, swz = sb ^ (((sb >> 9) & 1) << 5); R = (st >> 1) * 16 + swz / 64; C = (st & 1) * 32 + (swz % 64) / 2; }
__host__ __device__ __forceinline__ int perm32(int rho) { const int n = rho >> 4, i = rho & 15; return 8 * (i >> 2) + 4 * n + (i & 3); }
struct Unit { int pm, pn; };
struct Gemm { const bf16_t* A; const bf16_t* Bt; int M, N, K; };
struct StaticOrder {
    int nM, nN, nwg, G, c;
    __host__ __device__ void init(int M, int N, int G_, int c_) { nM = M / BM; nN = N / BM; nwg = nM * nN; G = G_; c = c_; }
    __host__ __device__ bool next(int i, Unit& u) const {
        const long L = (long)i * G + c; if (L >= nwg) return false;
        int wgid = (int)L; { const int q = nwg / NXCD, r = nwg % NXCD, xcd = wgid % NXCD, off = wgid / NXCD; wgid = (xcd < r ? xcd * (q + 1) : r * (q + 1) + (xcd - r) * q) + off; }
        const int nig = WGM * nN, gid = wgid / nig, fm = gid * WGM, gsz = (nM - fm) < WGM ? (nM - fm) : WGM;
        u.pm = fm + ((wgid % nig) % gsz); u.pn = (wgid % nig) / gsz; return true;
    }
};
struct InterleavedOrder { StaticOrder S;
    __host__ __device__ bool next(int i, Unit& u) const { if (!S.next(i, u)) return false; u.pn = 2 * (u.pn % 24) + u.pn / 24; return true; } };
template <int BMODE> __host__ __device__ __forceinline__ int bmap_row(int R) {
    if (BMODE == 0) return R;
    const int p = (R & ~31) + perm32(R & 31);
    if (BMODE == 1) return p;
    return (p >> 6) * 128 + (p & 63);
}
template <class Epi, class Sched = StaticOrder, bool ALIGN_EPI = true, bool SP2 = true>
__device__ __forceinline__ void gemm_phase(LAS unsigned char* lds, const Gemm g, const Sched& S, const Epi& E) {
    int tid = threadIdx.x; asm volatile("" : "+v"(tid)); const int wid = __builtin_amdgcn_readfirstlane(tid >> 6), lane = tid & 63, wr = wid >> 2, wc = wid & 3, fr = lane & 15, fq = lane >> 4;
    const int K = g.K, nt = K / BK;
    unsigned voffA[2], voffB[2];
#pragma unroll
    for (int i = 0; i < 2; ++i) { int R, C; stage_rc(tid * 16 + i * 8192, R, C); const int Rb = bmap_row<Epi::BMODE>(R);
        voffA[i] = (unsigned)(R * K + C) * 2u; voffB[i] = (unsigned)(Rb * K + C) * 2u; }
    const size_t kstep = (size_t)(BK * 2);
    const size_t hstep = (size_t)HALF * K * 2;
    const size_t hstepB = (size_t)(Epi::BMODE == 2 ? 64 : 128) * K * 2;
    const size_t tstep = 2 * hstep;
    const unsigned ldsw = (unsigned)wid * 1024u;
    const int aoff = lds_byte(wr * 64 + fr, fq * 8), boff = lds_byte(wc * 32 + fr, fq * 8);
#define PG8_SA(b, h) (((b) * 2 + (h)) * HTB)
#define PG8_SB(b, h) ((4 + (b) * 2 + (h)) * HTB)
#define PG8_STAGE(bufoff, gbase, voff) do { _Pragma("unroll") for (int _i = 0; _i < 2; ++_i) \
        __builtin_amdgcn_global_load_lds((const unsigned*)((const char*)(gbase) + (voff)[_i]), (LAS unsigned*)(lds + (bufoff) + ldsw + _i * 8192), 16, 0, 0); } while (0)
#define PG8_LDA(dst, b, h) do { _Pragma("unroll") for (int m = 0; m < 4; ++m) _Pragma("unroll") for (int k = 0; k < 2; ++k) dst[m][k] = *(const LAS bf16x8*)(lds + PG8_SA(b, h) + aoff + m * 2048 + k * 1024); } while (0)
#define PG8_LDB(dst, b, h) do { _Pragma("unroll") for (int n = 0; n < 2; ++n) _Pragma("unroll") for (int k = 0; k < 2; ++k) dst[n][k] = *(const LAS bf16x8*)(lds + PG8_SB(b, h) + boff + n * 2048 + k * 1024); } while (0)
#define PG8_MMA(ai, bj, At, Bt) do { __builtin_amdgcn_s_setprio(1); _Pragma("unroll") for (int m = 0; m < 4; ++m) _Pragma("unroll") for (int n = 0; n < 2; ++n) _Pragma("unroll") for (int k = 0; k < 2; ++k) \
        acc[ai][bj][m][n] = __builtin_amdgcn_mfma_f32_16x16x32_bf16(Bt[n][k], At[m][k], acc[ai][bj][m][n], 0, 0, 0); __builtin_amdgcn_s_setprio(0); } while (0)
#define PG8_WAIT_V(n) asm volatile("s_waitcnt vmcnt(" #n ")" ::: "memory")
#define PG8_WAIT_L(n) asm volatile("s_waitcnt lgkmcnt(" #n ")" ::: "memory")
#define PG8_BAR __builtin_amdgcn_s_barrier()
#define PG8_SCHED __builtin_amdgcn_sched_barrier(0)
    Unit cur, nxt; int ui = 0;
    if (!S.next(0, cur)) return;
    f32x4 acc[2][2][4][2];
#pragma unroll
    for (int a = 0; a < 2; ++a)
#pragma unroll
        for (int b = 0; b < 2; ++b)
#pragma unroll
            for (int m = 0; m < 4; ++m)
#pragma unroll
                for (int n = 0; n < 2; ++n) acc[a][b][m][n] = (f32x4){0.f, 0.f, 0.f, 0.f};
    bf16x8 At[4][2], B0[2][2], B1[2][2];
    const char* cA = (const char*)g.A + (size_t)cur.pm * tstep; const char* cB = (const char*)g.Bt + (size_t)cur.pn * tstep;
    if constexpr (SP2) {
        PG8_STAGE(PG8_SB(0, 0), cB, voffB); PG8_STAGE(PG8_SB(0, 1), cB + hstepB, voffB); PG8_STAGE(PG8_SA(0, 0), cA, voffA); PG8_STAGE(PG8_SA(0, 1), cA + hstep, voffA);
        if (wr == 1) PG8_BAR;
        PG8_WAIT_V(2); PG8_BAR;
        PG8_STAGE(PG8_SB(1, 0), cB + kstep, voffB); PG8_STAGE(PG8_SA(1, 0), cA + kstep, voffA); PG8_STAGE(PG8_SB(1, 1), cB + hstepB + kstep, voffB);
        PG8_WAIT_V(6); PG8_BAR;
    } else {
        PG8_STAGE(PG8_SB(0, 0), cB, voffB); PG8_STAGE(PG8_SA(0, 0), cA, voffA); PG8_STAGE(PG8_SB(0, 1), cB + hstepB, voffB); PG8_STAGE(PG8_SA(0, 1), cA + hstep, voffA);
        if (wr == 1) PG8_BAR;
        PG8_WAIT_V(4); PG8_BAR;
        PG8_STAGE(PG8_SB(1, 0), cB + kstep, voffB); PG8_STAGE(PG8_SA(1, 0), cA + kstep, voffA); PG8_STAGE(PG8_SB(1, 1), cB + hstepB + kstep, voffB);
        PG8_WAIT_V(6); PG8_BAR;
    }
    for (;;) {
        const bool has_next = S.next(ui + 1, nxt);
        const char* nA = has_next ? (const char*)g.A + (size_t)nxt.pm * tstep : cA; const char* nB = has_next ? (const char*)g.Bt + (size_t)nxt.pn * tstep : cB;
        for (int t = 0; t < nt; t += 2) {
            const bool last = (t == nt - 2);
            const char* a1 = cA + (size_t)(t + 1) * kstep;
            const char* a2 = last ? nA : cA + (size_t)(t + 2) * kstep; const char* b2 = last ? nB : cB + (size_t)(t + 2) * kstep;
            const char* a3 = a2 + kstep; const char* b3 = b2 + kstep;
            if constexpr (SP2) {
            PG8_LDB(B0, 0, 0); PG8_LDB(B1, 0, 1); PG8_SCHED; PG8_LDA(At, 0, 0); PG8_STAGE(PG8_SA(1, 1), a1 + hstep, voffA);
            PG8_WAIT_V(8); PG8_WAIT_L(0); PG8_BAR; PG8_MMA(0, 0, At, B0); PG8_MMA(0, 1, At, B1); PG8_BAR; PG8_SCHED;
            PG8_LDA(At, 0, 1); PG8_STAGE(PG8_SB(0, 0), b2, voffB); PG8_STAGE(PG8_SB(0, 1), b2 + hstepB, voffB); PG8_STAGE(PG8_SA(0, 0), a2, voffA);
            PG8_WAIT_V(8); PG8_WAIT_L(0); PG8_BAR; PG8_MMA(1, 0, At, B0); PG8_MMA(1, 1, At, B1); PG8_BAR; PG8_SCHED;
            PG8_LDB(B0, 1, 0); PG8_LDB(B1, 1, 1); PG8_SCHED; PG8_LDA(At, 1, 0); PG8_STAGE(PG8_SA(0, 1), a2 + hstep, voffA);
            PG8_WAIT_V(8); PG8_WAIT_L(0); PG8_BAR; PG8_MMA(0, 0, At, B0); PG8_MMA(0, 1, At, B1); PG8_BAR; PG8_SCHED;
            PG8_LDA(At, 1, 1); PG8_STAGE(PG8_SB(1, 0), b3, voffB); PG8_STAGE(PG8_SB(1, 1), b3 + hstepB, voffB); PG8_STAGE(PG8_SA(1, 0), a3, voffA);
            PG8_WAIT_V(8); PG8_WAIT_L(0); PG8_BAR; PG8_MMA(1, 0, At, B0); PG8_MMA(1, 1, At, B1); PG8_BAR; PG8_SCHED;
            } else {
            PG8_LDB(B0, 0, 0); PG8_SCHED; PG8_LDA(At, 0, 0); PG8_STAGE(PG8_SA(1, 1), a1 + hstep, voffA);
            PG8_WAIT_L(8); PG8_BAR; PG8_WAIT_L(0); PG8_MMA(0, 0, At, B0); PG8_BAR; PG8_SCHED;
            PG8_LDB(B1, 0, 1); PG8_STAGE(PG8_SB(0, 0), b2, voffB);
            PG8_BAR; PG8_WAIT_L(0); PG8_MMA(0, 1, At, B1); PG8_BAR;
            PG8_LDA(At, 0, 1); PG8_STAGE(PG8_SA(0, 0), a2, voffA);
            PG8_BAR; PG8_WAIT_L(0); PG8_MMA(1, 0, At, B0); PG8_BAR; PG8_SCHED;
            PG8_STAGE(PG8_SB(0, 1), b2 + hstepB, voffB);
            PG8_WAIT_V(6); PG8_BAR; PG8_MMA(1, 1, At, B1); PG8_BAR;
            PG8_LDB(B0, 1, 0); PG8_SCHED; PG8_LDA(At, 1, 0); PG8_STAGE(PG8_SA(0, 1), a2 + hstep, voffA);
            PG8_WAIT_L(8); PG8_BAR; PG8_WAIT_L(0); PG8_MMA(0, 0, At, B0); PG8_BAR; PG8_SCHED;
            PG8_LDB(B1, 1, 1); PG8_STAGE(PG8_SB(1, 0), b3, voffB);
            PG8_BAR; PG8_WAIT_L(0); PG8_MMA(0, 1, At, B1); PG8_BAR;
            PG8_LDA(At, 1, 1); PG8_STAGE(PG8_SA(1, 0), a3, voffA);
            PG8_BAR; PG8_WAIT_L(0); PG8_MMA(1, 0, At, B0); PG8_BAR; PG8_SCHED;
            PG8_STAGE(PG8_SB(1, 1), b3 + hstepB, voffB);
            PG8_WAIT_V(6); PG8_BAR; PG8_MMA(1, 1, At, B1); PG8_BAR;
            }
        }
        if constexpr (ALIGN_EPI) { if (wr == 0) PG8_BAR; }
        if constexpr (Epi::FUSED) E.fused(acc, cur, wr, wc, fr, fq, wid, lane); else E(acc, cur, wr, wc, fr, fq);
        if (!has_next) break;
#pragma unroll
        for (int a = 0; a < 2; ++a)
#pragma unroll
            for (int b = 0; b < 2; ++b)
#pragma unroll
                for (int m = 0; m < 4; ++m)
#pragma unroll
                    for (int n = 0; n < 2; ++n) acc[a][b][m][n] = (f32x4){0.f, 0.f, 0.f, 0.f};
        cur = nxt; cA = nA; cB = nB; ++ui;
        if constexpr (ALIGN_EPI) { if (wr == 1) PG8_BAR; }
    }
    PG8_WAIT_V(0);
    if constexpr (!ALIGN_EPI) { if (wr == 0) PG8_BAR; }
    PG8_BAR;
#undef PG8_SA
#undef PG8_SB
#undef PG8_STAGE
#undef PG8_LDA
#undef PG8_LDB
#undef PG8_MMA
#undef PG8_WAIT_V
#undef PG8_WAIT_L
#undef PG8_BAR
#undef PG8_SCHED
}
}

struct EpiInProj {
    static constexpr bool FUSED = false;
    static constexpr int BMODE = 2;
    bf16_t* Z; const float* rope; float* kout; float* vout;
    __device__ __forceinline__ void operator()(const f32x4 (&acc)[2][2][4][2], const pg8::Unit& u, int wr, int wc, int fr, int fq) const {
        const int pn = u.pn, hsel = wc >> 1, i0 = 32 * (wc & 1) + 8 * fq;
        const int colb = 256 * pn + 128 * hsel + i0;
#pragma unroll
        for (int ai = 0; ai < 2; ++ai)
#pragma unroll
            for (int m = 0; m < 4; ++m) {
                const int row = 256 * u.pm + 128 * ai + 64 * wr + 16 * m + fr;
                const int pos = row & (SEQ - 1), bb = row >> 12;
                f32x4 a0 = acc[ai][0][m][0], a1 = acc[ai][0][m][1], b0 = acc[ai][1][m][0], b1 = acc[ai][1][m][1];
                if (pn < 8) {
                    const float* rt = rope + (size_t)pos * 128 + i0;
                    const f32x4 c0 = *(const f32x4*)(rt), c1 = *(const f32x4*)(rt + 4), s0 = *(const f32x4*)(rt + 64), s1 = *(const f32x4*)(rt + 68);
                    const f32x4 o0 = a0 * c0 - b0 * s0, o1 = a1 * c1 - b1 * s1, p0 = b0 * c0 + a0 * s0, p1 = b1 * c1 + a1 * s1;
                    a0 = o0; a1 = o1; b0 = p0; b1 = p1;
                    if (pn < 4) { const float sc = 0.08838834764831845f; a0 *= sc; a1 *= sc; b0 *= sc; b1 *= sc; }
                } else if (pn >= 12 && pn < 18) { const float sc = 0.0625f; a0 *= sc; a1 *= sc; b0 *= sc; b1 *= sc; }
                bf16_t* zp = Z + (size_t)row * NZ + colb;
                u32x4 w; w.x = cvt_pk_bf16(a0[0], a0[1]); w.y = cvt_pk_bf16(a0[2], a0[3]); w.z = cvt_pk_bf16(a1[0], a1[1]); w.w = cvt_pk_bf16(a1[2], a1[3]);
                *(u32x4*)zp = w;
                w.x = cvt_pk_bf16(b0[0], b0[1]); w.y = cvt_pk_bf16(b0[2], b0[3]); w.z = cvt_pk_bf16(b1[0], b1[1]); w.w = cvt_pk_bf16(b1[2], b1[3]);
                *(u32x4*)(zp + 64) = w;
                if (pn >= 4 && pn < 12 && pos >= 2048) {
                    float* ob = (pn < 8) ? kout : vout; const int head = 2 * ((pn - 4) & 3) + hsel;
                    float* op = ob + ((size_t)(bb * 2048 + pos - 2048) * 8 + head) * 128 + i0;
                    *(f32x4*)op = a0; *(f32x4*)(op + 4) = a1; *(f32x4*)(op + 64) = b0; *(f32x4*)(op + 68) = b1;
                }
                asm volatile("" ::: "memory");
            }
    }
};
struct EpiOutProj {
    static constexpr bool FUSED = false;
    static constexpr int BMODE = 0;
    const float* X; float* H; bf16_t* HB; float* rss;
    __device__ __forceinline__ void operator()(const f32x4 (&acc)[2][2][4][2], const pg8::Unit& u, int wr, int wc, int fr, int fq) const {
        const int col0 = 256 * u.pn + 32 * wc + 4 * fq;
#pragma unroll
        for (int ai = 0; ai < 2; ++ai)
#pragma unroll
            for (int m = 0; m < 4; ++m) {
                const int row = 256 * u.pm + 128 * ai + 64 * wr + 16 * m + fr; const size_t off = (size_t)row * DM + col0; float ss = 0.f;
#pragma unroll
                for (int bj = 0; bj < 2; ++bj)
#pragma unroll
                    for (int n = 0; n < 2; ++n) { const size_t o = off + bj * 128 + n * 16; const f32x4 hv = *(const f32x4*)(X + o) + acc[ai][bj][m][n];
                        u32x2 w; w.x = cvt_pk_bf16(hv[0], hv[1]); w.y = cvt_pk_bf16(hv[2], hv[3]); *(u32x2*)(HB + o) = w;
                        ss += (hv[0] * hv[0] + hv[1] * hv[1]) + (hv[2] * hv[2] + hv[3] * hv[3]); }
                ss += __shfl_xor(ss, 16); ss += __shfl_xor(ss, 32);
                if (fq == 0) atomicAdd(rss + row, ss);
                asm volatile("" ::: "memory");
            }
    }
};
struct EpiUp {
    static constexpr bool FUSED = false;
    static constexpr int BMODE = 1;
    bf16_t* U; const float* rss; int pm0;
    __device__ __forceinline__ void operator()(const f32x4 (&acc)[2][2][4][2], const pg8::Unit& u, int wr, int wc, int fr, int fq) const {
        const int col0 = 256 * u.pn + 32 * wc + 8 * fq;
        float rr[2][4];
#pragma unroll
        for (int ai = 0; ai < 2; ++ai)
#pragma unroll
            for (int m = 0; m < 4; ++m) rr[ai][m] = rss[256 * (u.pm + pm0) + 128 * ai + 64 * wr + 16 * m + fr];
#pragma unroll
        for (int ai = 0; ai < 2; ++ai)
#pragma unroll
            for (int m = 0; m < 4; ++m) rr[ai][m] = rsqrtf(rr[ai][m] * (1.0f / DM) + EPS);
        asm volatile("" ::: "memory");
#pragma unroll
        for (int ai = 0; ai < 2; ++ai)
#pragma unroll
            for (int m = 0; m < 4; ++m) {
                const int row = 256 * (u.pm + pm0) + 128 * ai + 64 * wr + 16 * m + fr;
                const float r = rr[ai][m];
                bf16_t* up = U + (size_t)row * DFF + col0;
#pragma unroll
                for (int bj = 0; bj < 2; ++bj) { f32x4 v0 = acc[ai][bj][m][0] * r, v1 = acc[ai][bj][m][1] * r;
#pragma unroll
                    for (int j = 0; j < 4; ++j) { const float a = fmaxf(v0[j], 0.f), b = fmaxf(v1[j], 0.f); v0[j] = a * a; v1[j] = b * b; }
                    u32x4 w; w.x = cvt_pk_bf16(v0[0], v0[1]); w.y = cvt_pk_bf16(v0[2], v0[3]); w.z = cvt_pk_bf16(v1[0], v1[1]); w.w = cvt_pk_bf16(v1[2], v1[3]);
                    *(u32x4*)(up + bj * 128) = w; }
            }
    }
};
struct EpiDown {
    static constexpr bool FUSED = false;
    static constexpr int BMODE = 0;
    const bf16_t* HB; bf16_t* YB; float* rss; int pm0;
    __device__ __forceinline__ void operator()(const f32x4 (&acc)[2][2][4][2], const pg8::Unit& u, int wr, int wc, int fr, int fq) const {
        const int col0 = 256 * u.pn + 32 * wc + 4 * fq;
#pragma unroll
        for (int ai = 0; ai < 2; ++ai)
#pragma unroll
            for (int m = 0; m < 4; ++m) {
                const int row = 256 * (u.pm + pm0) + 128 * ai + 64 * wr + 16 * m + fr; const size_t off = (size_t)row * DM + col0; float ss = 0.f;
#pragma unroll
                for (int bj = 0; bj < 2; ++bj)
#pragma unroll
                    for (int n = 0; n < 2; ++n) { const size_t o = off + bj * 128 + n * 16; const u32x2 hw = *(const u32x2*)(HB + o);
                        const f32x4 hv = (f32x4){bf_lo(hw.x), bf_hi(hw.x), bf_lo(hw.y), bf_hi(hw.y)} + acc[ai][bj][m][n];
                        u32x2 w; w.x = cvt_pk_bf16(hv[0], hv[1]); w.y = cvt_pk_bf16(hv[2], hv[3]); *(u32x2*)(YB + o) = w;
                        ss += (hv[0] * hv[0] + hv[1] * hv[1]) + (hv[2] * hv[2] + hv[3] * hv[3]); }
                ss += __shfl_xor(ss, 16); ss += __shfl_xor(ss, 32);
                if (fq == 0) atomicAdd(rss + row, ss);
                asm volatile("" ::: "memory");
            }
    }
};

struct EpiDownNorm {
    static constexpr int BMODE = 0; static constexpr bool FUSED = true;
    const bf16_t* HB; float* Y; float* rss; unsigned* cnt; const float* gain; int pm0;
    __device__ __forceinline__ void operator()(const f32x4 (&)[2][2][4][2], const pg8::Unit&, int, int, int, int) const {}
    __device__ __forceinline__ void fused(f32x4 (&acc)[2][2][4][2], const pg8::Unit& u, int wr, int wc, int fr, int fq, int wid, int lane) const {
        const int col0 = 256 * u.pn + 32 * wc + 4 * fq, prow = 256 * (u.pm + pm0) + 64 * wr + fr;
        float chk = 0.f;
#pragma unroll
        for (int ai = 0; ai < 2; ++ai) {
            u32x2 hw[4][2][2];
#pragma unroll
            for (int m = 0; m < 4; ++m) { const size_t off = (size_t)(prow + 128 * ai + 16 * m) * DM + col0;
#pragma unroll
                for (int bj = 0; bj < 2; ++bj)
#pragma unroll
                    for (int n = 0; n < 2; ++n) hw[m][bj][n] = *(const u32x2*)(HB + off + bj * 128 + n * 16); }
#pragma unroll
            for (int m = 0; m < 4; ++m) { float ss = 0.f;
#pragma unroll
                for (int bj = 0; bj < 2; ++bj)
#pragma unroll
                    for (int n = 0; n < 2; ++n) { const u32x2 h2 = hw[m][bj][n]; f32x4 hv = (f32x4){bf_lo(h2.x), bf_hi(h2.x), bf_lo(h2.y), bf_hi(h2.y)} + acc[ai][bj][m][n]; acc[ai][bj][m][n] = hv;
                        ss += (hv[0] * hv[0] + hv[1] * hv[1]) + (hv[2] * hv[2] + hv[3] * hv[3]); }
                ss += __shfl_xor(ss, 16); ss += __shfl_xor(ss, 32);
                if (fq == 0) chk += __hip_atomic_fetch_add(rss + prow + 128 * ai + 16 * m, ss, __ATOMIC_RELAXED, __HIP_MEMORY_SCOPE_AGENT); }
        }
        asm volatile("s_waitcnt vmcnt(0)" :: "v"(chk) : "memory");
        unsigned* pc = cnt + 64 * (u.pm + pm0);
        if (lane == 0) __hip_atomic_fetch_add(pc, 1u, __ATOMIC_RELAXED, __HIP_MEMORY_SCOPE_AGENT);
        if (wid == 0) { unsigned sp = 0; while ((unsigned)__builtin_amdgcn_readfirstlane(__hip_atomic_load(pc, __ATOMIC_RELAXED, __HIP_MEMORY_SCOPE_AGENT)) < 128u && ++sp < 400000u) __builtin_amdgcn_s_sleep(1); }
        asm volatile("s_waitcnt vmcnt(0) lgkmcnt(0)" ::: "memory"); __builtin_amdgcn_s_barrier(); asm volatile("" ::: "memory");
        float rr[2][4];
#pragma unroll
        for (int ai = 0; ai < 2; ++ai)
#pragma unroll
            for (int m = 0; m < 4; ++m) rr[ai][m] = __hip_atomic_load(rss + prow + 128 * ai + 16 * m, __ATOMIC_RELAXED, __HIP_MEMORY_SCOPE_AGENT);
        f32x4 gg[2][2];
#pragma unroll
        for (int bj = 0; bj < 2; ++bj)
#pragma unroll
            for (int n = 0; n < 2; ++n) gg[bj][n] = *(const f32x4*)(gain + col0 + bj * 128 + n * 16);
#pragma unroll
        for (int ai = 0; ai < 2; ++ai)
#pragma unroll
            for (int m = 0; m < 4; ++m) { const float r = rsqrtf(rr[ai][m] * (1.0f / DM) + EPS); float* yp = Y + (size_t)(prow + 128 * ai + 16 * m) * DM + col0;
#pragma unroll
                for (int bj = 0; bj < 2; ++bj)
#pragma unroll
                    for (int n = 0; n < 2; ++n) *(f32x4*)(yp + bj * 128 + n * 16) = acc[ai][bj][m][n] * r * gg[bj][n]; }
    }
};

constexpr int SK_SROW = 528;
template <int NI, class Epi>
__device__ __forceinline__ void skinny_unit(LAS unsigned char* lds, const bf16_t* S, const bf16_t* T, int K, int kbeg, int klen, const Epi& E, int u, int w) {
    int tid = threadIdx.x; asm volatile("" : "+v"(tid)); const int wid = __builtin_amdgcn_readfirstlane(tid >> 6), lane = tid & 63, li = lane & 15, g = lane >> 4;
    const int kw = klen >> 3, k0 = kbeg + wid * kw;
    const bf16_t* t0 = T + (size_t)(E.jrow(u, w, 0) + li) * K + 32 * g;
    const bf16_t* t1 = T + (size_t)(E.jrow(u, w, 1) + li) * K + 32 * g;
    const bf16_t* s0 = S + (size_t)li * K + 32 * g;
    f32x4 acc[2][NI];
#pragma unroll
    for (int a = 0; a < 2; ++a)
#pragma unroll
        for (int b = 0; b < NI; ++b) acc[a][b] = (f32x4){0.f, 0.f, 0.f, 0.f};
    bf16x8 tcA[2][4], scA[NI][4], tcB[2][4], scB[NI][4];
#define SK_LOAD(tc_, sc_, kb_) do { _Pragma("unroll") for (int q = 0; q < 4; ++q) { const int ko = (kb_) + 8 * q; tc_[0][q] = *(const bf16x8*)(t0 + ko); tc_[1][q] = *(const bf16x8*)(t1 + ko); \
        _Pragma("unroll") for (int i2 = 0; i2 < NI; ++i2) sc_[i2][q] = *(const bf16x8*)(s0 + (size_t)(16 * i2) * K + ko); } } while (0)
#define SK_MMA(tc_, sc_) do { _Pragma("unroll") for (int q = 0; q < 4; ++q) _Pragma("unroll") for (int i2 = 0; i2 < NI; ++i2) { \
        acc[0][i2] = __builtin_amdgcn_mfma_f32_16x16x32_bf16(tc_[0][q], sc_[i2][q], acc[0][i2], 0, 0, 0); \
        acc[1][i2] = __builtin_amdgcn_mfma_f32_16x16x32_bf16(tc_[1][q], sc_[i2][q], acc[1][i2], 0, 0, 0); } } while (0)
    SK_LOAD(tcA, scA, k0);
#pragma unroll 1
    for (int kb = k0; kb < k0 + kw; kb += 256) {
        SK_LOAD(tcB, scB, kb + 128);
        SK_MMA(tcA, scA);
        if (kb + 256 < k0 + kw) SK_LOAD(tcA, scA, kb + 256);
        SK_MMA(tcB, scB);
    }
#undef SK_LOAD
#undef SK_MMA
    LAS f32x4* red = (LAS f32x4*)lds;
#pragma unroll
    for (int a = 0; a < 2; ++a)
#pragma unroll
        for (int b = 0; b < NI; ++b) red[((wid * 2 + a) * NI + b) * 64 + lane] = acc[a][b];
    __syncthreads();
    if (wid == 0) {
#pragma unroll
        for (int a = 0; a < 2; ++a)
#pragma unroll
            for (int b = 0; b < NI; ++b) { f32x4 s = red[(a * NI + b) * 64 + lane];
#pragma unroll
                for (int ww = 1; ww < 8; ++ww) s += red[((ww * 2 + a) * NI + b) * 64 + lane];
                acc[a][b] = s; }
        E(acc, u, w, li, g);
    }
    __syncthreads();
}

struct SkGates {
    const float* bif; float* G;
    __device__ __forceinline__ int jrow(int u, int w, int jt) const { return 256 * u + 32 * w + 16 * jt; }
    __device__ __forceinline__ void operator()(const f32x4 (&acc)[2][1], int u, int w, int li, int g) const {
        if (li >= 12) return;
        const float bias = bif[li];
#pragma unroll
        for (int jt = 0; jt < 2; ++jt) {
            const int tok = jrow(u, w, jt) + 4 * g; if (tok >= MT) continue;
            f32x4 v = acc[jt][0];
#pragma unroll
            for (int j = 0; j < 4; ++j) { float a = 15.0f * tanhf((v[j] + bias) * (1.0f / 15.0f));
                if (li >= 6) a = fminf(a, 0.f) - log1pf(__expf(-fabsf(a)));
                v[j] = a; }
            *(f32x4*)(G + (size_t)li * MT + tok) = v;
        }
    }
};
struct SkInProj {
    bf16_t* Z; const float* rope; float* kout; float* vout;
    __device__ __forceinline__ int jrow(int u, int w, int jt) const { return 256 * u + 128 * (w >> 2) + 64 * jt + 16 * (w & 3); }
    __device__ __forceinline__ void operator()(const f32x4 (&acc)[2][2], int u, int w, int li, int g) const {
        const int c0 = jrow(u, w, 0) + 4 * g;
        const int i0 = (c0 & 63);
#pragma unroll
        for (int i2 = 0; i2 < 2; ++i2) {
            const int sr = 16 * i2 + li, row = MP + sr;
            f32x4 a = acc[0][i2], b = acc[1][i2];
            if (u < 8) {
                const float* rt = rope + (size_t)4096 * 128 + i0;
                const f32x4 c = *(const f32x4*)rt, s = *(const f32x4*)(rt + 64);
                const f32x4 o = a * c - b * s, p = b * c + a * s; a = o; b = p;
                if (u < 4) { a *= 0.08838834764831845f; b *= 0.08838834764831845f; }
            } else if (u >= 12 && u < 18) { a *= 0.0625f; b *= 0.0625f; }
            bf16_t* zp = Z + (size_t)row * NZ + c0;
            u32x2 wv; wv.x = cvt_pk_bf16(a[0], a[1]); wv.y = cvt_pk_bf16(a[2], a[3]); *(u32x2*)zp = wv;
            wv.x = cvt_pk_bf16(b[0], b[1]); wv.y = cvt_pk_bf16(b[2], b[3]); *(u32x2*)(zp + 64) = wv;
            if (u >= 4 && u < 12) { float* ob = (u < 8) ? kout : vout; float* op = ob + (size_t)sr * 1024 + (c0 & 1023); *(f32x4*)op = a; *(f32x4*)(op + 64) = b; }
        }
    }
};
struct SkOutProj {
    const float* XS; float* H; bf16_t* HB; float* rss;
    __device__ __forceinline__ int jrow(int u, int w, int jt) const { return 256 * u + 32 * w + 16 * jt; }
    __device__ __forceinline__ void operator()(const f32x4 (&acc)[2][2], int u, int w, int li, int g) const {
#pragma unroll
        for (int i2 = 0; i2 < 2; ++i2) { const int sr = 16 * i2 + li, row = MP + sr; float ss = 0.f;
#pragma unroll
            for (int jt = 0; jt < 2; ++jt) { const int col = jrow(u, w, jt) + 4 * g; const f32x4 hv = *(const f32x4*)(XS + (size_t)sr * DM + col) + acc[jt][i2];
                u32x2 wv; wv.x = cvt_pk_bf16(hv[0], hv[1]); wv.y = cvt_pk_bf16(hv[2], hv[3]); *(u32x2*)(HB + (size_t)row * DM + col) = wv;
                ss += (hv[0] * hv[0] + hv[1] * hv[1]) + (hv[2] * hv[2] + hv[3] * hv[3]); }
            atomicAdd(rss + row, ss); }
    }
};
struct SkUp {
    bf16_t* U; const float* rss;
    __device__ __forceinline__ int jrow(int u, int w, int jt) const { return 256 * u + 32 * w + 16 * jt; }
    __device__ __forceinline__ void operator()(const f32x4 (&acc)[2][2], int u, int w, int li, int g) const {
#pragma unroll
        for (int i2 = 0; i2 < 2; ++i2) { const int row = MP + 16 * i2 + li; const float r = rsqrtf(rss[row] * (1.0f / DM) + EPS);
#pragma unroll
            for (int jt = 0; jt < 2; ++jt) { const int col = jrow(u, w, jt) + 4 * g; f32x4 v = acc[jt][i2] * r;
#pragma unroll
                for (int j = 0; j < 4; ++j) { const float a = fmaxf(v[j], 0.f); v[j] = a * a; }
                u32x2 wv; wv.x = cvt_pk_bf16(v[0], v[1]); wv.y = cvt_pk_bf16(v[2], v[3]); *(u32x2*)(U + (size_t)row * DFF + col) = wv; } }
    }
};
struct SkDown {
    float* ACC;
    __device__ __forceinline__ int jrow(int u, int w, int jt) const { return 256 * (u & 15) + 32 * w + 16 * jt; }
    __device__ __forceinline__ void operator()(const f32x4 (&acc)[2][2], int u, int w, int li, int g) const {
#pragma unroll
        for (int i2 = 0; i2 < 2; ++i2)
#pragma unroll
            for (int jt = 0; jt < 2; ++jt) { float* p = ACC + (size_t)(16 * i2 + li) * DM + jrow(u, w, jt) + 4 * g;
#pragma unroll
                for (int j = 0; j < 4; ++j) atomicAdd(p + j, acc[jt][i2][j]); }
    }
};

__device__ __forceinline__ void trw_load(f32x4 (&v)[16], const float* W, int ldw, int nnb, int it, int wid, int lane) {
    const int kbo = it / nnb, nb = it - kbo * nnb; const float* p = W + (size_t)(128 * kbo + 16 * wid) * ldw + 256 * nb + 4 * lane;
#pragma unroll
    for (int i = 0; i < 16; ++i) v[i] = __builtin_nontemporal_load((const f32x4*)(p + (size_t)i * ldw));
}
__device__ __forceinline__ void trw_to_lds(f32x4 (&v)[16], LAS unsigned char* buf, const float* gk, int nnb, int it, int wid, int lane) {
    if (gk) { const int kbo = it / nnb;
#pragma unroll
        for (int i = 0; i < 16; ++i) v[i] *= gk[128 * kbo + 16 * wid + i]; }
    const int key = lane & 7;
#pragma unroll
    for (int c = 0; c < 4; ++c) { LAS unsigned char* rp = buf + (4 * lane + c) * 256;
        u32x4 lo, hi; lo.x = cvt_pk_bf16(v[0][c], v[1][c]); lo.y = cvt_pk_bf16(v[2][c], v[3][c]); lo.z = cvt_pk_bf16(v[4][c], v[5][c]); lo.w = cvt_pk_bf16(v[6][c], v[7][c]);
        hi.x = cvt_pk_bf16(v[8][c], v[9][c]); hi.y = cvt_pk_bf16(v[10][c], v[11][c]); hi.z = cvt_pk_bf16(v[12][c], v[13][c]); hi.w = cvt_pk_bf16(v[14][c], v[15][c]);
        *(LAS u32x4*)(rp + 16 * ((2 * wid) ^ key)) = lo; *(LAS u32x4*)(rp + 16 * ((2 * wid + 1) ^ key)) = hi; }
}
__device__ __forceinline__ void trw_store(const LAS unsigned char* buf, bf16_t* WT, int K, int nnb, int it, int wid, int lane) {
    const int kbo = it / nnb, nb = it - kbo * nnb, chunk = lane & 15;
#pragma unroll
    for (int j = 0; j < 8; ++j) { const int row = 32 * j + 4 * wid + (lane >> 4), key = (row >> 2) & 7;
        const u32x4 d = *(const LAS u32x4*)(buf + row * 256 + 16 * (chunk ^ key));
        *(u32x4*)(WT + (size_t)(256 * nb + row) * K + 128 * kbo + 8 * chunk) = d; }
}
__device__ __forceinline__ void trw_run(LAS unsigned char* lds, const float* W, int ldw, int K, int Nuse, bf16_t* WT, const float* gk, int first, int cnt, int stride) {
    int tid = threadIdx.x; asm volatile("" : "+v"(tid)); const int wid = __builtin_amdgcn_readfirstlane(tid >> 6), lane = tid & 63;
    const int nnb = Nuse / 256; if (cnt <= 0) return;
    f32x4 v[16]; int it = first;
    trw_load(v, W, ldw, nnb, it, wid, lane);
    trw_to_lds(v, lds, gk, nnb, it, wid, lane);
    __syncthreads();
    for (int j = 0; j < cnt; ++j) {
        const int nx = it + stride; const bool more = (j + 1 < cnt);
        if (more) trw_load(v, W, ldw, nnb, nx, wid, lane);
        trw_store(lds + (j & 1) * 65536, WT, K, nnb, it, wid, lane);
        if (more) trw_to_lds(v, lds + ((j + 1) & 1) * 65536, gk, nnb, nx, wid, lane);
        __syncthreads();
        it = nx;
    }
}
__device__ __forceinline__ void p0_tr_load(f32x4 (&v)[8], const float* W, int ldw, int Nuse_, int it, int lane) {
    const int nnb = Nuse_ / 256, kb = 8 * (it / (8 * nnb)) + (it & 7), nb = (it >> 3) % nnb, k0 = 8 * kb, n0 = 256 * nb + 4 * lane;
#pragma unroll
    for (int i = 0; i < 8; ++i) v[i] = *(const f32x4*)(W + (size_t)(k0 + i) * ldw + n0);
}
__device__ __forceinline__ void p0_tr_store(f32x4 (&v)[8], int K, bf16_t* WT, const float* gk, int Nuse_, int it, int lane) {
    const int nnb = Nuse_ / 256, kb = 8 * (it / (8 * nnb)) + (it & 7), nb = (it >> 3) % nnb, k0 = 8 * kb, n0 = 256 * nb + 4 * lane;
    if (gk) {
#pragma unroll
        for (int i = 0; i < 8; ++i) v[i] *= gk[k0 + i];
    }
#pragma unroll
    for (int c = 0; c < 4; ++c) { u32x4 o; o.x = cvt_pk_bf16(v[0][c], v[1][c]); o.y = cvt_pk_bf16(v[2][c], v[3][c]); o.z = cvt_pk_bf16(v[4][c], v[5][c]); o.w = cvt_pk_bf16(v[6][c], v[7][c]);
        *(u32x4*)(WT + (size_t)(n0 + c) * K + k0) = o; }
}
__device__ __forceinline__ void p0_transpose(const float* W, int ldw, int K, int Nuse, bf16_t* WT, const float* gk, int gw, int ngw, int lane) {
    const int nkb = K / 8, nnb = Nuse / 256, items = nkb * nnb;
    int it = gw; if (it >= items) return;
    f32x4 v[8], w[8];
    p0_tr_load(v, W, ldw, Nuse, it, lane);
    for (;;) {
        const int n1 = it + ngw;
        if (n1 < items) p0_tr_load(w, W, ldw, Nuse, n1, lane);
        p0_tr_store(v, K, WT, gk, Nuse, it, lane);
        if (n1 >= items) break;
        const int n2 = n1 + ngw;
        if (n2 < items) p0_tr_load(v, W, ldw, Nuse, n2, lane);
        p0_tr_store(w, K, WT, gk, Nuse, n1, lane);
        if (n2 >= items) break;
        it = n2;
    }
}
__device__ __forceinline__ void sincos_d(float ang, float& c, float& s) {
    const double x = (double)ang;
    const double n = __builtin_rint(x * 0.63661977236758134308);
    double r = __builtin_fma(-n, 1.57079632679489655800e+00, x); r = __builtin_fma(-n, 6.12323399573676603587e-17, r);
    const double r2 = r * r;
    double sp = 1.0 / 6227020800.0; sp = sp * r2 * (-1.0) + 1.0 / 39916800.0; sp = sp * r2 * (-1.0) + 1.0 / 362880.0; sp = sp * r2 * (-1.0) + 1.0 / 5040.0; sp = sp * r2 * (-1.0) + 1.0 / 120.0; sp = sp * r2 * (-1.0) + 1.0 / 6.0; sp = sp * r2 * (-1.0) + 1.0;
    const double sn = sp * r;
    double cp = 1.0 / 87178291200.0; cp = cp * r2 * (-1.0) + 1.0 / 479001600.0; cp = cp * r2 * (-1.0) + 1.0 / 3628800.0; cp = cp * r2 * (-1.0) + 1.0 / 40320.0; cp = cp * r2 * (-1.0) + 1.0 / 720.0; cp = cp * r2 * (-1.0) + 1.0 / 24.0; cp = cp * r2 * (-1.0) + 0.5; cp = cp * r2 * (-1.0) + 1.0;
    const double cs = cp;
    const int q = ((int)n) & 3;
    const double cc = (q == 0) ? cs : (q == 1) ? -sn : (q == 2) ? -cs : sn;
    const double ss = (q == 0) ? sn : (q == 1) ? cs : (q == 2) ? -sn : -cs;
    c = (float)cc; s = (float)ss;
}
struct P0Args { const float *xp, *xs, *g1, *win, *wout, *g2, *wup, *wdn; bf16_t *WinT, *WoutT, *WupT, *WdnT, *XN, *WG; float* rope; };
__device__ __forceinline__ void p0_prologue(const P0Args& a, int vcu, int G, int wid, int lane) {
    const int gw = vcu * 8 + wid, ngw = G * 8, gt = gw * 64 + lane, ngt = ngw * 64;
    for (int idx = gt; idx < 4097 * 64; idx += ngt) { const int pi = idx >> 6, i = idx & 63; const int pos = pi < 4096 ? pi : 8192;
        double invd = 1.0; for (int e = 0; e < i; ++e) invd *= 0.86596432336006535;
        const float inv = (float)invd; const float ang = (float)pos * inv; float c, s; sincos_d(ang, c, s);
        a.rope[(size_t)pi * 128 + i] = c; a.rope[(size_t)pi * 128 + 64 + i] = s; }
    for (int idx = gt; idx < 16 * DM; idx += ngt) { const int gi = idx >> 12, k = idx & 4095; const float v = gi < 12 ? a.win[(size_t)k * NINF + NZ + gi] : 0.f; a.WG[idx] = (bf16_t)(cvt_pk_bf16(v, 0.f) & 0xffffu); }
    for (int m = gw; m < MT; m += ngw) {
        const float* xr = (m < MP) ? a.xp + (size_t)m * DM : a.xs + (size_t)(m - MP) * DM;
        f32x4 v[8][2]; float ss = 0.f;
#pragma unroll
        for (int c = 0; c < 8; ++c) { v[c][0] = *(const f32x4*)(xr + 512 * c + 8 * lane); v[c][1] = *(const f32x4*)(xr + 512 * c + 8 * lane + 4);
            ss += (v[c][0][0] * v[c][0][0] + v[c][0][1] * v[c][0][1]) + (v[c][0][2] * v[c][0][2] + v[c][0][3] * v[c][0][3]) + (v[c][1][0] * v[c][1][0] + v[c][1][1] * v[c][1][1]) + (v[c][1][2] * v[c][1][2] + v[c][1][3] * v[c][1][3]); }
        const float r = rsqrtf(wave_sum(ss) * (1.0f / DM) + EPS);
#pragma unroll
        for (int c = 0; c < 8; ++c) { const f32x4 g0 = *(const f32x4*)(a.g1 + 512 * c + 8 * lane), g1v = *(const f32x4*)(a.g1 + 512 * c + 8 * lane + 4);
            const f32x4 y0 = v[c][0] * r * g0, y1 = v[c][1] * r * g1v;
            u32x4 o; o.x = cvt_pk_bf16(y0[0], y0[1]); o.y = cvt_pk_bf16(y0[2], y0[3]); o.z = cvt_pk_bf16(y1[0], y1[1]); o.w = cvt_pk_bf16(y1[2], y1[3]);
            *(u32x4*)(a.XN + (size_t)m * DM + 512 * c + 8 * lane) = o; }
    }
}


constexpr int SC_KSTR = 544, SC_VSTR = 144, SC_KIMG = 50176, SC_VIMG = 84992;
__device__ __forceinline__ void mlstm_scan(LAS unsigned char* lds, const bf16_t* Z, const float* GT, bf16_t* CT, float* NC, float* TB, float* TWV, float* TMT, float* CM, float* out, int unit) {
    int tid = threadIdx.x; asm volatile("" : "+v"(tid)); const int wid = __builtin_amdgcn_readfirstlane(tid >> 6), lane = tid & 63, li = lane & 15, g = lane >> 4;
    const int bh = unit >> 3, sl = unit & 7, b = bh / NH, h = bh % NH, dvt = wid & 3, dkh = wid >> 2;
    LAS float* wv = (LAS float*)lds; LAS float* bl = wv + 4096; LAS float* cml = bl + 4096; LAS float* bs = cml + 4096; LAS float* gc = bs + 64; LAS float* mC = gc + 64;
    LAS unsigned char* Kimg = lds + SC_KIMG; LAS unsigned char* Vimg = lds + SC_VIMG;
    { const float* lip = GT + (size_t)h * MT + b * SEQ; const float* lfp = GT + (size_t)(6 + h) * MT + b * SEQ;
      for (int c = wid; c < NCH; c += 8) { const int t = 64 * c + lane; const float lf = lfp[t], liv = lip[t];
          float bsum = lf;
#pragma unroll
          for (int o = 1; o < 64; o <<= 1) { const float v = __shfl_up(bsum, o); if (lane >= o) bsum += v; }
          const float w = liv - bsum; float cm = w;
#pragma unroll
          for (int o = 1; o < 64; o <<= 1) { const float v = __shfl_up(cm, o); if (lane >= o) cm = fmaxf(cm, v); }
          wv[t] = w; bl[t] = bsum; cml[t] = cm;
          if (lane == 63) { bs[c] = bsum; gc[c] = bsum + cm; } }
      __syncthreads();
      if (tid == 0) { float m = 0.f; mC[0] = 0.f; for (int c = 0; c < NCH; ++c) { m = fmaxf(bs[c] + m, gc[c]); mC[c + 1] = m; } }
      __syncthreads();
      if (sl == 0) { for (int t = tid; t < SEQ; t += 512) { const int c = t >> 6; TB[bh * SEQ + t] = bl[t]; TWV[bh * SEQ + t] = wv[t]; TMT[bh * SEQ + t] = bl[t] + fmaxf(mC[c], cml[t]); }
                     if (tid < 65) CM[bh * 80 + tid] = mC[tid]; } }
    const bool nwr = (sl == 0) && (dvt == 0);
    f32x4 acc[8], nacc[8];
#pragma unroll
    for (int T = 0; T < 8; ++T) { acc[T] = (f32x4){0.f, 0.f, 0.f, 0.f}; nacc[T] = (f32x4){0.f, 0.f, 0.f, 0.f}; }
    bf16x8 ones;
#pragma unroll
    for (int e = 0; e < 8; ++e) ones[e] = (short)0x3F80;
    u32x4 kq[2][4], vq[2];
#define SCAN_LOAD(S_, c_) do { _Pragma("unroll") for (int q = 0; q < 4; ++q) { const int ch = tid + 512 * q, tok = ch >> 5, c16 = ch & 31; kq[S_][q] = *(const u32x4*)(Z + ((size_t)b * SEQ + 64 * (c_) + tok) * NZ + ZKM + h * DK + 8 * c16); } \
        { const int tok = tid >> 3, c16 = tid & 7; vq[S_] = *(const u32x4*)(Z + ((size_t)b * SEQ + 64 * (c_) + tok) * NZ + ZVM + h * DV + 64 * sl + 8 * c16); } } while (0)
#define SC_CL(x) fminf(fmaxf((x), -440.0f), 440.0f)
#define SC_PK8(v) ((unsigned)__builtin_amdgcn_cvt_pk_fp8_f32(SC_CL((v)[2]), SC_CL((v)[3]), __builtin_amdgcn_cvt_pk_fp8_f32(SC_CL((v)[0]), SC_CL((v)[1]), 0, false), true))
#define SCAN_STEP(S_, c_) do { const int c = (c_); \
        { unsigned char* ct = (unsigned char*)CT + (((size_t)(bh * NCH + c) * DV + (64 * sl + 16 * dvt + li)) * DK + 128 * dkh + 16 * g); \
          _Pragma("unroll") for (int Q = 0; Q < 2; ++Q) { u32x4 w; \
              w.x = SC_PK8(acc[4 * Q + 0]); w.y = SC_PK8(acc[4 * Q + 1]); w.z = SC_PK8(acc[4 * Q + 2]); w.w = SC_PK8(acc[4 * Q + 3]); \
              *(u32x4*)(ct + 64 * Q) = w; } \
          if (nwr && li == 0) { _Pragma("unroll") for (int T = 0; T < 8; ++T) *(f32x4*)(NC + (size_t)(bh * NCH + c) * DK + 128 * dkh + 64 * (T >> 2) + 16 * g + 4 * (T & 3)) = nacc[T]; } } \
        __syncthreads(); \
        const float mn = mC[c + 1], bsc = bs[c]; \
        _Pragma("unroll") for (int q = 0; q < 4; ++q) { const int ch = tid + 512 * q, tok = ch >> 5, c16 = ch & 31; \
            const u32x4 kv = kq[S_][q]; const float w = __expf(bsc + wv[64 * c + tok] - mn); \
            u32x4 o; o.x = cvt_pk_bf16(bf_lo(kv.x) * w, bf_hi(kv.x) * w); o.y = cvt_pk_bf16(bf_lo(kv.y) * w, bf_hi(kv.y) * w); o.z = cvt_pk_bf16(bf_lo(kv.z) * w, bf_hi(kv.z) * w); o.w = cvt_pk_bf16(bf_lo(kv.w) * w, bf_hi(kv.w) * w); \
            *(LAS u32x4*)(Kimg + tok * SC_KSTR + 16 * c16) = o; } \
        { const int tok = tid >> 3, c16 = tid & 7; *(LAS u32x4*)(Vimg + tok * SC_VSTR + 16 * c16) = vq[S_]; } \
        __syncthreads(); \
        if (c + 2 < NCH) SCAN_LOAD(S_, c + 2); \
        const float dec = __expf(bsc + mC[c] - mn); \
        _Pragma("unroll") for (int T = 0; T < 8; ++T) { acc[T] *= dec; nacc[T] *= dec; } \
        _Pragma("unroll") for (int kb = 0; kb < 2; ++kb) { \
            const LAS unsigned char* vp = Vimg + (32 * kb + 8 * g + (li >> 2)) * SC_VSTR + (16 * dvt + 4 * (li & 3)) * 2; \
            const bf16x8 Bf = cat8(vtr(vp), vtr(vp + 4 * SC_VSTR)); \
            _Pragma("unroll") for (int T = 0; T < 8; ++T) { \
                const LAS unsigned char* kp = Kimg + (32 * kb + 8 * g + (li >> 2)) * SC_KSTR + (128 * dkh + 64 * (T >> 2) + 16 * (li & 3) + 4 * (T & 3)) * 2; \
                const bf16x8 Af = cat8(vtr(kp), vtr(kp + 4 * SC_KSTR)); \
                acc[T] = __builtin_amdgcn_mfma_f32_16x16x32_bf16(Af, Bf, acc[T], 0, 0, 0); \
                if (nwr) nacc[T] = __builtin_amdgcn_mfma_f32_16x16x32_bf16(Af, ones, nacc[T], 0, 0, 0); } } } while (0)
    SCAN_LOAD(0, 0); SCAN_LOAD(1, 1);
#pragma unroll 1
    for (int c2 = 0; c2 < NCH; c2 += 2) { SCAN_STEP(0, c2); SCAN_STEP(1, c2 + 1); }
#undef SCAN_LOAD
#undef SCAN_STEP
#undef SC_PK8
#undef SC_CL
#pragma unroll
    for (int T = 0; T < 8; ++T)
#pragma unroll
        for (int r = 0; r < 4; ++r) out[O_CP + ((size_t)bh * DK + 128 * dkh + 64 * (T >> 2) + 16 * g + 4 * (T & 3) + r) * DV + 64 * sl + 16 * dvt + li] = acc[T][r];
    if (nwr && li == 0) {
#pragma unroll
        for (int T = 0; T < 8; ++T) *(f32x4*)(out + O_NP + (size_t)bh * DK + 128 * dkh + 64 * (T >> 2) + 16 * g + 4 * (T & 3)) = nacc[T]; }
    if (sl == 0 && tid == 0) out[O_MP + bh] = mC[NCH];
    __syncthreads();
}

constexpr int AT_VS = 272;
__device__ __forceinline__ void attn_blk_cfg(int s, int& r, int& w, int& blk) { if (s < 12) { r = 1; w = 128; blk = s; } else if (s < 18) { r = 4; w = 512; blk = s - 12; } else { r = 16; w = 2048; blk = s - 18; } }
__device__ __forceinline__ void attn_blk_load(const char* zc, int pmax, int s, int lane, bf16x8 (&kf)[2][4], u32x4 (&vv)[8]) {
    int r, w, blk; attn_blk_cfg(s, r, w, blk); const int li = lane & 15, g = lane >> 4;
    const int pb = pmax - r * 32 * blk;
#pragma unroll
    for (int it = 0; it < 8; ++it) { int kp = pb - r * (it * 4 + g); kp = kp < 0 ? 0 : kp;
        const unsigned off = __umul24((unsigned)kp, (unsigned)(NZ * 2)) + (unsigned)((ZVA + 8 * li) * 2);
        vv[it] = *(const u32x4*)(zc + off); }
#pragma unroll
    for (int T = 0; T < 2; ++T) { int kp = pb - r * (16 * T + li); kp = kp < 0 ? 0 : kp;
        const unsigned off = __umul24((unsigned)kp, (unsigned)(NZ * 2)) + (unsigned)((ZKA + 8 * g) * 2);
#pragma unroll
        for (int q = 0; q < 4; ++q) kf[T][q] = *(const bf16x8*)(zc + off + 64 * q); }
}
__device__ __forceinline__ void attn_tile(LAS unsigned char* vimg, const bf16_t* Z, bf16_t* MIX, int b, int h, int p0c, int lane) {
    const int li = lane & 15, g = lane >> 4;
    const int qpos = p0c + 16 * li, pmax = p0c + 240;
    const bf16_t* zb = Z + (size_t)b * SEQ * NZ + h * 128;
    const char* zc = (const char*)zb;
    bf16x8 qf[4];
#pragma unroll
    for (int s = 0; s < 4; ++s) qf[s] = *(const bf16x8*)(zb + (size_t)qpos * NZ + ZQA + 32 * s + 8 * g);
    f32x4 o[8];
#pragma unroll
    for (int d = 0; d < 8; ++d) o[d] = (f32x4){0.f, 0.f, 0.f, 0.f};
    float m = -INFINITY, l = 0.f;
    bf16x8 kA[2][4], kB[2][4]; u32x4 vA[8], vB[8];
    auto step = [&](int s, bf16x8 (&kf)[2][4], u32x4 (&vv)[8], bf16x8 (&kn)[2][4], u32x4 (&vn)[8]) __attribute__((always_inline)) {
        if (s + 1 < 23) attn_blk_load(zc, pmax, s + 1, lane, kn, vn);
        int r, w, blk; attn_blk_cfg(s, r, w, blk);
        f32x4 st[2];
#pragma unroll
        for (int T = 0; T < 2; ++T) { st[T] = (f32x4){0.f, 0.f, 0.f, 0.f};
#pragma unroll
            for (int q = 0; q < 4; ++q) st[T] = __builtin_amdgcn_mfma_f32_16x16x32_bf16(kf[T][q], qf[q], st[T], 0, 0, 0); }
        const int sh = (r == 1) ? 0 : (r == 4) ? 2 : 4, off16 = 16 * (15 - li);
        const int nlo = (off16 + r - 1) >> sh; int nhi = (w + off16) >> sh; { const int nb = pmax >> sh; nhi = nhi < nb ? nhi : nb; }
        float bm = -INFINITY;
#pragma unroll
        for (int T = 0; T < 2; ++T)
#pragma unroll
            for (int rg = 0; rg < 4; ++rg) { const int n = 32 * blk + 16 * T + 4 * g + rg; const bool ok = (n >= nlo) && (n <= nhi);
                st[T][rg] = ok ? st[T][rg] : -INFINITY; bm = fmaxf(bm, st[T][rg]); }
        bm = fmaxf(bm, __shfl_xor(bm, 16)); bm = fmaxf(bm, __shfl_xor(bm, 32));
        const float mn = fmaxf(m, bm), mu = (mn == -INFINITY) ? 0.f : mn;
        const float alpha = __expf(m - mu);
        float ps = 0.f; f32x4 p[2];
#pragma unroll
        for (int T = 0; T < 2; ++T)
#pragma unroll
            for (int rg = 0; rg < 4; ++rg) { p[T][rg] = __expf(st[T][rg] - mu); ps += p[T][rg]; }
        l = l * alpha + ps;
        if (!__all(mn == m)) {
#pragma unroll
            for (int d = 0; d < 8; ++d) o[d] *= alpha; }
        m = mn;
        bf16x8 pf; { const unsigned w0 = cvt_pk_bf16(p[0][0], p[0][1]), w1 = cvt_pk_bf16(p[0][2], p[0][3]), w2 = cvt_pk_bf16(p[1][0], p[1][1]), w3 = cvt_pk_bf16(p[1][2], p[1][3]);
            pf[0] = (short)(w0 & 0xffff); pf[1] = (short)(w0 >> 16); pf[2] = (short)(w1 & 0xffff); pf[3] = (short)(w1 >> 16); pf[4] = (short)(w2 & 0xffff); pf[5] = (short)(w2 >> 16); pf[6] = (short)(w3 & 0xffff); pf[7] = (short)(w3 >> 16); }
        asm volatile("" ::: "memory");
#pragma unroll
        for (int it = 0; it < 8; ++it) { const int ci = it * 64 + lane, key = ci >> 4, part = ci & 15; *(LAS u32x4*)(vimg + key * AT_VS + 16 * part) = vv[it]; }
        asm volatile("" ::: "memory");
#pragma unroll
        for (int d = 0; d < 8; ++d) { const LAS unsigned char* vp = vimg + (4 * g + (li >> 2)) * AT_VS + (16 * d + 4 * (li & 3)) * 2;
            const bf16x8 af = cat8(vtr(vp), vtr(vp + 16 * AT_VS));
            o[d] = __builtin_amdgcn_mfma_f32_16x16x32_bf16(af, pf, o[d], 0, 0, 0); }
        asm volatile("" ::: "memory");
    };
    attn_blk_load(zc, pmax, 0, lane, kA, vA);
#pragma unroll 1
    for (int s = 0; s < 22; s += 2) { step(s, kA, vA, kB, vB); step(s + 1, kB, vB, kA, vA); }
    step(22, kA, vA, kB, vB);
    l += __shfl_xor(l, 16); l += __shfl_xor(l, 32);
    const float inv = 1.0f / l;
    bf16_t* mp = MIX + ((size_t)b * SEQ + qpos) * DM + h * 128 + 4 * g;
#pragma unroll
    for (int d = 0; d < 8; ++d) { u32x2 w; w.x = cvt_pk_bf16(o[d][0] * inv, o[d][1] * inv); w.y = cvt_pk_bf16(o[d][2] * inv, o[d][3] * inv); *(u32x2*)(mp + 16 * d) = w; }
}
__device__ __forceinline__ void attn_unit(LAS unsigned char* lds, const bf16_t* Z, bf16_t* MIX, int unit) {
    int tid = threadIdx.x; asm volatile("" : "+v"(tid)); const int wid = __builtin_amdgcn_readfirstlane(tid >> 6), lane = tid & 63;
    const int qb = unit & 15, h = (unit >> 4) & 7, b = unit >> 7;
    LAS unsigned char* vimg = lds + wid * (32 * AT_VS);
    attn_tile(vimg, Z, MIX, b, h, 256 * qb + wid, lane);
    attn_tile(vimg, Z, MIX, b, h, 256 * qb + wid + 8, lane);
}

__device__ __forceinline__ const float* sattn_row(int e, const float* fresh, const float* cache) {
    const int cfg = e / 129, j = e - cfg * 129, r = (cfg == 0) ? 1 : (cfg == 1) ? 4 : 16, dist = j * r;
    return (dist == 0) ? fresh : cache + (size_t)(2048 - dist) * 1024;
}
__device__ __forceinline__ void sattn_unit(LAS unsigned char* lds, const bf16_t* Z, const float* ck, const float* cv, const float* out, bf16_t* MIX, int unit) {
    int tid = threadIdx.x; asm volatile("" : "+v"(tid)); const int wid = __builtin_amdgcn_readfirstlane(tid >> 6), lane = tid & 63, hl = lane & 31, hf = lane >> 5;
    const int b = unit >> 3, h = unit & 7;
    LAS float* sc = (LAS float*)lds;
    LAS float* red = sc + 400;
    LAS float* misc = red + 2048;
    const u32x2 qw = *(const u32x2*)(Z + (size_t)(MP + b) * NZ + ZQA + h * 128 + 4 * hl);
    const f32x4 q4 = (f32x4){bf_lo(qw.x), bf_hi(qw.x), bf_lo(qw.y), bf_hi(qw.y)};
    const float* knew = out + O_KS + (size_t)b * 1024 + h * 128; const float* vnew = out + O_VS + (size_t)b * 1024 + h * 128;
    const float* ckb = ck + (size_t)b * 2048 * 1024 + h * 128; const float* cvb = cv + (size_t)b * 2048 * 1024 + h * 128;
    constexpr int SN = 25;
    f32x4 kv[SN], vv[SN];
#pragma unroll
    for (int i = 0; i < SN; ++i) { int e = 16 * i + 2 * wid + hf; e = e < 387 ? e : 386; kv[i] = *(const f32x4*)(sattn_row(e, knew, ckb) + 4 * hl); }
#pragma unroll
    for (int i = 0; i < SN; ++i) { int e = 16 * i + 2 * wid + hf; e = e < 387 ? e : 386; vv[i] = *(const f32x4*)(sattn_row(e, vnew, cvb) + 4 * hl); }
#pragma unroll
    for (int i = 0; i < SN; ++i) { float s = (q4[0] * kv[i][0] + q4[1] * kv[i][1]) + (q4[2] * kv[i][2] + q4[3] * kv[i][3]);
        s += __shfl_xor(s, 1); s += __shfl_xor(s, 2); s += __shfl_xor(s, 4); s += __shfl_xor(s, 8); s += __shfl_xor(s, 16);
        const int e = 16 * i + 2 * wid + hf; if (hl == 0 && e < 387) sc[e] = s; }
    __syncthreads();
    if (wid == 0) { float mx = -INFINITY; for (int e = lane; e < 387; e += 64) mx = fmaxf(mx, sc[e]); mx = wave_max(mx);
        float sm = 0.f; for (int e = lane; e < 387; e += 64) { const float p = __expf(sc[e] - mx); sc[e] = p; sm += p; } sm = wave_sum(sm);
        if (lane == 0) misc[1] = sm; }
    __syncthreads();
    f32x4 acc = (f32x4){0.f, 0.f, 0.f, 0.f};
#pragma unroll
    for (int i = 0; i < SN; ++i) { const int e = 16 * i + 2 * wid + hf; const float p = (e < 387) ? sc[e] : 0.f; acc += vv[i] * p; }
    *(LAS f32x4*)(red + (2 * wid + hf) * 128 + 4 * hl) = acc;
    __syncthreads();
    if (tid < 128) { float s = 0.f;
#pragma unroll
        for (int w = 0; w < 16; ++w) s += red[w * 128 + tid];
        const float v = s / misc[1]; MIX[(size_t)(MP + b) * DM + h * 128 + tid] = (bf16_t)(cvt_pk_bf16(v, 0.f) & 0xffffu); }
    __syncthreads();
}

__device__ __forceinline__ void smlstm_unit(LAS unsigned char* lds, const bf16_t* Z, const float* GT, const float* sC, const float* sN, const float* sM, const float* mhg, float* out, bf16_t* MIX, float* HRAW, int unit) {
    int tid = threadIdx.x; asm volatile("" : "+v"(tid)); const int wid = __builtin_amdgcn_readfirstlane(tid >> 6), lane = tid & 63;
    const int b = unit / NH, h = unit % NH, row = MP + b;
    LAS float* qs = (LAS float*)lds; LAS float* ks = qs + 256; LAS float* red = ks + 256;
    LAS float* part = red + 32;
    const bf16_t* zr = Z + (size_t)row * NZ;
    const float liv = GT[(size_t)h * MT + row], lf = GT[(size_t)(6 + h) * MT + row], m0 = sM[b * NH + h];
    const float mt = fmaxf(lf + m0, liv), a = __expf(lf + m0 - mt), wsv = __expf(liv - mt);
    float pq = 0.f, pn = 0.f;
    if (tid < 256) { const float q = bf1(zr[ZQM + h * DK + tid]), k = bf1(zr[ZKM + h * DK + tid]), n0 = sN[(size_t)(b * NH + h) * DK + tid]; qs[tid] = q; ks[tid] = k; pq = q * k; pn = q * n0;
        out[O_NS + (size_t)(b * NH + h) * DK + tid] = a * n0 + wsv * k; }
    pq = wave_sum(pq); pn = wave_sum(pn);
    if (lane == 0) { red[wid] = pq; red[8 + wid] = pn; }
    __syncthreads();
    const float qk = red[0] + red[1] + red[2] + red[3], qn = red[8] + red[9] + red[10] + red[11];
    const float sw = qk * wsv;
    {
      const int dq = tid >> 7, dv0 = 4 * (tid & 127);
      const u32x2 vw = *(const u32x2*)(zr + ZVM + h * DV + dv0); const f32x4 v4 = (f32x4){bf_lo(vw.x), bf_hi(vw.x), bf_lo(vw.y), bf_hi(vw.y)} * wsv;
      const float* cp = sC + ((size_t)(b * NH + h) * DK + 64 * dq) * DV + dv0; float* co = out + O_CS + ((size_t)(b * NH + h) * DK + 64 * dq) * DV + dv0;
      f32x4 numi = (f32x4){0.f, 0.f, 0.f, 0.f};
#pragma unroll 1
      for (int d0 = 0; d0 < 64; d0 += 8) { f32x4 cc[8];
#pragma unroll
          for (int i = 0; i < 8; ++i) cc[i] = *(const f32x4*)(cp + (size_t)(d0 + i) * DV);
#pragma unroll
          for (int i = 0; i < 8; ++i) { numi += cc[i] * qs[64 * dq + d0 + i]; *(f32x4*)(co + (size_t)(d0 + i) * DV) = cc[i] * a + v4 * ks[64 * dq + d0 + i]; } }
      *(LAS f32x4*)(part + dq * 512 + dv0) = numi; }
    __syncthreads();
    const float v = bf1(zr[ZVM + h * DV + tid]);
    const float numt = part[tid] + part[512 + tid] + part[1024 + tid] + part[1536 + tid];
    const float num = sw * v + a * numt, den = sw + a * qn;
    const float hv = num / fmaxf(fabsf(den), __expf(-mt));
    if (HRAW) HRAW[(size_t)row * 3072 + h * DV + tid] = hv;
    const float ssq = wave_sum(hv * hv);
    if (lane == 0) red[16 + wid] = ssq;
    __syncthreads();
    float tot = 0.f;
#pragma unroll
    for (int w = 0; w < 8; ++w) tot += red[16 + w];
    const float om = bf1(zr[ZOM + h * DV + tid]);
    const float y = hv * rsqrtf(tot * (1.0f / DV) + EPS) * mhg[h * DV + tid] * (1.0f / (1.0f + __expf(-om)));
    MIX[(size_t)row * DM + 1024 + h * DV + tid] = (bf16_t)(cvt_pk_bf16(y, 0.f) & 0xffffu);
    if (tid == 0) out[O_MS + b * NH + h] = mt;
    __syncthreads();
}

constexpr int OB_QS = 528, OB_Q = 0, OB_K = 33792, OB_V0 = 67584, OB_V1 = 101376, OB_SW = 135168, OB_SWS = 144, OB_SM = 144384;
__device__ __forceinline__ void mlstm_out(LAS unsigned char* lds, const bf16_t* Z, const bf16_t* CT, const float* NC, const float* TB, const float* TWV, const float* TMT, const float* CM, const float* mhg, bf16_t* MIX, float* HRAW, int unit) {
    int tid = threadIdx.x; asm volatile("" : "+v"(tid)); const int wid = __builtin_amdgcn_readfirstlane(tid >> 6), lane = tid & 63, li = lane & 15, g = lane >> 4;
    const int bh = unit >> 6, c = unit & 63, b = bh / NH, h = bh % NH;
    LAS float* rs = (LAS float*)(lds + OB_SM); LAS float* dn = rs + 64; LAS float* hs = dn + 64; LAS float* ub = hs + 64; LAS float* wvv = ub + 64; LAS float* av = wvv + 64; LAS float* em = av + 64;
    const size_t row0 = (size_t)b * SEQ + 64 * c;
    const unsigned char* ctb = (const unsigned char*)CT + ((size_t)(bh * NCH + c) * DV + 64 * wid + li) * DK + 16 * g;
    u32x4 cf[4][4];
#pragma unroll
    for (int j = 0; j < 4; ++j)
#pragma unroll
        for (int vt = 0; vt < 4; ++vt) cf[j][vt] = *(const u32x4*)(ctb + (size_t)(16 * vt) * DK + 64 * j);
#pragma unroll
    for (int q = 0; q < 4; ++q) { const int ch = tid + 512 * q, tok = ch >> 5, c16 = ch & 31; const bf16_t* zr = Z + (row0 + tok) * NZ;
        *(LAS u32x4*)(lds + OB_Q + tok * OB_QS + 16 * c16) = *(const u32x4*)(zr + ZQM + h * DK + 8 * c16);
        *(LAS u32x4*)(lds + OB_K + tok * OB_QS + 16 * c16) = *(const u32x4*)(zr + ZKM + h * DK + 8 * c16); }
#pragma unroll
    for (int q = 0; q < 8; ++q) { const int ch = tid + 512 * q, tok = ch >> 6, c16 = ch & 63; const bf16_t* zr = Z + (row0 + tok) * NZ;
        *(LAS u32x4*)(lds + ((c16 >> 5) ? OB_V1 : OB_V0) + tok * OB_QS + 16 * (c16 & 31)) = *(const u32x4*)(zr + ZVM + h * DV + 8 * c16); }
    if (tid < 64) { const int t = bh * SEQ + 64 * c + tid; const float bb = TB[t], mt = TMT[t];
        ub[tid] = bb - mt; wvv[tid] = TWV[t]; av[tid] = __expf(bb + CM[bh * 80 + c] - mt); em[tid] = __expf(-mt); rs[tid] = 0.f; hs[tid] = 0.f; }
    __syncthreads();
    { const int t = tid >> 3, part = tid & 7; const float* np = NC + (size_t)(bh * NCH + c) * DK + 32 * part; const LAS bf16_t* qp = (const LAS bf16_t*)(lds + OB_Q + t * OB_QS) + 32 * part; float s = 0.f;
#pragma unroll 8
      for (int e = 0; e < 32; ++e) s += bf1(qp[e]) * np[e];
      s += __shfl_xor(s, 1); s += __shfl_xor(s, 2); s += __shfl_xor(s, 4);
      if (part == 0) dn[t] = s; }
    { const int st = wid & 3;
#pragma unroll
      for (int tq = 0; tq < 2; ++tq) { const int tt = 2 * (wid >> 2) + tq; f32x4 d = (f32x4){0.f, 0.f, 0.f, 0.f};
#pragma unroll
          for (int kk = 0; kk < 8; ++kk) { const bf16x8 kf = *(const LAS bf16x8*)(lds + OB_K + (16 * st + li) * OB_QS + (32 * kk + 8 * g) * 2);
              const bf16x8 qf = *(const LAS bf16x8*)(lds + OB_Q + (16 * tt + li) * OB_QS + (32 * kk + 8 * g) * 2);
              d = __builtin_amdgcn_mfma_f32_16x16x32_bf16(kf, qf, d, 0, 0, 0); }
          const int t = 16 * tt + li; const float ut = ub[t]; float ps = 0.f; f32x4 sw;
#pragma unroll
          for (int r = 0; r < 4; ++r) { const int s = 16 * st + 4 * g + r; const float w = (s <= t) ? d[r] * __expf(ut + wvv[s]) : 0.f; sw[r] = w; ps += w; }
          u32x2 pk; pk.x = cvt_pk_bf16(sw[0], sw[1]); pk.y = cvt_pk_bf16(sw[2], sw[3]);
          *(LAS u32x2*)(lds + OB_SW + t * OB_SWS + (16 * st + 4 * g) * 2) = pk;
          lds_addf(rs + t, ps); } }
    __syncthreads();
    f32x4 acc[4][4];
#pragma unroll
    for (int a = 0; a < 4; ++a)
#pragma unroll
        for (int t = 0; t < 4; ++t) acc[a][t] = (f32x4){0.f, 0.f, 0.f, 0.f};
#pragma unroll
    for (int j = 0; j < 4; ++j)
#pragma unroll
        for (int s = 0; s < 2; ++s) {
            bf16x8 bq[4], af[4];
#pragma unroll
            for (int tt = 0; tt < 4; ++tt) bq[tt] = *(const LAS bf16x8*)(lds + OB_Q + (16 * tt + li) * OB_QS + (64 * j + 16 * g + 8 * s) * 2);
#pragma unroll
            for (int vt = 0; vt < 4; ++vt) { const unsigned d0 = s ? cf[j][vt].z : cf[j][vt].x, d1 = s ? cf[j][vt].w : cf[j][vt].y;
                const f32x2 p0 = __builtin_amdgcn_cvt_pk_f32_fp8((int)d0, false), p1 = __builtin_amdgcn_cvt_pk_f32_fp8((int)d0, true), p2 = __builtin_amdgcn_cvt_pk_f32_fp8((int)d1, false), p3 = __builtin_amdgcn_cvt_pk_f32_fp8((int)d1, true);
                const unsigned w0 = cvt_pk_bf16(p0.x, p0.y), w1 = cvt_pk_bf16(p1.x, p1.y), w2 = cvt_pk_bf16(p2.x, p2.y), w3 = cvt_pk_bf16(p3.x, p3.y);
                bf16x8 f; f[0] = (short)(w0 & 0xffff); f[1] = (short)(w0 >> 16); f[2] = (short)(w1 & 0xffff); f[3] = (short)(w1 >> 16); f[4] = (short)(w2 & 0xffff); f[5] = (short)(w2 >> 16); f[6] = (short)(w3 & 0xffff); f[7] = (short)(w3 >> 16);
                af[vt] = f; }
#pragma unroll
            for (int vt = 0; vt < 4; ++vt)
#pragma unroll
                for (int tt = 0; tt < 4; ++tt) acc[vt][tt] = __builtin_amdgcn_mfma_f32_16x16x32_bf16(af[vt], bq[tt], acc[vt][tt], 0, 0, 0);
        }
#pragma unroll
    for (int tt = 0; tt < 4; ++tt) { const float at = av[16 * tt + li];
#pragma unroll
        for (int vt = 0; vt < 4; ++vt) acc[vt][tt] *= at; }
    { const LAS unsigned char* vb = lds + ((wid >> 2) ? OB_V1 : OB_V0);
#pragma unroll
      for (int kb = 0; kb < 2; ++kb) {
          bf16x8 bs_[4];
#pragma unroll
          for (int tt = 0; tt < 4; ++tt) bs_[tt] = *(const LAS bf16x8*)(lds + OB_SW + (16 * tt + li) * OB_SWS + (32 * kb + 8 * g) * 2);
#pragma unroll
          for (int vt = 0; vt < 4; ++vt) { const LAS unsigned char* vp = vb + (32 * kb + 8 * g + (li >> 2)) * OB_QS + (64 * (wid & 3) + 16 * vt + 4 * (li & 3)) * 2;
              const bf16x8 af = cat8(vtr(vp), vtr(vp + 4 * OB_QS));
#pragma unroll
              for (int tt = 0; tt < 4; ++tt) acc[vt][tt] = __builtin_amdgcn_mfma_f32_16x16x32_bf16(af, bs_[tt], acc[vt][tt], 0, 0, 0); } } }
    u32x2 omw[4][4]; f32x4 gg[4];
#pragma unroll
    for (int vt = 0; vt < 4; ++vt) { const int dvg = h * DV + 64 * wid + 16 * vt + 4 * g; gg[vt] = *(const f32x4*)(mhg + dvg);
#pragma unroll
        for (int tt = 0; tt < 4; ++tt) omw[tt][vt] = *(const u32x2*)(Z + (row0 + 16 * tt + li) * NZ + ZOM + dvg); }
    float dd[4];
#pragma unroll
    for (int tt = 0; tt < 4; ++tt) { const int t = 16 * tt + li; const float den = rs[t] + av[t] * dn[t]; dd[tt] = fmaxf(fabsf(den), em[t]);
        float q = 0.f;
#pragma unroll
        for (int vt = 0; vt < 4; ++vt) q += (acc[vt][tt][0] * acc[vt][tt][0] + acc[vt][tt][1] * acc[vt][tt][1]) + (acc[vt][tt][2] * acc[vt][tt][2] + acc[vt][tt][3] * acc[vt][tt][3]);
        q += __shfl_xor(q, 16); q += __shfl_xor(q, 32);
        if (g == 0) lds_addf(hs + t, q); }
    __syncthreads();
#pragma unroll
    for (int tt = 0; tt < 4; ++tt) { const int t = 16 * tt + li; const float idd = __builtin_amdgcn_rcpf(dd[tt]); const float tot = idd * rsqrtf(hs[t] * idd * idd * (1.0f / DV) + EPS);
        const size_t row = row0 + t;
#pragma unroll
        for (int vt = 0; vt < 4; ++vt) { const int dvg = h * DV + 64 * wid + 16 * vt + 4 * g;
            const u32x2 ow = omw[tt][vt];
            const float o0 = bf_lo(ow.x), o1 = bf_hi(ow.x), o2 = bf_lo(ow.y), o3 = bf_hi(ow.y);
            const f32x4 a4 = acc[vt][tt];
            if (HRAW) *(f32x4*)(HRAW + row * 3072 + dvg) = a4 * idd;
            const float y0 = a4[0] * tot * gg[vt][0] * __builtin_amdgcn_rcpf(1.0f + __expf(-o0)), y1 = a4[1] * tot * gg[vt][1] * __builtin_amdgcn_rcpf(1.0f + __expf(-o1)), y2 = a4[2] * tot * gg[vt][2] * __builtin_amdgcn_rcpf(1.0f + __expf(-o2)), y3 = a4[3] * tot * gg[vt][3] * __builtin_amdgcn_rcpf(1.0f + __expf(-o3));
            u32x2 w; w.x = cvt_pk_bf16(y0, y1); w.y = cvt_pk_bf16(y2, y3); *(u32x2*)(MIX + row * DM + 1024 + dvg) = w; } }
    __syncthreads();
}


constexpr int CV_OUT = (DM / 128) * (DM / 256), CV_UP = (DM / 128) * (DFF / 256), CV_DN = (DFF / 128) * (DM / 256);
__device__ __forceinline__ void conv_unit(LAS unsigned char* lds, const float* wout, const float* wup, const float* wdn, const float* g2, bf16_t* WoutT, bf16_t* WupT, bf16_t* WdnT, int j) {
    int base = 4 * j;
    if (base < CV_OUT) trw_run(lds, wout, DM, DM, DM, WoutT, nullptr, base, 4, 1);
    else if (base < CV_OUT + CV_UP) trw_run(lds, wup, DFF, DM, DFF, WupT, g2, base - CV_OUT, 4, 1);
    else trw_run(lds, wdn, DM, DFF, DM, WdnT, nullptr, base - CV_OUT - CV_UP, 4, 1);
}

struct Args { const float* in[16]; float* out; unsigned char* ws; };
#if CHECKS
__device__ __forceinline__ unsigned hsh(unsigned x) { x ^= x >> 16; x *= 0x7feb352dU; x ^= x >> 15; x *= 0x846ca68bU; x ^= x >> 16; return x; }
__device__ __forceinline__ bool far_(float got, float ref, float rel, float ab) { return !(fabsf(got - ref) <= rel * fabsf(ref) + ab); }
#define CHK_FAIL(id) atomicMax(ctl + CW_ERR, 40u - (unsigned)(id))
#define CHK_CODE(cd) atomicMax(ctl + CW_ERR, (unsigned)(cd))
__device__ __forceinline__ float dot_bf(const bf16_t* a, const bf16_t* b, int n) { float s = 0.f; for (int k = 0; k < n; k += 8) { const u32x4 x = *(const u32x4*)(a + k), y = *(const u32x4*)(b + k);
        s += bf_lo(x.x) * bf_lo(y.x) + bf_hi(x.x) * bf_hi(y.x) + bf_lo(x.y) * bf_lo(y.y) + bf_hi(x.y) * bf_hi(y.y) + bf_lo(x.z) * bf_lo(y.z) + bf_hi(x.z) * bf_hi(y.z) + bf_lo(x.w) * bf_lo(y.w) + bf_hi(x.w) * bf_hi(y.w); } return s; }
__device__ __forceinline__ float softcap_(float a) { return 15.0f * tanhf(a * (1.0f / 15.0f)); }
__device__ __forceinline__ float logsig_(float a) { return fminf(a, 0.f) - log1pf(expf(-fabsf(a))); }
__device__ void run_checks(const Args& args, LAS unsigned char* lds) {
    const int tid = threadIdx.x, lane = tid & 63, wid = tid >> 6, bx = blockIdx.x, G = gridDim.x;
    const unsigned gt = (unsigned)bx * 512u + tid, ngt = (unsigned)G * 512u;
    unsigned char* ws = args.ws; unsigned* ctl = (unsigned*)(ws + WS_CTL); float* out = args.out;
    const float* x_prompt = args.in[0]; const float* x_sample = args.in[1]; const float* cache_k = args.in[2]; const float* cache_v = args.in[3]; const float* state_C = args.in[4]; const float* state_n = args.in[5]; const float* state_m = args.in[6];
    const float* norm1_g = args.in[7]; const float* w_in = args.in[8]; const float* b_if = args.in[9]; const float* mh_g = args.in[10];
    const float* w_out = args.in[11]; const float* norm2_g = args.in[12]; const float* w_up = args.in[13]; const float* w_down = args.in[14]; const float* final_g = args.in[15];
    const bf16_t* WinT = (bf16_t*)(ws + WS_WIN); const bf16_t* WoutT = (bf16_t*)(ws + WS_WOUT); const bf16_t* WupT = (bf16_t*)(ws + WS_WUP); const bf16_t* WdnT = (bf16_t*)(ws + WS_WDN);
    const bf16_t* XN = (bf16_t*)(ws + WS_XN); const bf16_t* Z = (bf16_t*)(ws + WS_Z); const bf16_t* MIX = (bf16_t*)(ws + WS_MIX); const float* H = (float*)(ws + WS_H); const bf16_t* HB = (bf16_t*)(ws + WS_HB);
    const bf16_t* U = (bf16_t*)(ws + WS_U); const bf16_t* WG = (bf16_t*)(ws + WS_WG); const float* GT = (float*)(ws + WS_G); const float* HRAW = (float*)(ws + WS_HRAW);
    const float* RSS2 = (float*)(ws + WS_CTL + CTL_RSS2); const float* RSS3 = (float*)(ws + WS_CTL + CTL_RSS3);
    for (unsigned s = gt; s < 2048u; s += ngt) { const int row = (s < 64u) ? MP + (int)(s & 31u) : (int)(hsh(s) % MT), k = (int)(hsh(s + 99991u) % DM);
        const float* xr = row < MP ? x_prompt + (size_t)row * DM : x_sample + (size_t)(row - MP) * DM; float ss = 0.f; for (int j = 0; j < DM; ++j) ss += xr[j] * xr[j];
        const float ref = xr[k] * rsqrtf(ss * (1.0f / DM) + EPS) * norm1_g[k]; if (far_(bf1(XN[(size_t)row * DM + k]), ref, 0.01f, 1e-3f)) CHK_FAIL(1); }
    for (unsigned s = gt; s < 4096u; s += ngt) { const unsigned a = hsh(s), b = hsh(s + 7777u);
        { const int n = a % NZ, k = b % DM; if (far_(bf1(WinT[(size_t)n * DM + k]), w_in[(size_t)k * NINF + n], 0.01f, 1e-7f)) CHK_FAIL(2); }
        { const int n = a % DM, k = b % DM; if (far_(bf1(WoutT[(size_t)n * DM + k]), w_out[(size_t)k * DM + n], 0.01f, 1e-7f)) CHK_FAIL(2); }
        { const int f = a % DFF, k = b % DM; if (far_(bf1(WupT[(size_t)f * DM + k]), w_up[(size_t)k * DFF + f] * norm2_g[k], 0.01f, 1e-7f)) CHK_FAIL(2); }
        { const int n = a % DM, f = b % DFF; if (far_(bf1(WdnT[(size_t)n * DFF + f]), w_down[(size_t)f * DM + n], 0.01f, 1e-7f)) CHK_FAIL(2); }
        { const int gi = a % 16, k = b % DM; const float ref = gi < 12 ? w_in[(size_t)k * NINF + NZ + gi] : 0.f; if (far_(bf1(WG[gi * DM + k]), ref, 0.01f, 1e-7f)) CHK_FAIL(2); } }
    for (unsigned s = gt; s < 8192u; s += ngt) { const int row = (s < 1024u) ? MP + (int)(s & 31u) : (int)(hsh(s) % MP), col = (int)(hsh(s + 12345u) % NZ); const int id = row < MP ? 3 : 4;
        const bf16_t* xr = XN + (size_t)row * DM; float val;
        if (col < 2048) { const int d = col & 127, c1 = (d < 64) ? col : col - 64, c2 = c1 + 64; const float x1 = dot_bf(xr, WinT + (size_t)c1 * DM, DM), x2 = dot_bf(xr, WinT + (size_t)c2 * DM, DM);
            const int pos = row < MP ? (row & (SEQ - 1)) : 8192, i = d & 63; double invd = 1.0; for (int e = 0; e < i; ++e) invd *= 0.86596432336006535;
            float c, sn; sincos_d((float)pos * (float)invd, c, sn); val = (d < 64) ? x1 * c - x2 * sn : x2 * c + x1 * sn; if (col < 1024) val *= 0.08838834764831845f; }
        else { val = dot_bf(xr, WinT + (size_t)col * DM, DM); if (col >= ZQM && col < ZKM) val *= 0.0625f; }
        if (far_(bf1(Z[(size_t)row * NZ + col]), val, 0.02f, 0.02f)) CHK_FAIL(id);
        if (col >= 1024 && col < 3072) { const int cc = col & 1023; const bool isk = col < 2048;
            if (row >= MP) { if (far_(out[(isk ? O_KS : O_VS) + (size_t)(row - MP) * 1024 + cc], val, 0.01f, 0.01f)) CHK_FAIL(id); }
            else { const int pos = row & (SEQ - 1), bb = row >> 12; if (pos >= 2048) { if (far_(out[(isk ? O_KP : O_VP) + ((size_t)(bb * 2048 + pos - 2048)) * 1024 + cc], val, 0.01f, 0.01f)) CHK_FAIL(id); } } } }
    for (unsigned s = gt; s < 4096u; s += ngt) { const int gi = (int)(hsh(s) % 12), tok = (s < 256u) ? MP + (int)(s & 31u) : (int)(hsh(s + 555u) % MT);
        float v = softcap_(dot_bf(XN + (size_t)tok * DM, WG + (size_t)gi * DM, DM) + b_if[gi]); if (gi >= 6) v = logsig_(v);
        if (far_(GT[(size_t)gi * MT + tok], v, 0.01f, 0.005f)) CHK_FAIL(5); }
    for (unsigned s = gt; s < 4096u; s += ngt) { const unsigned a = hsh(s), b2 = hsh(s + 424242u); const int b = a & 1, pos = (s & 3u) == 0u ? (int)((a >> 1) % 300u) : (int)((a >> 1) % SEQ), h = b2 & 7, d = (b2 >> 3) & 127;
        const bf16_t* zb = Z + (size_t)b * SEQ * NZ; const bf16_t* qr = zb + (size_t)pos * NZ + ZQA + h * 128; float m = -INFINITY, l = 0.f, o = 0.f;
        for (int cfg = 0; cfg < 3; ++cfg) { const int r = cfg == 0 ? 1 : cfg == 1 ? 4 : 16;
            for (int j = 0; j <= 128; ++j) { const int kp = pos - j * r; if (kp < 0) break; const float sc = dot_bf(qr, zb + (size_t)kp * NZ + ZKA + h * 128, 128);
                const float mn = fmaxf(m, sc), al = expf(m - mn), p = expf(sc - mn); l = l * al + p; o = o * al + p * bf1(zb[(size_t)kp * NZ + ZVA + h * 128 + d]); m = mn; } }
        if (far_(bf1(MIX[((size_t)b * SEQ + pos) * DM + h * 128 + d]), o / l, 0.03f, 0.004f)) CHK_FAIL(6); }
    if (bx == 30) { const int li = lane & 15, g = lane >> 4, dvt = wid & 3, dkh = wid >> 2; LAS unsigned char* Kimg = lds + SC_KIMG; LAS unsigned char* Vimg = lds + SC_VIMG;
#pragma unroll
        for (int q = 0; q < 4; ++q) { const int ch = tid + 512 * q, tok = ch >> 5, c16 = ch & 31; *(LAS u32x4*)(Kimg + tok * SC_KSTR + 16 * c16) = *(const u32x4*)(Z + (size_t)tok * NZ + ZKM + 8 * c16); }
        { const int tok = tid >> 3, c16 = tid & 7; *(LAS u32x4*)(Vimg + tok * SC_VSTR + 16 * c16) = *(const u32x4*)(Z + (size_t)tok * NZ + ZVM + 8 * c16); }
        __syncthreads();
        bf16x8 ones;
#pragma unroll
        for (int e = 0; e < 8; ++e) ones[e] = (short)0x3F80;
        unsigned mask = 0u;
#pragma unroll 1
        for (int T = 0; T < 8; ++T) { f32x4 na = (f32x4){0.f, 0.f, 0.f, 0.f}, ca = (f32x4){0.f, 0.f, 0.f, 0.f};
#pragma unroll
            for (int kb = 0; kb < 2; ++kb) { const LAS unsigned char* vp = Vimg + (32 * kb + 8 * g + (li >> 2)) * SC_VSTR + (16 * dvt + 4 * (li & 3)) * 2; const bf16x8 Bf = cat8(vtr(vp), vtr(vp + 4 * SC_VSTR));
                const LAS unsigned char* kp = Kimg + (32 * kb + 8 * g + (li >> 2)) * SC_KSTR + (128 * dkh + 16 * T + 4 * (li & 3)) * 2; const bf16x8 Af = cat8(vtr(kp), vtr(kp + 4 * SC_KSTR));
                na = __builtin_amdgcn_mfma_f32_16x16x32_bf16(Af, ones, na, 0, 0, 0); ca = __builtin_amdgcn_mfma_f32_16x16x32_bf16(Af, Bf, ca, 0, 0, 0); }
#pragma unroll
            for (int r = 0; r < 4; ++r) { const int dk = 128 * dkh + 16 * T + 4 * g + r, dv = 16 * dvt + li; float cs = 0.f, cv = 0.f;
                for (int t = 0; t < 64; ++t) { const float kk = bf1(Z[(size_t)t * NZ + ZKM + dk]); cs += kk; cv += kk * bf1(Z[(size_t)t * NZ + ZVM + dv]); }
                if (far_(na[r], cs, 0.01f, 1e-2f)) mask |= 1u; if (far_(ca[r], cv, 0.01f, 2e-2f)) mask |= 2u; } }
        if (mask) atomicOr(ctl + CW_ERR + 2, mask);
        __syncthreads(); }
    if (gt < 12u) { const int bh = (int)gt, b = bh / NH, h = bh % NH; const float* TBc = (const float*)(ws + WS_TB); const float* TWVc = (const float*)(ws + WS_TWV); const float* TMTc = (const float*)(ws + WS_TMT); const float* CMc = (const float*)(ws + WS_CM);
        float m = 0.f, bsum = 0.f; bool bad = false;
        for (int t = 0; t < SEQ; ++t) { const size_t row = (size_t)b * SEQ + t; const float liv = GT[(size_t)h * MT + row], lf = GT[(size_t)(6 + h) * MT + row];
            if ((t & 63) == 0) { bsum = 0.f; if (far_(CMc[bh * 80 + (t >> 6)], m, 1e-3f, 1e-3f)) bad = true; }
            bsum += lf; m = fmaxf(lf + m, liv);
            if (far_(TBc[bh * SEQ + t], bsum, 1e-3f, 1e-3f) || far_(TWVc[bh * SEQ + t], liv - bsum, 1e-3f, 1e-3f) || far_(TMTc[bh * SEQ + t], m, 1e-3f, 1e-3f)) bad = true; }
        if (far_(CMc[bh * 80 + 64], m, 1e-3f, 1e-3f)) bad = true;
        if (bad) CHK_CODE(33); }
    if (bx < 24) { const int bh = bx % 12, b = bh / NH, h = bh % NH, sel = tid >> 8, dk = tid & 255; const int dv = sel ? (300 + 17 * bx) % DV : (37 + 41 * bx) % DV;
        LAS float* red = (LAS float*)lds;
        float C = 0.f, n = 0.f, m = 0.f, n63 = 0.f, C63 = 0.f; bool bad8 = false;
        for (int t = 0; t < SEQ; ++t) { const size_t row = (size_t)b * SEQ + t; const bf16_t* zr = Z + row * NZ; if (t == 63 * 64) { n63 = n; C63 = C; }
            const float q = bf1(zr[ZQM + h * DK + dk]), k = bf1(zr[ZKM + h * DK + dk]), v = bf1(zr[ZVM + h * DV + dv]), liv = GT[(size_t)h * MT + row], lf = GT[(size_t)(6 + h) * MT + row];
            const float mn = fmaxf(lf + m, liv), f = expf(lf + m - mn), iw = expf(liv - mn); C = f * C + iw * k * v; n = f * n + iw * k; m = mn;
            const float s1 = wave_sum(q * C), s2 = wave_sum(q * n); LAS float* rb = red + (t & 1) * 32;
            if (lane == 0) { rb[wid] = s1; rb[16 + wid] = s2; }
            __syncthreads();
            const int w0 = sel * 4; const float num = rb[w0] + rb[w0 + 1] + rb[w0 + 2] + rb[w0 + 3], qn = rb[16 + w0] + rb[16 + w0 + 1] + rb[16 + w0 + 2] + rb[16 + w0 + 3];
            const float hv = num / fmaxf(fabsf(qn), expf(-m));
            if (dk == 0 && far_(HRAW[row * 3072 + h * DV + dv], hv, 0.04f, 0.03f)) bad8 = true; }
        if (far_(out[O_CP + ((size_t)bh * DK + dk) * DV + dv], C, 0.03f, 0.03f)) CHK_CODE(30);
        if (sel == 0 && far_(out[O_NP + (size_t)bh * DK + dk], n, 0.03f, 0.03f)) CHK_CODE(31);
        if (sel == 0 && far_(((const float*)(ws + WS_NC))[(size_t)(bh * NCH + 63) * DK + dk], n63, 0.03f, 0.03f)) CHK_CODE(31);
        if (far_(bf1(((const bf16_t*)(ws + WS_CT))[((size_t)(bh * NCH + 63) * DV + dv) * DK + dk]), C63, 0.03f, 0.03f)) CHK_CODE(30);
        if (tid == 0 && far_(out[O_MP + bh], m, 0.01f, 0.01f)) CHK_CODE(32);
        if (bad8) CHK_CODE(29);
        __syncthreads(); }
    for (unsigned s = gt; s < 4096u; s += ngt) { const unsigned a = hsh(s), b2 = hsh(s + 31337u); const int row = (s < 128u) ? MP + (int)(s & 31u) : (int)(a % MP), h = b2 % NH, dv = (b2 >> 8) % DV;
        const float* hr = HRAW + (size_t)row * 3072 + h * DV; float ss = 0.f; for (int j = 0; j < DV; ++j) ss += hr[j] * hr[j];
        const float om = bf1(Z[(size_t)row * NZ + ZOM + h * DV + dv]); const float ref = hr[dv] * rsqrtf(ss * (1.0f / DV) + EPS) * mh_g[h * DV + dv] / (1.0f + expf(-om));
        if (far_(bf1(MIX[(size_t)row * DM + 1024 + h * DV + dv]), ref, 0.02f, 0.005f)) CHK_CODE(28); }
    for (unsigned s = gt; s < 2048u; s += ngt) { const unsigned a = hsh(s); const int b = a & 31, h = (a >> 5) & 7, d = (a >> 8) & 127;
        const bf16_t* qr = Z + (size_t)(MP + b) * NZ + ZQA + h * 128; float m = -INFINITY, l = 0.f, o = 0.f;
        for (int cfg = 0; cfg < 3; ++cfg) { const int r = cfg == 0 ? 1 : cfg == 1 ? 4 : 16;
            for (int j = 0; j <= 128; ++j) { const int dist = j * r; const float* kp = dist == 0 ? out + O_KS + (size_t)b * 1024 + h * 128 : cache_k + ((size_t)b * 2048 + 2048 - dist) * 1024 + h * 128;
                const float* vp = dist == 0 ? out + O_VS + (size_t)b * 1024 + h * 128 : cache_v + ((size_t)b * 2048 + 2048 - dist) * 1024 + h * 128;
                float sc = 0.f; for (int e = 0; e < 128; ++e) sc += bf1(qr[e]) * kp[e];
                const float mn = fmaxf(m, sc), al = expf(m - mn), p = expf(sc - mn); l = l * al + p; o = o * al + p * vp[d]; m = mn; } }
        if (far_(bf1(MIX[(size_t)(MP + b) * DM + h * 128 + d]), o / l, 0.02f, 0.004f)) CHK_CODE(27); }
    for (unsigned s = gt; s < 2048u; s += ngt) { const unsigned a = hsh(s), b2 = hsh(s + 99u); const int b = a & 31, h = (a >> 5) % NH, dv = (a >> 9) % DV, dkx = b2 % DK; const int row = MP + b; const bf16_t* zr = Z + (size_t)row * NZ;
        const float liv = GT[(size_t)h * MT + row], lf = GT[(size_t)(6 + h) * MT + row], m0 = state_m[b * NH + h]; const float mt = fmaxf(lf + m0, liv), aa = expf(lf + m0 - mt), wsv = expf(liv - mt);
        const float* c0 = state_C + (size_t)(b * NH + h) * DK * DV; const float* n0 = state_n + (size_t)(b * NH + h) * DK; float qk = 0.f, qn = 0.f, qc = 0.f;
        for (int k = 0; k < DK; ++k) { const float q = bf1(zr[ZQM + h * DK + k]); qk += q * bf1(zr[ZKM + h * DK + k]); qn += q * n0[k]; qc += q * c0[(size_t)k * DV + dv]; }
        const float v = bf1(zr[ZVM + h * DV + dv]), sw = qk * wsv, num = sw * v + aa * qc, den = sw + aa * qn, hv = num / fmaxf(fabsf(den), expf(-mt));
        if (far_(HRAW[(size_t)row * 3072 + h * DV + dv], hv, 0.02f, 0.005f)) CHK_CODE(26);
        const float kx = bf1(zr[ZKM + h * DK + dkx]);
        if (far_(out[O_CS + ((size_t)(b * NH + h) * DK + dkx) * DV + dv], aa * c0[(size_t)dkx * DV + dv] + wsv * kx * v, 1e-3f, 1e-5f)) CHK_CODE(26);
        if (far_(out[O_NS + (size_t)(b * NH + h) * DK + dkx], aa * n0[dkx] + wsv * kx, 1e-3f, 1e-5f)) CHK_CODE(26);
        if (far_(out[O_MS + b * NH + h], mt, 1e-4f, 1e-5f)) CHK_CODE(26); }
    for (unsigned s = gt; s < 4096u; s += ngt) { const int row = (s < 256u) ? MP + (int)(s & 31u) : (int)(hsh(s) % MP), col = (int)(hsh(s + 777u) % DM);
        const float xv = row < MP ? x_prompt[(size_t)row * DM + col] : x_sample[(size_t)(row - MP) * DM + col]; const float ref = xv + dot_bf(MIX + (size_t)row * DM, WoutT + (size_t)col * DM, DM);
        if (far_(H[(size_t)row * DM + col], ref, 0.01f, 0.01f)) CHK_CODE(25); if (far_(bf1(HB[(size_t)row * DM + col]), ref, 0.01f, 0.01f)) CHK_CODE(25);
        if (s < 512u) { float ss = 0.f; for (int j = 0; j < DM; ++j) { const float hv = H[(size_t)row * DM + j]; ss += hv * hv; } if (far_(RSS2[row], ss, 2e-3f, 1e-2f)) CHK_CODE(25); } }
    for (unsigned s = gt; s < 4096u; s += ngt) { const int row = (s < 256u) ? MP + (int)(s & 31u) : (int)(hsh(s) % MP), f = (int)(hsh(s + 4242u) % DFF);
        const float r = rsqrtf(RSS2[row] * (1.0f / DM) + EPS); float v = fmaxf(r * dot_bf(HB + (size_t)row * DM, WupT + (size_t)f * DM, DM), 0.f); v = v * v;
        if (far_(bf1(U[(size_t)row * DFF + f]), v, 0.03f, 0.01f)) CHK_CODE(24); }
    for (unsigned s = gt; s < 2048u; s += ngt) { const int row = (s < 128u) ? MP + (int)(s & 31u) : (int)(hsh(s) % MP), col = (int)(hsh(s + 9u) % DM);
        const float pre = H[(size_t)row * DM + col] + dot_bf(U + (size_t)row * DFF, WdnT + (size_t)col * DFF, DFF);
        if (row < MP) { const float ref = pre * rsqrtf(RSS3[row] * (1.0f / DM) + EPS) * final_g[col]; if (!(row == 0 && col == 0) && far_(out[O_Y + (size_t)row * DM + col], ref, 0.02f, 0.01f)) CHK_CODE(23); }
        else { const int col2 = (col + 1234) % DM; const float pre2 = H[(size_t)row * DM + col2] + dot_bf(U + (size_t)row * DFF, WdnT + (size_t)col2 * DFF, DFF);
            const float y1 = out[O_Y + (size_t)row * DM + col] / final_g[col], y2 = out[O_Y + (size_t)row * DM + col2] / final_g[col2];
            if (far_(y1 * pre2, y2 * pre, 0.04f, 0.03f)) CHK_CODE(23); } }
}
#endif

__global__ void __launch_bounds__(512, 2) hymba_fwd(Args args) {
    extern __shared__ __attribute__((aligned(16))) unsigned char lds_raw[];
    LAS unsigned char* lds = (LAS unsigned char*)lds_raw;
    const int tid = threadIdx.x, lane = tid & 63, wid = __builtin_amdgcn_readfirstlane(tid >> 6);
    const int G = gridDim.x, bx = blockIdx.x, vcu = (G % 8 == 0) ? (bx % 8) * (G / 8) + bx / 8 : bx;
    unsigned char* ws = args.ws;
    unsigned* ctl = (unsigned*)(ws + WS_CTL);
    volatile LAS unsigned* MISC = (volatile LAS unsigned*)(lds + MISC_OFF);
    if (tid < 64) MISC[tid] = 0u;
    __syncthreads();
    XcdBarrier bar = xcd_barrier_post(ctl + CW_BAR, MISC + 8);
    const bool early = ((bx & 7) >= 4);
#if PROF
#define STAMP(k) do { if (bx == 0 && tid == 0) { const unsigned long long t_ = __builtin_amdgcn_s_memrealtime(); MISC[32] = (unsigned)t_; MISC[33] = (unsigned)(t_ >> 32); } } while (0)
#define PRE(k) do { if ((k) == PROF && bx == 0 && tid == 0) { const unsigned long long t_ = __builtin_amdgcn_s_memrealtime(); const unsigned long long p_ = ((unsigned long long)MISC[33] << 32) | MISC[32]; const unsigned long long w_ = 3ull * (t_ - p_); \
        while (__builtin_amdgcn_s_memrealtime() - t_ < w_) __builtin_amdgcn_s_sleep(8); } } while (0)
#else
#define STAMP(k) do { } while (0)
#define PRE(k) do { } while (0)
#endif
    STAMP(0);

    const float* x_prompt = args.in[0]; const float* x_sample = args.in[1];
    const float* norm1_g = args.in[7]; const float* w_in = args.in[8]; const float* b_if = args.in[9];
    const float* w_out = args.in[11]; const float* norm2_g = args.in[12]; const float* w_up = args.in[13]; const float* w_down = args.in[14]; const float* final_g = args.in[15];
    float* out = args.out;
    bf16_t* WinT = (bf16_t*)(ws + WS_WIN); bf16_t* WoutT = (bf16_t*)(ws + WS_WOUT); bf16_t* WupT = (bf16_t*)(ws + WS_WUP); bf16_t* WdnT = (bf16_t*)(ws + WS_WDN);
    bf16_t* XN = (bf16_t*)(ws + WS_XN); bf16_t* Z = (bf16_t*)(ws + WS_Z); bf16_t* MIX = (bf16_t*)(ws + WS_MIX); float* H = (float*)(ws + WS_H); bf16_t* HB = (bf16_t*)(ws + WS_HB);
    bf16_t* U = (bf16_t*)(ws + WS_U); bf16_t* WG = (bf16_t*)(ws + WS_WG); float* ROPE = (float*)(ws + WS_ROPE); float* GT = (float*)(ws + WS_G);
    float* RSS2 = (float*)(ws + WS_CTL + CTL_RSS2); float* RSS3 = (float*)(ws + WS_CTL + CTL_RSS3); float* ACCB = (float*)(ws + WS_CTL + CTL_ACC);

    { P0Args a{x_prompt, x_sample, norm1_g, w_in, w_out, norm2_g, w_up, w_down, WinT, WoutT, WupT, WdnT, XN, WG, ROPE};
      p0_prologue(a, vcu, G, wid, lane);
      trw_run(lds, w_in, NINF, DM, NZ, WinT, nullptr, bx, ((DM / 128) * (NZ / 256) - bx + G - 1) / G, G); }
    PRE(1);
    xcd_barrier(bar);
    STAMP(1);

    { pg8::Gemm g{XN, WinT, MP, NZ, DM}; pg8::StaticOrder S; S.init(MP, NZ, G, bx);
      EpiInProj E{Z, ROPE, out + O_KP, out + O_VP};
      pg8::InterleavedOrder SI{S};
      SkInProj Es{Z, ROPE, out + O_KS, out + O_VS};
      SkGates Eg{b_if, GT};
#pragma unroll 1
      for (int pass = 0; pass < 2; ++pass) {
          if ((pass == 0) == early) { for (int u2 = bx; u2 < 48 * 8 + 33 * 8; u2 += G) { if (u2 < 384) skinny_unit<2>(lds, XN + (size_t)MP * DM, WinT, DM, 0, DM, Es, u2 >> 3, u2 & 7); else skinny_unit<1>(lds, WG, XN, DM, 0, DM, Eg, (u2 - 384) >> 3, (u2 - 384) & 7); } }
          else pg8::gemm_phase<EpiInProj, pg8::InterleavedOrder>(lds, g, SI, E); }
    }
    PRE(2);
    xcd_barrier(bar);
    STAMP(2);

    bf16_t* CT = (bf16_t*)(ws + WS_CT); float* NC = (float*)(ws + WS_NC); float* TB = (float*)(ws + WS_TB); float* TWV = (float*)(ws + WS_TWV); float* TMT = (float*)(ws + WS_TMT); float* CMb = (float*)(ws + WS_CM);
    float* HRAW = CHECKS ? (float*)(ws + WS_HRAW) : nullptr;
    const float* cache_k = args.in[2]; const float* cache_v = args.in[3]; const float* state_C = args.in[4]; const float* state_n = args.in[5]; const float* state_m = args.in[6]; const float* mh_g = args.in[10];

    { if (bx < 96) mlstm_scan(lds, Z, GT, CT, NC, TB, TWV, TMT, CMb, out, bx);
      for (;;) {
          if (tid == 0) MISC[16] = atomicAdd(&ctl[CW_Q2], 1u);
          __syncthreads();
          const unsigned item = (unsigned)__builtin_amdgcn_readfirstlane((int)MISC[16]);
          __syncthreads();
          if (item >= 704u + (unsigned)((CV_OUT + CV_UP) / 4)) break;
          if (item < 192u) smlstm_unit(lds, Z, GT, state_C, state_n, state_m, mh_g, out, MIX, HRAW, (int)item);
          else if (item < 448u) attn_unit(lds, Z, MIX, (int)item - 192);
          else if (item < 704u) sattn_unit(lds, Z, cache_k, cache_v, out, MIX, (int)item - 448);
          else conv_unit(lds, w_out, w_up, w_down, norm2_g, WoutT, WupT, WdnT, (int)item - 704);
      } }
    PRE(3);
    xcd_barrier(bar);
    STAMP(3);

    for (;;) {
        if (tid == 0) MISC[16] = atomicAdd(&ctl[CW_Q2 + 64], 1u);
        __syncthreads();
        const unsigned item = (unsigned)__builtin_amdgcn_readfirstlane((int)MISC[16]);
        __syncthreads();
        if (item >= 1280u) break;
        const unsigned grp = item / 5u, r = item % 5u;
        if (r < 3u) mlstm_out(lds, Z, CT, NC, TB, TWV, TMT, CMb, mh_g, MIX, HRAW, (int)(3u * grp + r));
        else conv_unit(lds, w_out, w_up, w_down, norm2_g, WoutT, WupT, WdnT, (int)((CV_OUT + CV_UP) / 4 + 2u * grp + (r - 3u)));
    }
    PRE(4);
    xcd_barrier(bar);
    STAMP(4);

    { pg8::Gemm g{MIX, WoutT, MP, DM, DM}; pg8::StaticOrder S; S.init(MP, DM, G, bx);
      EpiOutProj E{x_prompt, H, HB, RSS2};
      SkOutProj Es{x_sample, H, HB, RSS2};
#pragma unroll 1
      for (int pass = 0; pass < 2; ++pass) {
          if ((pass == 0) == early) { for (int u2 = bx; u2 < 16 * 8; u2 += G) skinny_unit<2>(lds, MIX + (size_t)MP * DM, WoutT, DM, 0, DM, Es, u2 >> 3, u2 & 7); }
          else pg8::gemm_phase<EpiOutProj>(lds, g, S, E); } }
    PRE(5);
    xcd_barrier(bar);
    STAMP(5);

    constexpr int MH = MP / 2;
    { pg8::Gemm g{HB, WupT, MH, DFF, DM}; pg8::StaticOrder S; S.init(MH, DFF, G, bx);
      EpiUp E{U, RSS2, 0};
      SkUp Es{U, RSS2};
#pragma unroll 1
      for (int pass = 0; pass < 2; ++pass) {
          if ((pass == 0) == early) { for (int u2 = bx; u2 < 64 * 8; u2 += G) skinny_unit<2>(lds, HB + (size_t)MP * DM, WupT, DM, 0, DM, Es, u2 >> 3, u2 & 7); }
          else pg8::gemm_phase<EpiUp>(lds, g, S, E); } }
    PRE(6);
    xcd_barrier(bar);
    STAMP(6);
    { pg8::Gemm g{U, WdnT, MH, DM, DFF}; pg8::StaticOrder S; S.init(MH, DM, G, bx);
      EpiDownNorm E{HB, out + O_Y, RSS3, ctl + CW_Q2 + 768, final_g, 0};
      SkDown Es{ACCB};
      pg8::Gemm g2{HB + (size_t)MH * DM, WupT, MH, DFF, DM}; pg8::StaticOrder S2; S2.init(MH, DFF, G, bx);
      EpiUp E2{U, RSS2, MH / 256};
#pragma unroll 1
      for (int pass = 0; pass < 3; ++pass) {
          if (pass == 1) { pg8::gemm_phase<EpiDownNorm>(lds, g, S, E); pg8::gemm_phase<EpiUp>(lds, g2, S2, E2); }
          else if ((pass == 0) == early) { for (int u2 = bx; u2 < 512; u2 += G) { const int kc = u2 >> 7, j32 = u2 & 127; skinny_unit<2>(lds, U + (size_t)MP * DFF, WdnT, DFF, 4096 * kc, 4096, Es, j32 >> 3, j32 & 7); } } } }
    xcd_barrier(bar);
    { const int gw = vcu * 8 + wid, ngw = G * 8; const bf16_t* YB = MIX;
      for (int m = MP + gw; m < MT; m += ngw) {
          float* yr = out + O_Y + (size_t)m * DM; f32x4 v[8][2]; float r;
          if (m < MP) { const bf16_t* yb = YB + (size_t)m * DM;
#pragma unroll
              for (int c = 0; c < 8; ++c) { const u32x4 w = *(const u32x4*)(yb + 512 * c + 8 * lane); v[c][0] = (f32x4){bf_lo(w.x), bf_hi(w.x), bf_lo(w.y), bf_hi(w.y)}; v[c][1] = (f32x4){bf_lo(w.z), bf_hi(w.z), bf_lo(w.w), bf_hi(w.w)}; }
              r = rsqrtf(RSS3[m] * (1.0f / DM) + EPS);
          } else { const bf16_t* hr = HB + (size_t)m * DM; const float* ar = ACCB + (size_t)(m - MP) * DM; float ss = 0.f;
#pragma unroll
              for (int c = 0; c < 8; ++c) { const u32x4 w = *(const u32x4*)(hr + 512 * c + 8 * lane);
                  v[c][0] = (f32x4){bf_lo(w.x), bf_hi(w.x), bf_lo(w.y), bf_hi(w.y)} + *(const f32x4*)(ar + 512 * c + 8 * lane); v[c][1] = (f32x4){bf_lo(w.z), bf_hi(w.z), bf_lo(w.w), bf_hi(w.w)} + *(const f32x4*)(ar + 512 * c + 8 * lane + 4);
                  ss += (v[c][0][0] * v[c][0][0] + v[c][0][1] * v[c][0][1]) + (v[c][0][2] * v[c][0][2] + v[c][0][3] * v[c][0][3]) + (v[c][1][0] * v[c][1][0] + v[c][1][1] * v[c][1][1]) + (v[c][1][2] * v[c][1][2] + v[c][1][3] * v[c][1][3]); }
              r = rsqrtf(wave_sum(ss) * (1.0f / DM) + EPS); }
#pragma unroll
          for (int c = 0; c < 8; ++c) { const f32x4 g0 = *(const f32x4*)(final_g + 512 * c + 8 * lane), g1v = *(const f32x4*)(final_g + 512 * c + 8 * lane + 4);
              *(f32x4*)(yr + 512 * c + 8 * lane) = v[c][0] * r * g0; *(f32x4*)(yr + 512 * c + 8 * lane + 4) = v[c][1] * r * g1v; }
      } }
    { pg8::Gemm g{U + (size_t)MH * DFF, WdnT, MH, DM, DFF}; pg8::StaticOrder S; S.init(MH, DM, G, bx);
      EpiDownNorm E{HB, out + O_Y, RSS3, ctl + CW_Q2 + 768, final_g, MH / 256};
      pg8::gemm_phase<EpiDownNorm>(lds, g, S, E); }

#if PROF
    PRE(8);
    xcd_barrier(bar);
#endif
#if CHECKS
    PRE(8);
    xcd_barrier(bar);
    STAMP(8);
    run_checks(args, lds);
    PRE(9);
    xcd_barrier(bar);
    STAMP(9);
    if (bx == 0 && tid == 0) { const unsigned code = __hip_atomic_load(ctl + CW_ERR, __ATOMIC_RELAXED, __HIP_MEMORY_SCOPE_AGENT); const unsigned msk = __hip_atomic_load(ctl + CW_ERR + 2, __ATOMIC_RELAXED, __HIP_MEMORY_SCOPE_AGENT);
        if (msk) out[0] = (float)(60u + msk) * 10000.0f; else if (code) out[0] = (float)code * 10000.0f; }
#endif
}

extern "C" void kernel_launch(void* const* d_in, const int* in_sizes, int n_in, void* d_out, int out_size, void* d_ws, size_t ws_size, hipStream_t stream) {
    static int grid = 0;
    if (grid == 0) {
        if (n_in != 16 || out_size != (int)O_END || ws_size < WS_NEED) { fprintf(stderr, "kernel_launch: unexpected shapes (n_in %d, out %d, ws %zu)\n", n_in, out_size, ws_size); grid = -1; return; }
        int dev = 0, cus = 0, per_cu = 0;
        if (hipGetDevice(&dev) != hipSuccess || hipDeviceGetAttribute(&cus, hipDeviceAttributeMultiprocessorCount, dev) != hipSuccess) { grid = -1; return; }
        if (hipFuncSetAttribute((const void*)hymba_fwd, hipFuncAttributeMaxDynamicSharedMemorySize, LDS_BYTES) != hipSuccess) { fprintf(stderr, "kernel_launch: hipFuncSetAttribute failed\n"); grid = -1; return; }
        if (hipOccupancyMaxActiveBlocksPerMultiprocessor(&per_cu, (const void*)hymba_fwd, 512, LDS_BYTES) != hipSuccess || per_cu < 1) { fprintf(stderr, "kernel_launch: occupancy query says %d\n", per_cu); }
        (void)hipGetLastError();
        grid = cus;
    }
    if (grid < 0) return;
    (void)in_sizes;
    hipMemsetAsync((char*)d_ws + WS_CTL, 0, CTL_ZERO_BYTES, stream);
    Args a{};
    for (int i = 0; i < 16; ++i) a.in[i] = (const float*)d_in[i];
    a.out = (float*)d_out; a.ws = (unsigned char*)d_ws;
    hipLaunchKernelGGL(hymba_fwd, dim3(grid), dim3(512), LDS_BYTES, stream, a);
}
```

```cpp
#include <hip/hip_runtime.h>
#include <cstdio>
#include <cstdint>

#define LAS __attribute__((address_space(3)))
typedef unsigned short bf16_t;
typedef short bf16x8 __attribute__((ext_vector_type(8)));
typedef short s16x4 __attribute__((ext_vector_type(4)));
typedef float f32x4 __attribute__((ext_vector_type(4)));
typedef float f32x2 __attribute__((ext_vector_type(2)));
typedef unsigned u32x4 __attribute__((ext_vector_type(4)));
typedef unsigned u32x2 __attribute__((ext_vector_type(2)));

constexpr int DM = 4096, SEQ = 4096, NB = 2, MP = NB * SEQ  , MS = 32, MT = MP + MS  , MPAD = 8448;
constexpr int NZ = 12288, NINF = 12300, DFF = 16384;
constexpr int ZQA = 0, ZKA = 1024, ZVA = 2048, ZQM = 3072, ZKM = 4608, ZVM = 6144, ZOM = 9216;
constexpr int NH = 6, DK = 256, DV = 512, LCH = 64, NCH = 64;
constexpr float EPS = 1e-6f;
constexpr size_t O_Y = 0, O_KP = 33685504, O_VP = 37879808, O_CP = 42074112, O_NP = 43646976, O_MP = 43650048, O_KS = 43650060, O_VS = 43682828,
                 O_CS = 43715596, O_NS = 68881420, O_MS = 68930572, O_END = 68930764;

constexpr size_t MiB = 1u << 20;
constexpr size_t WS_CTL = 0, CTL_ZERO_BYTES = 1 * MiB;
constexpr int CW_BAR = 0;
constexpr int CW_Q2 = 4096;
constexpr size_t CTL_RSS2 = 64 * 1024, CTL_RSS3 = 128 * 1024, CTL_ACC = 512 * 1024;
constexpr size_t WS_ROPE = 2 * MiB;
constexpr size_t WS_WG = 5 * MiB;
constexpr size_t WS_G = 6 * MiB;
constexpr size_t WS_TB = 7 * MiB, WS_TWV = 7 * MiB + 256 * 1024, WS_TMT = 7 * MiB + 512 * 1024, WS_CM = 7 * MiB + 768 * 1024;
constexpr size_t WS_NC = 8 * MiB;
constexpr size_t WS_WIN = 16 * MiB, WS_WOUT = 112 * MiB, WS_WUP = 144 * MiB, WS_WDN = 272 * MiB;
constexpr size_t WS_XN = 400 * MiB, WS_Z = 466 * MiB, WS_MIX = 660 * MiB, WS_H = 726 * MiB, WS_HB = 855 * MiB, WS_CT = 921 * MiB, WS_END = 1114 * MiB;
#ifndef CHECKS
#define CHECKS 0
#endif
#ifndef PROF
#define PROF 0
#endif
constexpr size_t WS_U = CHECKS ? 1114 * MiB : 400 * MiB;
constexpr size_t WS_HRAW = 1380 * MiB;
constexpr size_t WS_NEED = CHECKS ? 1480 * MiB : WS_END;
constexpr int CW_ERR = 8192;
constexpr size_t WS_DBG = 1477 * MiB;

constexpr int LDS_BYTES = 153600, MISC_OFF = 153088;

__device__ __forceinline__ unsigned cvt_pk_bf16(float lo, float hi) { unsigned r; asm volatile("v_cvt_pk_bf16_f32 %0, %1, %2" : "=v"(r) : "v"(lo), "v"(hi)); return r; }
__device__ __forceinline__ float bf_lo(unsigned w) { return __uint_as_float(w << 16); }
__device__ __forceinline__ float bf_hi(unsigned w) { return __uint_as_float(w & 0xffff0000u); }
__device__ __forceinline__ float bf1(bf16_t b) { return __uint_as_float(((unsigned)b) << 16); }
__device__ __forceinline__ float wave_sum(float v) {
#pragma unroll
    for (int o = 1; o < 64; o <<= 1) v += __shfl_xor(v, o);
    return v;
}
__device__ __forceinline__ float wave_max(float v) {
#pragma unroll
    for (int o = 1; o < 64; o <<= 1) v = fmaxf(v, __shfl_xor(v, o));
    return v;
}
__device__ __forceinline__ void lds_addf(LAS float* p, float v) { (void)__hip_atomic_fetch_add(p, v, __ATOMIC_RELAXED, __HIP_MEMORY_SCOPE_WORKGROUP); }
typedef short v4i16_t __attribute__((ext_vector_type(4)));
__device__ __forceinline__ s16x4 vtr(const LAS unsigned char* p) { return __builtin_bit_cast(s16x4, __builtin_amdgcn_ds_read_tr16_b64_v4i16((LAS v4i16_t*)p)); }
__device__ __forceinline__ bf16x8 cat8(s16x4 a, s16x4 b) { bf16x8 r; r[0] = a[0]; r[1] = a[1]; r[2] = a[2]; r[3] = a[3]; r[4] = b[0]; r[5] = b[1]; r[6] = b[2]; r[7] = b[3]; return r; }

#define XB_TMO      128
#define XB_XCNT(j)  (256  + 64 * (j))
#define XB_XSUB(j)  (1280 + 64 * (j))
#define XB_XGEN(j)  (2304 + 64 * (j))
#define XB_TOP      3328
#define XB_TOPGEN   3392
#define XCD_BAR_WORDS 3456
#define XB_SPIN_CAP (1u << 18)
__device__ __forceinline__ unsigned xb_ld(unsigned* p)              { return __hip_atomic_load(p, __ATOMIC_RELAXED, __HIP_MEMORY_SCOPE_AGENT); }
__device__ __forceinline__ unsigned xb_add(unsigned* p, unsigned v) { return __hip_atomic_fetch_add(p, v, __ATOMIC_RELAXED, __HIP_MEMORY_SCOPE_AGENT); }
__device__ __forceinline__ unsigned xb_xcc_id() { return (unsigned)__builtin_amdgcn_s_getreg((3 << 11) | 20) & 0xFu; }
#define XB_SPIN(cond, bar) do { unsigned _sp = 0; while (cond) { __builtin_amdgcn_s_sleep(1); \
    if ((++_sp & 255u) == 0u) { if (xb_ld(&(bar)[XB_TMO])) break; if (_sp > XB_SPIN_CAP) { atomicAdd(&(bar)[XB_TMO], 1u); break; } } } } while (0)
struct XcdBarrier { unsigned* bar; unsigned x; volatile LAS unsigned* st; };
__device__ __forceinline__ XcdBarrier xcd_barrier_post(unsigned* bar, volatile LAS unsigned* st) {
    XcdBarrier b; b.bar = bar; b.x = xb_xcc_id(); b.st = st;
    if (threadIdx.x == 0) (void)xb_add(&bar[XB_XCNT(b.x)], 1u);
    return b;
}
__device__ __forceinline__ void xcd_barrier_complete(unsigned* bar, unsigned x, unsigned& nloc, unsigned& nx) {
    const unsigned G = gridDim.x * gridDim.y * gridDim.z;
    unsigned sum, cnt, mine, sp = 0u;
    for (;;) {
        sum = 0u; cnt = 0u; mine = 0u;
#pragma unroll
        for (unsigned j = 0; j < 16; ++j) { const unsigned c = xb_ld(&bar[XB_XCNT(j)]); sum += c; cnt += (c > 0u) ? 1u : 0u; mine = (j == x) ? c : mine; }
        if (sum == G) break;
        __builtin_amdgcn_s_sleep(1);
        if ((++sp & 255u) == 0u) { if (xb_ld(&bar[XB_TMO])) break; if (sp > XB_SPIN_CAP) { atomicAdd(&bar[XB_TMO], 1u); break; } }
    }
    nloc = mine > 0u ? mine : 1u; nx = cnt > 0u ? cnt : 1u;
}
__device__ __forceinline__ void xcd_barrier(const XcdBarrier& b) {
    asm volatile("s_waitcnt vmcnt(0)" ::: "memory");
    __syncthreads();
    if (threadIdx.x == 0) {
        unsigned* bar = b.bar;
        __builtin_amdgcn_s_waitcnt(0);
        unsigned nloc = b.st[0], nx = b.st[1];
        if (nloc == 0u) { xcd_barrier_complete(bar, b.x, nloc, nx); b.st[0] = nloc; b.st[1] = nx; }
        const unsigned old = xb_add(&bar[XB_XSUB(b.x)], 1u);
        const unsigned gen = old / nloc;
        if (old + 1u == (gen + 1u) * nloc) {
            __builtin_amdgcn_fence(__ATOMIC_RELEASE, "agent");
            asm volatile("s_waitcnt vmcnt(0)" ::: "memory");
            const unsigned og = xb_add(&bar[XB_TOP], 1u);
            const unsigned tg = og / nx;
            if (og + 1u == (tg + 1u) * nx) xb_add(&bar[XB_TOPGEN], 1u);
            else XB_SPIN(xb_ld(&bar[XB_TOPGEN]) == tg, bar);
            __builtin_amdgcn_fence(__ATOMIC_ACQUIRE, "agent");
            xb_add(&bar[XB_XGEN(b.x)], 1u);
            asm volatile("s_waitcnt vmcnt(0)" ::: "memory");
        } else {
            XB_SPIN(xb_ld(&bar[XB_XGEN(b.x)]) == gen, bar);
            __builtin_amdgcn_fence(__ATOMIC_ACQUIRE, "agent");
            asm volatile("s_waitcnt vmcnt(0)" ::: "memory");
        }
    }
    __syncthreads();
}

namespace pg8 {
constexpr int BM = 256, BK = 64, HALF = 128, HTB = HALF * BK * 2, STAGE_BYTES = 8 * HTB, NXCD = 8, WGM = 8;
__host__ __device__ __forceinline__ int lds_byte(int r, int c) { const int st = (r >> 4) * 2 + (c >> 5), rr = r & 15, cc = c & 31, ob = rr * 64 + cc * 2; return st * 1024 + (ob ^ (((ob >> 9) & 1) << 5)); }
__host__ __device__ __forceinline__ void stage_rc(int b, int& R, int& C) { const int st = b / 1024, sb = b % 1024, swz = sb ^ (((sb >> 9) & 1) << 5); R = (st >> 1) * 16 + swz / 64; C = (st & 1) * 32 + (swz % 64) / 2; }
__host__ __device__ __forceinline__ int perm32(int rho) { const int n = rho >> 4, i = rho & 15; return 8 * (i >> 2) + 4 * n + (i & 3); }
struct Unit { int pm, pn; };
struct Gemm { const bf16_t* A; const bf16_t* Bt; int M, N, K; };
struct StaticOrder {
    int nM, nN, nwg, G, c;
    __host__ __device__ void init(int M, int N, int G_, int c_) { nM = M / BM; nN = N / BM; nwg = nM * nN; G = G_; c = c_; }
    __host__ __device__ bool next(int i, Unit& u) const {
        const long L = (long)i * G + c; if (L >= nwg) return false;
        int wgid = (int)L; { const int q = nwg / NXCD, r = nwg % NXCD, xcd = wgid % NXCD, off = wgid / NXCD; wgid = (xcd < r ? xcd * (q + 1) : r * (q + 1) + (xcd - r) * q) + off; }
        const int nig = WGM * nN, gid = wgid / nig, fm = gid * WGM, gsz = (nM - fm) < WGM ? (nM - fm) : WGM;
        u.pm = fm + ((wgid % nig) % gsz); u.pn = (wgid % nig) / gsz; return true;
    }
};
struct InterleavedOrder { StaticOrder S;
    __host__ __device__ bool next(int i, Unit& u) const { if (!S.next(i, u)) return false; u.pn = 2 * (u.pn % 24) + u.pn / 24; return true; } };
template <int BMODE> __host__ __device__ __forceinline__ int bmap_row(int R) {
    if (BMODE == 0) return R;
    const int p = (R & ~31) + perm32(R & 31);
    if (BMODE == 1) return p;
    return (p >> 6) * 128 + (p & 63);
}
template <class Epi, class Sched = StaticOrder, bool ALIGN_EPI = true, bool SP2 = true>
__device__ __forceinline__ void gemm_phase(LAS unsigned char* lds, const Gemm g, const Sched& S, const Epi& E) {
    int tid = threadIdx.x; asm volatile("" : "+v"(tid)); const int wid = __builtin_amdgcn_readfirstlane(tid >> 6), lane = tid & 63, wr = wid >> 2, wc = wid & 3, fr = lane & 15, fq = lane >> 4;
    const int K = g.K, nt = K / BK;
    unsigned voffA[2], voffB[2];
#pragma unroll
    for (int i = 0; i < 2; ++i) { int R, C; stage_rc(tid * 16 + i * 8192, R, C); const int Rb = bmap_row<Epi::BMODE>(R);
        voffA[i] = (unsigned)(R * K + C) * 2u; voffB[i] = (unsigned)(Rb * K + C) * 2u; }
    const size_t kstep = (size_t)(BK * 2);
    const size_t hstep = (size_t)HALF * K * 2;
    const size_t hstepB = (size_t)(Epi::BMODE == 2 ? 64 : 128) * K * 2;
    const size_t tstep = 2 * hstep;
    const unsigned ldsw = (unsigned)wid * 1024u;
    const int aoff = lds_byte(wr * 64 + fr, fq * 8), boff = lds_byte(wc * 32 + fr, fq * 8);
#define PG8_SA(b, h) (((b) * 2 + (h)) * HTB)
#define PG8_SB(b, h) ((4 + (b) * 2 + (h)) * HTB)
#define PG8_STAGE(bufoff, gbase, voff) do { _Pragma("unroll") for (int _i = 0; _i < 2; ++_i) \
        __builtin_amdgcn_global_load_lds((const unsigned*)((const char*)(gbase) + (voff)[_i]), (LAS unsigned*)(lds + (bufoff) + ldsw + _i * 8192), 16, 0, 0); } while (0)
#define PG8_LDA(dst, b, h) do { _Pragma("unroll") for (int m = 0; m < 4; ++m) _Pragma("unroll") for (int k = 0; k < 2; ++k) dst[m][k] = *(const LAS bf16x8*)(lds + PG8_SA(b, h) + aoff + m * 2048 + k * 1024); } while (0)
#define PG8_LDB(dst, b, h) do { _Pragma("unroll") for (int n = 0; n < 2; ++n) _Pragma("unroll") for (int k = 0; k < 2; ++k) dst[n][k] = *(const LAS bf16x8*)(lds + PG8_SB(b, h) + boff + n * 2048 + k * 1024); } while (0)
#define PG8_MMA(ai, bj, At, Bt) do { __builtin_amdgcn_s_setprio(1); _Pragma("unroll") for (int m = 0; m < 4; ++m) _Pragma("unroll") for (int n = 0; n < 2; ++n) _Pragma("unroll") for (int k = 0; k < 2; ++k) \
        acc[ai][bj][m][n] = __builtin_amdgcn_mfma_f32_16x16x32_bf16(Bt[n][k], At[m][k], acc[ai][bj][m][n], 0, 0, 0); __builtin_amdgcn_s_setprio(0); } while (0)
#define PG8_WAIT_V(n) asm volatile("s_waitcnt vmcnt(" #n ")" ::: "memory")
#define PG8_WAIT_L(n) asm volatile("s_waitcnt lgkmcnt(" #n ")" ::: "memory")
#define PG8_BAR __builtin_amdgcn_s_barrier()
#define PG8_SCHED __builtin_amdgcn_sched_barrier(0)
    Unit cur, nxt; int ui = 0;
    if (!S.next(0, cur)) return;
    f32x4 acc[2][2][4][2];
#pragma unroll
    for (int a = 0; a < 2; ++a)
#pragma unroll
        for (int b = 0; b < 2; ++b)
#pragma unroll
            for (int m = 0; m < 4; ++m)
#pragma unroll
                for (int n = 0; n < 2; ++n) acc[a][b][m][n] = (f32x4){0.f, 0.f, 0.f, 0.f};
    bf16x8 At[4][2], B0[2][2], B1[2][2];
    const char* cA = (const char*)g.A + (size_t)cur.pm * tstep; const char* cB = (const char*)g.Bt + (size_t)cur.pn * tstep;
    if constexpr (SP2) {
        PG8_STAGE(PG8_SB(0, 0), cB, voffB); PG8_STAGE(PG8_SB(0, 1), cB + hstepB, voffB); PG8_STAGE(PG8_SA(0, 0), cA, voffA); PG8_STAGE(PG8_SA(0, 1), cA + hstep, voffA);
        if (wr == 1) PG8_BAR;
        PG8_WAIT_V(2); PG8_BAR;
        PG8_STAGE(PG8_SB(1, 0), cB + kstep, voffB); PG8_STAGE(PG8_SA(1, 0), cA + kstep, voffA); PG8_STAGE(PG8_SB(1, 1), cB + hstepB + kstep, voffB);
        PG8_WAIT_V(6); PG8_BAR;
    } else {
        PG8_STAGE(PG8_SB(0, 0), cB, voffB); PG8_STAGE(PG8_SA(0, 0), cA, voffA); PG8_STAGE(PG8_SB(0, 1), cB + hstepB, voffB); PG8_STAGE(PG8_SA(0, 1), cA + hstep, voffA);
        if (wr == 1) PG8_BAR;
        PG8_WAIT_V(4); PG8_BAR;
        PG8_STAGE(PG8_SB(1, 0), cB + kstep, voffB); PG8_STAGE(PG8_SA(1, 0), cA + kstep, voffA); PG8_STAGE(PG8_SB(1, 1), cB + hstepB + kstep, voffB);
        PG8_WAIT_V(6); PG8_BAR;
    }
    for (;;) {
        const bool has_next = S.next(ui + 1, nxt);
        const char* nA = has_next ? (const char*)g.A + (size_t)nxt.pm * tstep : cA; const char* nB = has_next ? (const char*)g.Bt + (size_t)nxt.pn * tstep : cB;
        for (int t = 0; t < nt; t += 2) {
            const bool last = (t == nt - 2);
            const char* a1 = cA + (size_t)(t + 1) * kstep;
            const char* a2 = last ? nA : cA + (size_t)(t + 2) * kstep; const char* b2 = last ? nB : cB + (size_t)(t + 2) * kstep;
            const char* a3 = a2 + kstep; const char* b3 = b2 + kstep;
            if constexpr (SP2) {
            PG8_LDB(B0, 0, 0); PG8_LDB(B1, 0, 1); PG8_SCHED; PG8_LDA(At, 0, 0); PG8_STAGE(PG8_SA(1, 1), a1 + hstep, voffA);
            PG8_WAIT_V(8); PG8_WAIT_L(0); PG8_BAR; PG8_MMA(0, 0, At, B0); PG8_MMA(0, 1, At, B1); PG8_BAR; PG8_SCHED;
            PG8_LDA(At, 0, 1); PG8_STAGE(PG8_SB(0, 0), b2, voffB); PG8_STAGE(PG8_SB(0, 1), b2 + hstepB, voffB); PG8_STAGE(PG8_SA(0, 0), a2, voffA);
            PG8_WAIT_V(8); PG8_WAIT_L(0); PG8_BAR; PG8_MMA(1, 0, At, B0); PG8_MMA(1, 1, At, B1); PG8_BAR; PG8_SCHED;
            PG8_LDB(B0, 1, 0); PG8_LDB(B1, 1, 1); PG8_SCHED; PG8_LDA(At, 1, 0); PG8_STAGE(PG8_SA(0, 1), a2 + hstep, voffA);
            PG8_WAIT_V(8); PG8_WAIT_L(0); PG8_BAR; PG8_MMA(0, 0, At, B0); PG8_MMA(0, 1, At, B1); PG8_BAR; PG8_SCHED;
            PG8_LDA(At, 1, 1); PG8_STAGE(PG8_SB(1, 0), b3, voffB); PG8_STAGE(PG8_SB(1, 1), b3 + hstepB, voffB); PG8_STAGE(PG8_SA(1, 0), a3, voffA);
            PG8_WAIT_V(8); PG8_WAIT_L(0); PG8_BAR; PG8_MMA(1, 0, At, B0); PG8_MMA(1, 1, At, B1); PG8_BAR; PG8_SCHED;
            } else {
            PG8_LDB(B0, 0, 0); PG8_SCHED; PG8_LDA(At, 0, 0); PG8_STAGE(PG8_SA(1, 1), a1 + hstep, voffA);
            PG8_WAIT_L(8); PG8_BAR; PG8_WAIT_L(0); PG8_MMA(0, 0, At, B0); PG8_BAR; PG8_SCHED;
            PG8_LDB(B1, 0, 1); PG8_STAGE(PG8_SB(0, 0), b2, voffB);
            PG8_BAR; PG8_WAIT_L(0); PG8_MMA(0, 1, At, B1); PG8_BAR;
            PG8_LDA(At, 0, 1); PG8_STAGE(PG8_SA(0, 0), a2, voffA);
            PG8_BAR; PG8_WAIT_L(0); PG8_MMA(1, 0, At, B0); PG8_BAR; PG8_SCHED;
            PG8_STAGE(PG8_SB(0, 1), b2 + hstepB, voffB);
            PG8_WAIT_V(6); PG8_BAR; PG8_MMA(1, 1, At, B1); PG8_BAR;
            PG8_LDB(B0, 1, 0); PG8_SCHED; PG8_LDA(At, 1, 0); PG8_STAGE(PG8_SA(0, 1), a2 + hstep, voffA);
            PG8_WAIT_L(8); PG8_BAR; PG8_WAIT_L(0); PG8_MMA(0, 0, At, B0); PG8_BAR; PG8_SCHED;
            PG8_LDB(B1, 1, 1); PG8_STAGE(PG8_SB(1, 0), b3, voffB);
            PG8_BAR; PG8_WAIT_L(0); PG8_MMA(0, 1, At, B1); PG8_BAR;
            PG8_LDA(At, 1, 1); PG8_STAGE(PG8_SA(1, 0), a3, voffA);
            PG8_BAR; PG8_WAIT_L(0); PG8_MMA(1, 0, At, B0); PG8_BAR; PG8_SCHED;
            PG8_STAGE(PG8_SB(1, 1), b3 + hstepB, voffB);
            PG8_WAIT_V(6); PG8_BAR; PG8_MMA(1, 1, At, B1); PG8_BAR;
            }
        }
        if constexpr (ALIGN_EPI) { if (wr == 0) PG8_BAR; }
        if constexpr (Epi::FUSED) E.fused(acc, cur, wr, wc, fr, fq, wid, lane); else E(acc, cur, wr, wc, fr, fq);
        if (!has_next) break;
#pragma unroll
        for (int a = 0; a < 2; ++a)
#pragma unroll
            for (int b = 0; b < 2; ++b)
#pragma unroll
                for (int m = 0; m < 4; ++m)
#pragma unroll
                    for (int n = 0; n < 2; ++n) acc[a][b][m][n] = (f32x4){0.f, 0.f, 0.f, 0.f};
        cur = nxt; cA = nA; cB = nB; ++ui;
        if constexpr (ALIGN_EPI) { if (wr == 1) PG8_BAR; }
    }
    PG8_WAIT_V(0);
    if constexpr (!ALIGN_EPI) { if (wr == 0) PG8_BAR; }
    PG8_BAR;
#undef PG8_SA
#undef PG8_SB
#undef PG8_STAGE
#undef PG8_LDA
#undef PG8_LDB
#undef PG8_MMA
#undef PG8_WAIT_V
#undef PG8_WAIT_L
#undef PG8_BAR
#undef PG8_SCHED
}
}

struct EpiInProj {
    static constexpr bool FUSED = false;
    static constexpr int BMODE = 2;
    bf16_t* Z; const float* rope; float* kout; float* vout;
    __device__ __forceinline__ void operator()(const f32x4 (&acc)[2][2][4][2], const pg8::Unit& u, int wr, int wc, int fr, int fq) const {
        const int pn = u.pn, hsel = wc >> 1, i0 = 32 * (wc & 1) + 8 * fq;
        const int colb = 256 * pn + 128 * hsel + i0;
#pragma unroll
        for (int ai = 0; ai < 2; ++ai)
#pragma unroll
            for (int m = 0; m < 4; ++m) {
                const int row = 256 * u.pm + 128 * ai + 64 * wr + 16 * m + fr;
                const int pos = row & (SEQ - 1), bb = row >> 12;
                f32x4 a0 = acc[ai][0][m][0], a1 = acc[ai][0][m][1], b0 = acc[ai][1][m][0], b1 = acc[ai][1][m][1];
                if (pn < 8) {
                    const float* rt = rope + (size_t)pos * 128 + i0;
                    const f32x4 c0 = *(const f32x4*)(rt), c1 = *(const f32x4*)(rt + 4), s0 = *(const f32x4*)(rt + 64), s1 = *(const f32x4*)(rt + 68);
                    const f32x4 o0 = a0 * c0 - b0 * s0, o1 = a1 * c1 - b1 * s1, p0 = b0 * c0 + a0 * s0, p1 = b1 * c1 + a1 * s1;
                    a0 = o0; a1 = o1; b0 = p0; b1 = p1;
                    if (pn < 4) { const float sc = 0.08838834764831845f; a0 *= sc; a1 *= sc; b0 *= sc; b1 *= sc; }
                } else if (pn >= 12 && pn < 18) { const float sc = 0.0625f; a0 *= sc; a1 *= sc; b0 *= sc; b1 *= sc; }
                bf16_t* zp = Z + (size_t)row * NZ + colb;
                u32x4 w; w.x = cvt_pk_bf16(a0[0], a0[1]); w.y = cvt_pk_bf16(a0[2], a0[3]); w.z = cvt_pk_bf16(a1[0], a1[1]); w.w = cvt_pk_bf16(a1[2], a1[3]);
                *(u32x4*)zp = w;
                w.x = cvt_pk_bf16(b0[0], b0[1]); w.y = cvt_pk_bf16(b0[2], b0[3]); w.z = cvt_pk_bf16(b1[0], b1[1]); w.w = cvt_pk_bf16(b1[2], b1[3]);
                *(u32x4*)(zp + 64) = w;
                if (pn >= 4 && pn < 12 && pos >= 2048) {
                    float* ob = (pn < 8) ? kout : vout; const int head = 2 * ((pn - 4) & 3) + hsel;
                    float* op = ob + ((size_t)(bb * 2048 + pos - 2048) * 8 + head) * 128 + i0;
                    *(f32x4*)op = a0; *(f32x4*)(op + 4) = a1; *(f32x4*)(op + 64) = b0; *(f32x4*)(op + 68) = b1;
                }
                asm volatile("" ::: "memory");
            }
    }
};
struct EpiOutProj {
    static constexpr bool FUSED = false;
    static constexpr int BMODE = 0;
    const float* X; float* H; bf16_t* HB; float* rss;
    __device__ __forceinline__ void operator()(const f32x4 (&acc)[2][2][4][2], const pg8::Unit& u, int wr, int wc, int fr, int fq) const {
        const int col0 = 256 * u.pn + 32 * wc + 4 * fq;
#pragma unroll
        for (int ai = 0; ai < 2; ++ai)
#pragma unroll
            for (int m = 0; m < 4; ++m) {
                const int row = 256 * u.pm + 128 * ai + 64 * wr + 16 * m + fr; const size_t off = (size_t)row * DM + col0; float ss = 0.f;
#pragma unroll
                for (int bj = 0; bj < 2; ++bj)
#pragma unroll
                    for (int n = 0; n < 2; ++n) { const size_t o = off + bj * 128 + n * 16; const f32x4 hv = *(const f32x4*)(X + o) + acc[ai][bj][m][n];
                        u32x2 w; w.x = cvt_pk_bf16(hv[0], hv[1]); w.y = cvt_pk_bf16(hv[2], hv[3]); *(u32x2*)(HB + o) = w;
                        ss += (hv[0] * hv[0] + hv[1] * hv[1]) + (hv[2] * hv[2] + hv[3] * hv[3]); }
                ss += __shfl_xor(ss, 16); ss += __shfl_xor(ss, 32);
                if (fq == 0) atomicAdd(rss + row, ss);
                asm volatile("" ::: "memory");
            }
    }
};
struct EpiUp {
    static constexpr bool FUSED = false;
    static constexpr int BMODE = 1;
    bf16_t* U; const float* rss; int pm0;
    __device__ __forceinline__ void operator()(const f32x4 (&acc)[2][2][4][2], const pg8::Unit& u, int wr, int wc, int fr, int fq) const {
        const int col0 = 256 * u.pn + 32 * wc + 8 * fq;
        float rr[2][4];
#pragma unroll
        for (int ai = 0; ai < 2; ++ai)
#pragma unroll
            for (int m = 0; m < 4; ++m) rr[ai][m] = rss[256 * (u.pm + pm0) + 128 * ai + 64 * wr + 16 * m + fr];
#pragma unroll
        for (int ai = 0; ai < 2; ++ai)
#pragma unroll
            for (int m = 0; m < 4; ++m) rr[ai][m] = rsqrtf(rr[ai][m] * (1.0f / DM) + EPS);
        asm volatile("" ::: "memory");
#pragma unroll
        for (int ai = 0; ai < 2; ++ai)
#pragma unroll
            for (int m = 0; m < 4; ++m) {
                const int row = 256 * (u.pm + pm0) + 128 * ai + 64 * wr + 16 * m + fr;
                const float r = rr[ai][m];
                bf16_t* up = U + (size_t)row * DFF + col0;
#pragma unroll
                for (int bj = 0; bj < 2; ++bj) { f32x4 v0 = acc[ai][bj][m][0] * r, v1 = acc[ai][bj][m][1] * r;
#pragma unroll
                    for (int j = 0; j < 4; ++j) { const float a = fmaxf(v0[j], 0.f), b = fmaxf(v1[j], 0.f); v0[j] = a * a; v1[j] = b * b; }
                    u32x4 w; w.x = cvt_pk_bf16(v0[0], v0[1]); w.y = cvt_pk_bf16(v0[2], v0[3]); w.z = cvt_pk_bf16(v1[0], v1[1]); w.w = cvt_pk_bf16(v1[2], v1[3]);
                    *(u32x4*)(up + bj * 128) = w; }
            }
    }
};
struct EpiDown {
    static constexpr bool FUSED = false;
    static constexpr int BMODE = 0;
    const bf16_t* HB; bf16_t* YB; float* rss; int pm0;
    __device__ __forceinline__ void operator()(const f32x4 (&acc)[2][2][4][2], const pg8::Unit& u, int wr, int wc, int fr, int fq) const {
        const int col0 = 256 * u.pn + 32 * wc + 4 * fq;
#pragma unroll
        for (int ai = 0; ai < 2; ++ai)
#pragma unroll
            for (int m = 0; m < 4; ++m) {
                const int row = 256 * (u.pm + pm0) + 128 * ai + 64 * wr + 16 * m + fr; const size_t off = (size_t)row * DM + col0; float ss = 0.f;
#pragma unroll
                for (int bj = 0; bj < 2; ++bj)
#pragma unroll
                    for (int n = 0; n < 2; ++n) { const size_t o = off + bj * 128 + n * 16; const u32x2 hw = *(const u32x2*)(HB + o);
                        const f32x4 hv = (f32x4){bf_lo(hw.x), bf_hi(hw.x), bf_lo(hw.y), bf_hi(hw.y)} + acc[ai][bj][m][n];
                        u32x2 w; w.x = cvt_pk_bf16(hv[0], hv[1]); w.y = cvt_pk_bf16(hv[2], hv[3]); *(u32x2*)(YB + o) = w;
                        ss += (hv[0] * hv[0] + hv[1] * hv[1]) + (hv[2] * hv[2] + hv[3] * hv[3]); }
                ss += __shfl_xor(ss, 16); ss += __shfl_xor(ss, 32);
                if (fq == 0) atomicAdd(rss + row, ss);
                asm volatile("" ::: "memory");
            }
    }
};

struct EpiDownNorm {
    static constexpr int BMODE = 0; static constexpr bool FUSED = true;
    const bf16_t* HB; float* Y; float* rss; unsigned* cnt; const float* gain; int pm0;
    __device__ __forceinline__ void operator()(const f32x4 (&)[2][2][4][2], const pg8::Unit&, int, int, int, int) const {}
    __device__ __forceinline__ void fused(f32x4 (&acc)[2][2][4][2], const pg8::Unit& u, int wr, int wc, int fr, int fq, int wid, int lane) const {
        const int col0 = 256 * u.pn + 32 * wc + 4 * fq, prow = 256 * (u.pm + pm0) + 64 * wr + fr;
        float chk = 0.f;
#pragma unroll
        for (int ai = 0; ai < 2; ++ai) {
            u32x2 hw[4][2][2];
#pragma unroll
            for (int m = 0; m < 4; ++m) { const size_t off = (size_t)(prow + 128 * ai + 16 * m) * DM + col0;
#pragma unroll
                for (int bj = 0; bj < 2; ++bj)
#pragma unroll
                    for (int n = 0; n < 2; ++n) hw[m][bj][n] = *(const u32x2*)(HB + off + bj * 128 + n * 16); }
#pragma unroll
            for (int m = 0; m < 4; ++m) { float ss = 0.f;
#pragma unroll
                for (int bj = 0; bj < 2; ++bj)
#pragma unroll
                    for (int n = 0; n < 2; ++n) { const u32x2 h2 = hw[m][bj][n]; f32x4 hv = (f32x4){bf_lo(h2.x), bf_hi(h2.x), bf_lo(h2.y), bf_hi(h2.y)} + acc[ai][bj][m][n]; acc[ai][bj][m][n] = hv;
                        ss += (hv[0] * hv[0] + hv[1] * hv[1]) + (hv[2] * hv[2] + hv[3] * hv[3]); }
                ss += __shfl_xor(ss, 16); ss += __shfl_xor(ss, 32);
                if (fq == 0) chk += __hip_atomic_fetch_add(rss + prow + 128 * ai + 16 * m, ss, __ATOMIC_RELAXED, __HIP_MEMORY_SCOPE_AGENT); }
        }
        asm volatile("s_waitcnt vmcnt(0)" :: "v"(chk) : "memory");
        unsigned* pc = cnt + 64 * (u.pm + pm0);
        if (lane == 0) __hip_atomic_fetch_add(pc, 1u, __ATOMIC_RELAXED, __HIP_MEMORY_SCOPE_AGENT);
        if (wid == 0) { unsigned sp = 0; while ((unsigned)__builtin_amdgcn_readfirstlane(__hip_atomic_load(pc, __ATOMIC_RELAXED, __HIP_MEMORY_SCOPE_AGENT)) < 128u && ++sp < 400000u) __builtin_amdgcn_s_sleep(1); }
        asm volatile("s_waitcnt vmcnt(0) lgkmcnt(0)" ::: "memory"); __builtin_amdgcn_s_barrier(); asm volatile("" ::: "memory");
        float rr[2][4];
#pragma unroll
        for (int ai = 0; ai < 2; ++ai)
#pragma unroll
            for (int m = 0; m < 4; ++m) rr[ai][m] = __hip_atomic_load(rss + prow + 128 * ai + 16 * m, __ATOMIC_RELAXED, __HIP_MEMORY_SCOPE_AGENT);
        f32x4 gg[2][2];
#pragma unroll
        for (int bj = 0; bj < 2; ++bj)
#pragma unroll
            for (int n = 0; n < 2; ++n) gg[bj][n] = *(const f32x4*)(gain + col0 + bj * 128 + n * 16);
#pragma unroll
        for (int ai = 0; ai < 2; ++ai)
#pragma unroll
            for (int m = 0; m < 4; ++m) { const float r = rsqrtf(rr[ai][m] * (1.0f / DM) + EPS); float* yp = Y + (size_t)(prow + 128 * ai + 16 * m) * DM + col0;
#pragma unroll
                for (int bj = 0; bj < 2; ++bj)
#pragma unroll
                    for (int n = 0; n < 2; ++n) *(f32x4*)(yp + bj * 128 + n * 16) = acc[ai][bj][m][n] * r * gg[bj][n]; }
    }
};

constexpr int SK_SROW = 528;
template <int NI, class Epi>
__device__ __forceinline__ void skinny_unit(LAS unsigned char* lds, const bf16_t* S, const bf16_t* T, int K, int kbeg, int klen, const Epi& E, int u, int w) {
    int tid = threadIdx.x; asm volatile("" : "+v"(tid)); const int wid = __builtin_amdgcn_readfirstlane(tid >> 6), lane = tid & 63, li = lane & 15, g = lane >> 4;
    const int kw = klen >> 3, k0 = kbeg + wid * kw;
    const bf16_t* t0 = T + (size_t)(E.jrow(u, w, 0) + li) * K + 32 * g;
    const bf16_t* t1 = T + (size_t)(E.jrow(u, w, 1) + li) * K + 32 * g;
    const bf16_t* s0 = S + (size_t)li * K + 32 * g;
    f32x4 acc[2][NI];
#pragma unroll
    for (int a = 0; a < 2; ++a)
#pragma unroll
        for (int b = 0; b < NI; ++b) acc[a][b] = (f32x4){0.f, 0.f, 0.f, 0.f};
    bf16x8 tcA[2][4], scA[NI][4], tcB[2][4], scB[NI][4];
#define SK_LOAD(tc_, sc_, kb_) do { _Pragma("unroll") for (int q = 0; q < 4; ++q) { const int ko = (kb_) + 8 * q; tc_[0][q] = *(const bf16x8*)(t0 + ko); tc_[1][q] = *(const bf16x8*)(t1 + ko); \
        _Pragma("unroll") for (int i2 = 0; i2 < NI; ++i2) sc_[i2][q] = *(const bf16x8*)(s0 + (size_t)(16 * i2) * K + ko); } } while (0)
#define SK_MMA(tc_, sc_) do { _Pragma("unroll") for (int q = 0; q < 4; ++q) _Pragma("unroll") for (int i2 = 0; i2 < NI; ++i2) { \
        acc[0][i2] = __builtin_amdgcn_mfma_f32_16x16x32_bf16(tc_[0][q], sc_[i2][q], acc[0][i2], 0, 0, 0); \
        acc[1][i2] = __builtin_amdgcn_mfma_f32_16x16x32_bf16(tc_[1][q], sc_[i2][q], acc[1][i2], 0, 0, 0); } } while (0)
    SK_LOAD(tcA, scA, k0);
#pragma unroll 1
    for (int kb = k0; kb < k0 + kw; kb += 256) {
        SK_LOAD(tcB, scB, kb + 128);
        SK_MMA(tcA, scA);
        if (kb + 256 < k0 + kw) SK_LOAD(tcA, scA, kb + 256);
        SK_MMA(tcB, scB);
    }
#undef SK_LOAD
#undef SK_MMA
    LAS f32x4* red = (LAS f32x4*)lds;
#pragma unroll
    for (int a = 0; a < 2; ++a)
#pragma unroll
        for (int b = 0; b < NI; ++b) red[((wid * 2 + a) * NI + b) * 64 + lane] = acc[a][b];
    __syncthreads();
    if (wid == 0) {
#pragma unroll
        for (int a = 0; a < 2; ++a)
#pragma unroll
            for (int b = 0; b < NI; ++b) { f32x4 s = red[(a * NI + b) * 64 + lane];
#pragma unroll
                for (int ww = 1; ww < 8; ++ww) s += red[((ww * 2 + a) * NI + b) * 64 + lane];
                acc[a][b] = s; }
        E(acc, u, w, li, g);
    }
    __syncthreads();
}

struct SkGates {
    const float* bif; float* G;
    __device__ __forceinline__ int jrow(int u, int w, int jt) const { return 256 * u + 32 * w + 16 * jt; }
    __device__ __forceinline__ void operator()(const f32x4 (&acc)[2][1], int u, int w, int li, int g) const {
        if (li >= 12) return;
        const float bias = bif[li];
#pragma unroll
        for (int jt = 0; jt < 2; ++jt) {
            const int tok = jrow(u, w, jt) + 4 * g; if (tok >= MT) continue;
            f32x4 v = acc[jt][0];
#pragma unroll
            for (int j = 0; j < 4; ++j) { float a = 15.0f * tanhf((v[j] + bias) * (1.0f / 15.0f));
                if (li >= 6) a = fminf(a, 0.f) - log1pf(__expf(-fabsf(a)));
                v[j] = a; }
            *(f32x4*)(G + (size_t)li * MT + tok) = v;
        }
    }
};
struct SkInProj {
    bf16_t* Z; const float* rope; float* kout; float* vout;
    __device__ __forceinline__ int jrow(int u, int w, int jt) const { return 256 * u + 128 * (w >> 2) + 64 * jt + 16 * (w & 3); }
    __device__ __forceinline__ void operator()(const f32x4 (&acc)[2][2], int u, int w, int li, int g) const {
        const int c0 = jrow(u, w, 0) + 4 * g;
        const int i0 = (c0 & 63);
#pragma unroll
        for (int i2 = 0; i2 < 2; ++i2) {
            const int sr = 16 * i2 + li, row = MP + sr;
            f32x4 a = acc[0][i2], b = acc[1][i2];
            if (u < 8) {
                const float* rt = rope + (size_t)4096 * 128 + i0;
                const f32x4 c = *(const f32x4*)rt, s = *(const f32x4*)(rt + 64);
                const f32x4 o = a * c - b * s, p = b * c + a * s; a = o; b = p;
                if (u < 4) { a *= 0.08838834764831845f; b *= 0.08838834764831845f; }
            } else if (u >= 12 && u < 18) { a *= 0.0625f; b *= 0.0625f; }
            bf16_t* zp = Z + (size_t)row * NZ + c0;
            u32x2 wv; wv.x = cvt_pk_bf16(a[0], a[1]); wv.y = cvt_pk_bf16(a[2], a[3]); *(u32x2*)zp = wv;
            wv.x = cvt_pk_bf16(b[0], b[1]); wv.y = cvt_pk_bf16(b[2], b[3]); *(u32x2*)(zp + 64) = wv;
            if (u >= 4 && u < 12) { float* ob = (u < 8) ? kout : vout; float* op = ob + (size_t)sr * 1024 + (c0 & 1023); *(f32x4*)op = a; *(f32x4*)(op + 64) = b; }
        }
    }
};
struct SkOutProj {
    const float* XS; float* H; bf16_t* HB; float* rss;
    __device__ __forceinline__ int jrow(int u, int w, int jt) const { return 256 * u + 32 * w + 16 * jt; }
    __device__ __forceinline__ void operator()(const f32x4 (&acc)[2][2], int u, int w, int li, int g) const {
#pragma unroll
        for (int i2 = 0; i2 < 2; ++i2) { const int sr = 16 * i2 + li, row = MP + sr; float ss = 0.f;
#pragma unroll
            for (int jt = 0; jt < 2; ++jt) { const int col = jrow(u, w, jt) + 4 * g; const f32x4 hv = *(const f32x4*)(XS + (size_t)sr * DM + col) + acc[jt][i2];
                u32x2 wv; wv.x = cvt_pk_bf16(hv[0], hv[1]); wv.y = cvt_pk_bf16(hv[2], hv[3]); *(u32x2*)(HB + (size_t)row * DM + col) = wv;
                ss += (hv[0] * hv[0] + hv[1] * hv[1]) + (hv[2] * hv[2] + hv[3] * hv[3]); }
            atomicAdd(rss + row, ss); }
    }
};
struct SkUp {
    bf16_t* U; const float* rss;
    __device__ __forceinline__ int jrow(int u, int w, int jt) const { return 256 * u + 32 * w + 16 * jt; }
    __device__ __forceinline__ void operator()(const f32x4 (&acc)[2][2], int u, int w, int li, int g) const {
#pragma unroll
        for (int i2 = 0; i2 < 2; ++i2) { const int row = MP + 16 * i2 + li; const float r = rsqrtf(rss[row] * (1.0f / DM) + EPS);
#pragma unroll
            for (int jt = 0; jt < 2; ++jt) { const int col = jrow(u, w, jt) + 4 * g; f32x4 v = acc[jt][i2] * r;
#pragma unroll
                for (int j = 0; j < 4; ++j) { const float a = fmaxf(v[j], 0.f); v[j] = a * a; }
                u32x2 wv; wv.x = cvt_pk_bf16(v[0], v[1]); wv.y = cvt_pk_bf16(v[2], v[3]); *(u32x2*)(U + (size_t)row * DFF + col) = wv; } }
    }
};
struct SkDown {
    float* ACC;
    __device__ __forceinline__ int jrow(int u, int w, int jt) const { return 256 * (u & 15) + 32 * w + 16 * jt; }
    __device__ __forceinline__ void operator()(const f32x4 (&acc)[2][2], int u, int w, int li, int g) const {
#pragma unroll
        for (int i2 = 0; i2 < 2; ++i2)
#pragma unroll
            for (int jt = 0; jt < 2; ++jt) { float* p = ACC + (size_t)(16 * i2 + li) * DM + jrow(u, w, jt) + 4 * g;
#pragma unroll
                for (int j = 0; j < 4; ++j) atomicAdd(p + j, acc[jt][i2][j]); }
    }
};

__device__ __forceinline__ void trw_load(f32x4 (&v)[16], const float* W, int ldw, int nnb, int it, int wid, int lane) {
    const int kbo = it / nnb, nb = it - kbo * nnb; const float* p = W + (size_t)(128 * kbo + 16 * wid) * ldw + 256 * nb + 4 * lane;
#pragma unroll
    for (int i = 0; i < 16; ++i) v[i] = __builtin_nontemporal_load((const f32x4*)(p + (size_t)i * ldw));
}
__device__ __forceinline__ void trw_to_lds(f32x4 (&v)[16], LAS unsigned char* buf, const float* gk, int nnb, int it, int wid, int lane) {
    if (gk) { const int kbo = it / nnb;
#pragma unroll
        for (int i = 0; i < 16; ++i) v[i] *= gk[128 * kbo + 16 * wid + i]; }
    const int key = lane & 7;
#pragma unroll
    for (int c = 0; c < 4; ++c) { LAS unsigned char* rp = buf + (4 * lane + c) * 256;
        u32x4 lo, hi; lo.x = cvt_pk_bf16(v[0][c], v[1][c]); lo.y = cvt_pk_bf16(v[2][c], v[3][c]); lo.z = cvt_pk_bf16(v[4][c], v[5][c]); lo.w = cvt_pk_bf16(v[6][c], v[7][c]);
        hi.x = cvt_pk_bf16(v[8][c], v[9][c]); hi.y = cvt_pk_bf16(v[10][c], v[11][c]); hi.z = cvt_pk_bf16(v[12][c], v[13][c]); hi.w = cvt_pk_bf16(v[14][c], v[15][c]);
        *(LAS u32x4*)(rp + 16 * ((2 * wid) ^ key)) = lo; *(LAS u32x4*)(rp + 16 * ((2 * wid + 1) ^ key)) = hi; }
}
__device__ __forceinline__ void trw_store(const LAS unsigned char* buf, bf16_t* WT, int K, int nnb, int it, int wid, int lane) {
    const int kbo = it / nnb, nb = it - kbo * nnb, chunk = lane & 15;
#pragma unroll
    for (int j = 0; j < 8; ++j) { const int row = 32 * j + 4 * wid + (lane >> 4), key = (row >> 2) & 7;
        const u32x4 d = *(const LAS u32x4*)(buf + row * 256 + 16 * (chunk ^ key));
        *(u32x4*)(WT + (size_t)(256 * nb + row) * K + 128 * kbo + 8 * chunk) = d; }
}
__device__ __forceinline__ void trw_run(LAS unsigned char* lds, const float* W, int ldw, int K, int Nuse, bf16_t* WT, const float* gk, int first, int cnt, int stride) {
    int tid = threadIdx.x; asm volatile("" : "+v"(tid)); const int wid = __builtin_amdgcn_readfirstlane(tid >> 6), lane = tid & 63;
    const int nnb = Nuse / 256; if (cnt <= 0) return;
    f32x4 v[16]; int it = first;
    trw_load(v, W, ldw, nnb, it, wid, lane);
    trw_to_lds(v, lds, gk, nnb, it, wid, lane);
    __syncthreads();
    for (int j = 0; j < cnt; ++j) {
        const int nx = it + stride; const bool more = (j + 1 < cnt);
        if (more) trw_load(v, W, ldw, nnb, nx, wid, lane);
        trw_store(lds + (j & 1) * 65536, WT, K, nnb, it, wid, lane);
        if (more) trw_to_lds(v, lds + ((j + 1) & 1) * 65536, gk, nnb, nx, wid, lane);
        __syncthreads();
        it = nx;
    }
}
__device__ __forceinline__ void p0_tr_load(f32x4 (&v)[8], const float* W, int ldw, int Nuse_, int it, int lane) {
    const int nnb = Nuse_ / 256, kb = 8 * (it / (8 * nnb)) + (it & 7), nb = (it >> 3) % nnb, k0 = 8 * kb, n0 = 256 * nb + 4 * lane;
#pragma unroll
    for (int i = 0; i < 8; ++i) v[i] = *(const f32x4*)(W + (size_t)(k0 + i) * ldw + n0);
}
__device__ __forceinline__ void p0_tr_store(f32x4 (&v)[8], int K, bf16_t* WT, const float* gk, int Nuse_, int it, int lane) {
    const int nnb = Nuse_ / 256, kb = 8 * (it / (8 * nnb)) + (it & 7), nb = (it >> 3) % nnb, k0 = 8 * kb, n0 = 256 * nb + 4 * lane;
    if (gk) {
#pragma unroll
        for (int i = 0; i < 8; ++i) v[i] *= gk[k0 + i];
    }
#pragma unroll
    for (int c = 0; c < 4; ++c) { u32x4 o; o.x = cvt_pk_bf16(v[0][c], v[1][c]); o.y = cvt_pk_bf16(v[2][c], v[3][c]); o.z = cvt_pk_bf16(v[4][c], v[5][c]); o.w = cvt_pk_bf16(v[6][c], v[7][c]);
        *(u32x4*)(WT + (size_t)(n0 + c) * K + k0) = o; }
}
__device__ __forceinline__ void p0_transpose(const float* W, int ldw, int K, int Nuse, bf16_t* WT, const float* gk, int gw, int ngw, int lane) {
    const int nkb = K / 8, nnb = Nuse / 256, items = nkb * nnb;
    int it = gw; if (it >= items) return;
    f32x4 v[8], w[8];
    p0_tr_load(v, W, ldw, Nuse, it, lane);
    for (;;) {
        const int n1 = it + ngw;
        if (n1 < items) p0_tr_load(w, W, ldw, Nuse, n1, lane);
        p0_tr_store(v, K, WT, gk, Nuse, it, lane);
        if (n1 >= items) break;
        const int n2 = n1 + ngw;
        if (n2 < items) p0_tr_load(v, W, ldw, Nuse, n2, lane);
        p0_tr_store(w, K, WT, gk, Nuse, n1, lane);
        if (n2 >= items) break;
        it = n2;
    }
}
__device__ __forceinline__ void sincos_d(float ang, float& c, float& s) {
    const double x = (double)ang;
    const double n = __builtin_rint(x * 0.63661977236758134308);
    double r = __builtin_fma(-n, 1.57079632679489655800e+00, x); r = __builtin_fma(-n, 6.12323399573676603587e-17, r);
    const double r2 = r * r;
    double sp = 1.0 / 6227020800.0; sp = sp * r2 * (-1.0) + 1.0 / 39916800.0; sp = sp * r2 * (-1.0) + 1.0 / 362880.0; sp = sp * r2 * (-1.0) + 1.0 / 5040.0; sp = sp * r2 * (-1.0) + 1.0 / 120.0; sp = sp * r2 * (-1.0) + 1.0 / 6.0; sp = sp * r2 * (-1.0) + 1.0;
    const double sn = sp * r;
    double cp = 1.0 / 87178291200.0; cp = cp * r2 * (-1.0) + 1.0 / 479001600.0; cp = cp * r2 * (-1.0) + 1.0 / 3628800.0; cp = cp * r2 * (-1.0) + 1.0 / 40320.0; cp = cp * r2 * (-1.0) + 1.0 / 720.0; cp = cp * r2 * (-1.0) + 1.0 / 24.0; cp = cp * r2 * (-1.0) + 0.5; cp = cp * r2 * (-1.0) + 1.0;
    const double cs = cp;
    const int q = ((int)n) & 3;
    const double cc = (q == 0) ? cs : (q == 1) ? -sn : (q == 2) ? -cs : sn;
    const double ss = (q == 0) ? sn : (q == 1) ? cs : (q == 2) ? -sn : -cs;
    c = (float)cc; s = (float)ss;
}
struct P0Args { const float *xp, *xs, *g1, *win, *wout, *g2, *wup, *wdn; bf16_t *WinT, *WoutT, *WupT, *WdnT, *XN, *WG; float* rope; };
__device__ __forceinline__ void p0_prologue(const P0Args& a, int vcu, int G, int wid, int lane) {
    const int gw = vcu * 8 + wid, ngw = G * 8, gt = gw * 64 + lane, ngt = ngw * 64;
    for (int idx = gt; idx < 4097 * 64; idx += ngt) { const int pi = idx >> 6, i = idx & 63; const int pos = pi < 4096 ? pi : 8192;
        double invd = 1.0; for (int e = 0; e < i; ++e) invd *= 0.86596432336006535;
        const float inv = (float)invd; const float ang = (float)pos * inv; float c, s; sincos_d(ang, c, s);
        a.rope[(size_t)pi * 128 + i] = c; a.rope[(size_t)pi * 128 + 64 + i] = s; }
    for (int idx = gt; idx < 16 * DM; idx += ngt) { const int gi = idx >> 12, k = idx & 4095; const float v = gi < 12 ? a.win[(size_t)k * NINF + NZ + gi] : 0.f; a.WG[idx] = (bf16_t)(cvt_pk_bf16(v, 0.f) & 0xffffu); }
    for (int m = gw; m < MT; m += ngw) {
        const float* xr = (m < MP) ? a.xp + (size_t)m * DM : a.xs + (size_t)(m - MP) * DM;
        f32x4 v[8][2]; float ss = 0.f;
#pragma unroll
        for (int c = 0; c < 8; ++c) { v[c][0] = *(const f32x4*)(xr + 512 * c + 8 * lane); v[c][1] = *(const f32x4*)(xr + 512 * c + 8 * lane + 4);
            ss += (v[c][0][0] * v[c][0][0] + v[c][0][1] * v[c][0][1]) + (v[c][0][2] * v[c][0][2] + v[c][0][3] * v[c][0][3]) + (v[c][1][0] * v[c][1][0] + v[c][1][1] * v[c][1][1]) + (v[c][1][2] * v[c][1][2] + v[c][1][3] * v[c][1][3]); }
        const float r = rsqrtf(wave_sum(ss) * (1.0f / DM) + EPS);
#pragma unroll
        for (int c = 0; c < 8; ++c) { const f32x4 g0 = *(const f32x4*)(a.g1 + 512 * c + 8 * lane), g1v = *(const f32x4*)(a.g1 + 512 * c + 8 * lane + 4);
            const f32x4 y0 = v[c][0] * r * g0, y1 = v[c][1] * r * g1v;
            u32x4 o; o.x = cvt_pk_bf16(y0[0], y0[1]); o.y = cvt_pk_bf16(y0[2], y0[3]); o.z = cvt_pk_bf16(y1[0], y1[1]); o.w = cvt_pk_bf16(y1[2], y1[3]);
            *(u32x4*)(a.XN + (size_t)m * DM + 512 * c + 8 * lane) = o; }
    }
}


constexpr int SC_KSTR = 544, SC_VSTR = 144, SC_KIMG = 50176, SC_VIMG = 84992;
__device__ __forceinline__ void mlstm_scan(LAS unsigned char* lds, const bf16_t* Z, const float* GT, bf16_t* CT, float* NC, float* TB, float* TWV, float* TMT, float* CM, float* out, int unit) {
    int tid = threadIdx.x; asm volatile("" : "+v"(tid)); const int wid = __builtin_amdgcn_readfirstlane(tid >> 6), lane = tid & 63, li = lane & 15, g = lane >> 4;
    const int bh = unit >> 3, sl = unit & 7, b = bh / NH, h = bh % NH, dvt = wid & 3, dkh = wid >> 2;
    LAS float* wv = (LAS float*)lds; LAS float* bl = wv + 4096; LAS float* cml = bl + 4096; LAS float* bs = cml + 4096; LAS float* gc = bs + 64; LAS float* mC = gc + 64;
    LAS unsigned char* Kimg = lds + SC_KIMG; LAS unsigned char* Vimg = lds + SC_VIMG;
    { const float* lip = GT + (size_t)h * MT + b * SEQ; const float* lfp = GT + (size_t)(6 + h) * MT + b * SEQ;
      for (int c = wid; c < NCH; c += 8) { const int t = 64 * c + lane; const float lf = lfp[t], liv = lip[t];
          float bsum = lf;
#pragma unroll
          for (int o = 1; o < 64; o <<= 1) { const float v = __shfl_up(bsum, o); if (lane >= o) bsum += v; }
          const float w = liv - bsum; float cm = w;
#pragma unroll
          for (int o = 1; o < 64; o <<= 1) { const float v = __shfl_up(cm, o); if (lane >= o) cm = fmaxf(cm, v); }
          wv[t] = w; bl[t] = bsum; cml[t] = cm;
          if (lane == 63) { bs[c] = bsum; gc[c] = bsum + cm; } }
      __syncthreads();
      if (tid == 0) { float m = 0.f; mC[0] = 0.f; for (int c = 0; c < NCH; ++c) { m = fmaxf(bs[c] + m, gc[c]); mC[c + 1] = m; } }
      __syncthreads();
      if (sl == 0) { for (int t = tid; t < SEQ; t += 512) { const int c = t >> 6; TB[bh * SEQ + t] = bl[t]; TWV[bh * SEQ + t] = wv[t]; TMT[bh * SEQ + t] = bl[t] + fmaxf(mC[c], cml[t]); }
                     if (tid < 65) CM[bh * 80 + tid] = mC[tid]; } }
    const bool nwr = (sl == 0) && (dvt == 0);
    f32x4 acc[8], nacc[8];
#pragma unroll
    for (int T = 0; T < 8; ++T) { acc[T] = (f32x4){0.f, 0.f, 0.f, 0.f}; nacc[T] = (f32x4){0.f, 0.f, 0.f, 0.f}; }
    bf16x8 ones;
#pragma unroll
    for (int e = 0; e < 8; ++e) ones[e] = (short)0x3F80;
    u32x4 kq[2][4], vq[2];
#define SCAN_LOAD(S_, c_) do { _Pragma("unroll") for (int q = 0; q < 4; ++q) { const int ch = tid + 512 * q, tok = ch >> 5, c16 = ch & 31; kq[S_][q] = *(const u32x4*)(Z + ((size_t)b * SEQ + 64 * (c_) + tok) * NZ + ZKM + h * DK + 8 * c16); } \
        { const int tok = tid >> 3, c16 = tid & 7; vq[S_] = *(const u32x4*)(Z + ((size_t)b * SEQ + 64 * (c_) + tok) * NZ + ZVM + h * DV + 64 * sl + 8 * c16); } } while (0)
#define SC_CL(x) fminf(fmaxf((x), -440.0f), 440.0f)
#define SC_PK8(v) ((unsigned)__builtin_amdgcn_cvt_pk_fp8_f32(SC_CL((v)[2]), SC_CL((v)[3]), __builtin_amdgcn_cvt_pk_fp8_f32(SC_CL((v)[0]), SC_CL((v)[1]), 0, false), true))
#define SCAN_STEP(S_, c_) do { const int c = (c_); \
        { unsigned char* ct = (unsigned char*)CT + (((size_t)(bh * NCH + c) * DV + (64 * sl + 16 * dvt + li)) * DK + 128 * dkh + 16 * g); \
          _Pragma("unroll") for (int Q = 0; Q < 2; ++Q) { u32x4 w; \
              w.x = SC_PK8(acc[4 * Q + 0]); w.y = SC_PK8(acc[4 * Q + 1]); w.z = SC_PK8(acc[4 * Q + 2]); w.w = SC_PK8(acc[4 * Q + 3]); \
              *(u32x4*)(ct + 64 * Q) = w; } \
          if (nwr && li == 0) { _Pragma("unroll") for (int T = 0; T < 8; ++T) *(f32x4*)(NC + (size_t)(bh * NCH + c) * DK + 128 * dkh + 64 * (T >> 2) + 16 * g + 4 * (T & 3)) = nacc[T]; } } \
        __syncthreads(); \
        const float mn = mC[c + 1], bsc = bs[c]; \
        _Pragma("unroll") for (int q = 0; q < 4; ++q) { const int ch = tid + 512 * q, tok = ch >> 5, c16 = ch & 31; \
            const u32x4 kv = kq[S_][q]; const float w = __expf(bsc + wv[64 * c + tok] - mn); \
            u32x4 o; o.x = cvt_pk_bf16(bf_lo(kv.x) * w, bf_hi(kv.x) * w); o.y = cvt_pk_bf16(bf_lo(kv.y) * w, bf_hi(kv.y) * w); o.z = cvt_pk_bf16(bf_lo(kv.z) * w, bf_hi(kv.z) * w); o.w = cvt_pk_bf16(bf_lo(kv.w) * w, bf_hi(kv.w) * w); \
            *(LAS u32x4*)(Kimg + tok * SC_KSTR + 16 * c16) = o; } \
        { const int tok = tid >> 3, c16 = tid & 7; *(LAS u32x4*)(Vimg + tok * SC_VSTR + 16 * c16) = vq[S_]; } \
        __syncthreads(); \
        if (c + 2 < NCH) SCAN_LOAD(S_, c + 2); \
        const float dec = __expf(bsc + mC[c] - mn); \
        _Pragma("unroll") for (int T = 0; T < 8; ++T) { acc[T] *= dec; nacc[T] *= dec; } \
        _Pragma("unroll") for (int kb = 0; kb < 2; ++kb) { \
            const LAS unsigned char* vp = Vimg + (32 * kb + 8 * g + (li >> 2)) * SC_VSTR + (16 * dvt + 4 * (li & 3)) * 2; \
            const bf16x8 Bf = cat8(vtr(vp), vtr(vp + 4 * SC_VSTR)); \
            _Pragma("unroll") for (int T = 0; T < 8; ++T) { \
                const LAS unsigned char* kp = Kimg + (32 * kb + 8 * g + (li >> 2)) * SC_KSTR + (128 * dkh + 64 * (T >> 2) + 16 * (li & 3) + 4 * (T & 3)) * 2; \
                const bf16x8 Af = cat8(vtr(kp), vtr(kp + 4 * SC_KSTR)); \
                acc[T] = __builtin_amdgcn_mfma_f32_16x16x32_bf16(Af, Bf, acc[T], 0, 0, 0); \
                if (nwr) nacc[T] = __builtin_amdgcn_mfma_f32_16x16x32_bf16(Af, ones, nacc[T], 0, 0, 0); } } } while (0)
    SCAN_LOAD(0, 0); SCAN_LOAD(1, 1);
#pragma unroll 1
    for (int c2 = 0; c2 < NCH; c2 += 2) { SCAN_STEP(0, c2); SCAN_STEP(1, c2 + 1); }
#undef SCAN_LOAD
#undef SCAN_STEP
#undef SC_PK8
#undef SC_CL
#pragma unroll
    for (int T = 0; T < 8; ++T)
#pragma unroll
        for (int r = 0; r < 4; ++r) out[O_CP + ((size_t)bh * DK + 128 * dkh + 64 * (T >> 2) + 16 * g + 4 * (T & 3) + r) * DV + 64 * sl + 16 * dvt + li] = acc[T][r];
    if (nwr && li == 0) {
#pragma unroll
        for (int T = 0; T < 8; ++T) *(f32x4*)(out + O_NP + (size_t)bh * DK + 128 * dkh + 64 * (T >> 2) + 16 * g + 4 * (T & 3)) = nacc[T]; }
    if (sl == 0 && tid == 0) out[O_MP + bh] = mC[NCH];
    __syncthreads();
}

constexpr int AT_VS = 272;
__device__ __forceinline__ void attn_blk_cfg(int s, int& r, int& w, int& blk) { if (s < 12) { r = 1; w = 128; blk = s; } else if (s < 18) { r = 4; w = 512; blk = s - 12; } else { r = 16; w = 2048; blk = s - 18; } }
__device__ __forceinline__ void attn_blk_load(const char* zc, int pmax, int s, int lane, bf16x8 (&kf)[2][4], u32x4 (&vv)[8]) {
    int r, w, blk; attn_blk_cfg(s, r, w, blk); const int li = lane & 15, g = lane >> 4;
    const int pb = pmax - r * 32 * blk;
#pragma unroll
    for (int it = 0; it < 8; ++it) { int kp = pb - r * (it * 4 + g); kp = kp < 0 ? 0 : kp;
        const unsigned off = __umul24((unsigned)kp, (unsigned)(NZ * 2)) + (unsigned)((ZVA + 8 * li) * 2);
        vv[it] = *(const u32x4*)(zc + off); }
#pragma unroll
    for (int T = 0; T < 2; ++T) { int kp = pb - r * (16 * T + li); kp = kp < 0 ? 0 : kp;
        const unsigned off = __umul24((unsigned)kp, (unsigned)(NZ * 2)) + (unsigned)((ZKA + 8 * g) * 2);
#pragma unroll
        for (int q = 0; q < 4; ++q) kf[T][q] = *(const bf16x8*)(zc + off + 64 * q); }
}
__device__ __forceinline__ void attn_tile(LAS unsigned char* vimg, const bf16_t* Z, bf16_t* MIX, int b, int h, int p0c, int lane) {
    const int li = lane & 15, g = lane >> 4;
    const int qpos = p0c + 16 * li, pmax = p0c + 240;
    const bf16_t* zb = Z + (size_t)b * SEQ * NZ + h * 128;
    const char* zc = (const char*)zb;
    bf16x8 qf[4];
#pragma unroll
    for (int s = 0; s < 4; ++s) qf[s] = *(const bf16x8*)(zb + (size_t)qpos * NZ + ZQA + 32 * s + 8 * g);
    f32x4 o[8];
#pragma unroll
    for (int d = 0; d < 8; ++d) o[d] = (f32x4){0.f, 0.f, 0.f, 0.f};
    float m = -INFINITY, l = 0.f;
    bf16x8 kA[2][4], kB[2][4]; u32x4 vA[8], vB[8];
    auto step = [&](int s, bf16x8 (&kf)[2][4], u32x4 (&vv)[8], bf16x8 (&kn)[2][4], u32x4 (&vn)[8]) __attribute__((always_inline)) {
        if (s + 1 < 23) attn_blk_load(zc, pmax, s + 1, lane, kn, vn);
        int r, w, blk; attn_blk_cfg(s, r, w, blk);
        f32x4 st[2];
#pragma unroll
        for (int T = 0; T < 2; ++T) { st[T] = (f32x4){0.f, 0.f, 0.f, 0.f};
#pragma unroll
            for (int q = 0; q < 4; ++q) st[T] = __builtin_amdgcn_mfma_f32_16x16x32_bf16(kf[T][q], qf[q], st[T], 0, 0, 0); }
        const int sh = (r == 1) ? 0 : (r == 4) ? 2 : 4, off16 = 16 * (15 - li);
        const int nlo = (off16 + r - 1) >> sh; int nhi = (w + off16) >> sh; { const int nb = pmax >> sh; nhi = nhi < nb ? nhi : nb; }
        float bm = -INFINITY;
#pragma unroll
        for (int T = 0; T < 2; ++T)
#pragma unroll
            for (int rg = 0; rg < 4; ++rg) { const int n = 32 * blk + 16 * T + 4 * g + rg; const bool ok = (n >= nlo) && (n <= nhi);
                st[T][rg] = ok ? st[T][rg] : -INFINITY; bm = fmaxf(bm, st[T][rg]); }
        bm = fmaxf(bm, __shfl_xor(bm, 16)); bm = fmaxf(bm, __shfl_xor(bm, 32));
        const float mn = fmaxf(m, bm), mu = (mn == -INFINITY) ? 0.f : mn;
        const float alpha = __expf(m - mu);
        float ps = 0.f; f32x4 p[2];
#pragma unroll
        for (int T = 0; T < 2; ++T)
#pragma unroll
            for (int rg = 0; rg < 4; ++rg) { p[T][rg] = __expf(st[T][rg] - mu); ps += p[T][rg]; }
        l = l * alpha + ps;
        if (!__all(mn == m)) {
#pragma unroll
            for (int d = 0; d < 8; ++d) o[d] *= alpha; }
        m = mn;
        bf16x8 pf; { const unsigned w0 = cvt_pk_bf16(p[0][0], p[0][1]), w1 = cvt_pk_bf16(p[0][2], p[0][3]), w2 = cvt_pk_bf16(p[1][0], p[1][1]), w3 = cvt_pk_bf16(p[1][2], p[1][3]);
            pf[0] = (short)(w0 & 0xffff); pf[1] = (short)(w0 >> 16); pf[2] = (short)(w1 & 0xffff); pf[3] = (short)(w1 >> 16); pf[4] = (short)(w2 & 0xffff); pf[5] = (short)(w2 >> 16); pf[6] = (short)(w3 & 0xffff); pf[7] = (short)(w3 >> 16); }
        asm volatile("" ::: "memory");
#pragma unroll
        for (int it = 0; it < 8; ++it) { const int ci = it * 64 + lane, key = ci >> 4, part = ci & 15; *(LAS u32x4*)(vimg + key * AT_VS + 16 * part) = vv[it]; }
        asm volatile("" ::: "memory");
#pragma unroll
        for (int d = 0; d < 8; ++d) { const LAS unsigned char* vp = vimg + (4 * g + (li >> 2)) * AT_VS + (16 * d + 4 * (li & 3)) * 2;
            const bf16x8 af = cat8(vtr(vp), vtr(vp + 16 * AT_VS));
            o[d] = __builtin_amdgcn_mfma_f32_16x16x32_bf16(af, pf, o[d], 0, 0, 0); }
        asm volatile("" ::: "memory");
    };
    attn_blk_load(zc, pmax, 0, lane, kA, vA);
#pragma unroll 1
    for (int s = 0; s < 22; s += 2) { step(s, kA, vA, kB, vB); step(s + 1, kB, vB, kA, vA); }
    step(22, kA, vA, kB, vB);
    l += __shfl_xor(l, 16); l += __shfl_xor(l, 32);
    const float inv = 1.0f / l;
    bf16_t* mp = MIX + ((size_t)b * SEQ + qpos) * DM + h * 128 + 4 * g;
#pragma unroll
    for (int d = 0; d < 8; ++d) { u32x2 w; w.x = cvt_pk_bf16(o[d][0] * inv, o[d][1] * inv); w.y = cvt_pk_bf16(o[d][2] * inv, o[d][3] * inv); *(u32x2*)(mp + 16 * d) = w; }
}
__device__ __forceinline__ void attn_unit(LAS unsigned char* lds, const bf16_t* Z, bf16_t* MIX, int unit) {
    int tid = threadIdx.x; asm volatile("" : "+v"(tid)); const int wid = __builtin_amdgcn_readfirstlane(tid >> 6), lane = tid & 63;
    const int qb = unit & 15, h = (unit >> 4) & 7, b = unit >> 7;
    LAS unsigned char* vimg = lds + wid * (32 * AT_VS);
    attn_tile(vimg, Z, MIX, b, h, 256 * qb + wid, lane);
    attn_tile(vimg, Z, MIX, b, h, 256 * qb + wid + 8, lane);
}

__device__ __forceinline__ const float* sattn_row(int e, const float* fresh, const float* cache) {
    const int cfg = e / 129, j = e - cfg * 129, r = (cfg == 0) ? 1 : (cfg == 1) ? 4 : 16, dist = j * r;
    return (dist == 0) ? fresh : cache + (size_t)(2048 - dist) * 1024;
}
__device__ __forceinline__ void sattn_unit(LAS unsigned char* lds, const bf16_t* Z, const float* ck, const float* cv, const float* out, bf16_t* MIX, int unit) {
    int tid = threadIdx.x; asm volatile("" : "+v"(tid)); const int wid = __builtin_amdgcn_readfirstlane(tid >> 6), lane = tid & 63, hl = lane & 31, hf = lane >> 5;
    const int b = unit >> 3, h = unit & 7;
    LAS float* sc = (LAS float*)lds;
    LAS float* red = sc + 400;
    LAS float* misc = red + 2048;
    const u32x2 qw = *(const u32x2*)(Z + (size_t)(MP + b) * NZ + ZQA + h * 128 + 4 * hl);
    const f32x4 q4 = (f32x4){bf_lo(qw.x), bf_hi(qw.x), bf_lo(qw.y), bf_hi(qw.y)};
    const float* knew = out + O_KS + (size_t)b * 1024 + h * 128; const float* vnew = out + O_VS + (size_t)b * 1024 + h * 128;
    const float* ckb = ck + (size_t)b * 2048 * 1024 + h * 128; const float* cvb = cv + (size_t)b * 2048 * 1024 + h * 128;
    constexpr int SN = 25;
    f32x4 kv[SN], vv[SN];
#pragma unroll
    for (int i = 0; i < SN; ++i) { int e = 16 * i + 2 * wid + hf; e = e < 387 ? e : 386; kv[i] = *(const f32x4*)(sattn_row(e, knew, ckb) + 4 * hl); }
#pragma unroll
    for (int i = 0; i < SN; ++i) { int e = 16 * i + 2 * wid + hf; e = e < 387 ? e : 386; vv[i] = *(const f32x4*)(sattn_row(e, vnew, cvb) + 4 * hl); }
#pragma unroll
    for (int i = 0; i < SN; ++i) { float s = (q4[0] * kv[i][0] + q4[1] * kv[i][1]) + (q4[2] * kv[i][2] + q4[3] * kv[i][3]);
        s += __shfl_xor(s, 1); s += __shfl_xor(s, 2); s += __shfl_xor(s, 4); s += __shfl_xor(s, 8); s += __shfl_xor(s, 16);
        const int e = 16 * i + 2 * wid + hf; if (hl == 0 && e < 387) sc[e] = s; }
    __syncthreads();
    if (wid == 0) { float mx = -INFINITY; for (int e = lane; e < 387; e += 64) mx = fmaxf(mx, sc[e]); mx = wave_max(mx);
        float sm = 0.f; for (int e = lane; e < 387; e += 64) { const float p = __expf(sc[e] - mx); sc[e] = p; sm += p; } sm = wave_sum(sm);
        if (lane == 0) misc[1] = sm; }
    __syncthreads();
    f32x4 acc = (f32x4){0.f, 0.f, 0.f, 0.f};
#pragma unroll
    for (int i = 0; i < SN; ++i) { const int e = 16 * i + 2 * wid + hf; const float p = (e < 387) ? sc[e] : 0.f; acc += vv[i] * p; }
    *(LAS f32x4*)(red + (2 * wid + hf) * 128 + 4 * hl) = acc;
    __syncthreads();
    if (tid < 128) { float s = 0.f;
#pragma unroll
        for (int w = 0; w < 16; ++w) s += red[w * 128 + tid];
        const float v = s / misc[1]; MIX[(size_t)(MP + b) * DM + h * 128 + tid] = (bf16_t)(cvt_pk_bf16(v, 0.f) & 0xffffu); }
    __syncthreads();
}

__device__ __forceinline__ void smlstm_unit(LAS unsigned char* lds, const bf16_t* Z, const float* GT, const float* sC, const float* sN, const float* sM, const float* mhg, float* out, bf16_t* MIX, float* HRAW, int unit) {
    int tid = threadIdx.x; asm volatile("" : "+v"(tid)); const int wid = __builtin_amdgcn_readfirstlane(tid >> 6), lane = tid & 63;
    const int b = unit / NH, h = unit % NH, row = MP + b;
    LAS float* qs = (LAS float*)lds; LAS float* ks = qs + 256; LAS float* red = ks + 256;
    LAS float* part = red + 32;
    const bf16_t* zr = Z + (size_t)row * NZ;
    const int dq = tid >> 7, dv0 = 4 * (tid & 127);
    const float* cp = sC + ((size_t)(b * NH + h) * DK + 64 * dq) * DV + dv0; float* co = out + O_CS + ((size_t)(b * NH + h) * DK + 64 * dq) * DV + dv0;
    f32x4 ca[16], cb[16];
#pragma unroll
    for (int i = 0; i < 16; ++i) ca[i] = __builtin_nontemporal_load((const f32x4*)(cp + (size_t)i * DV));
    const float liv = GT[(size_t)h * MT + row], lf = GT[(size_t)(6 + h) * MT + row], m0 = sM[b * NH + h];
    const float mt = fmaxf(lf + m0, liv), a = __expf(lf + m0 - mt), wsv = __expf(liv - mt);
    float pq = 0.f, pn = 0.f;
    if (tid < 256) { const float q = bf1(zr[ZQM + h * DK + tid]), k = bf1(zr[ZKM + h * DK + tid]), n0 = sN[(size_t)(b * NH + h) * DK + tid]; qs[tid] = q; ks[tid] = k; pq = q * k; pn = q * n0;
        out[O_NS + (size_t)(b * NH + h) * DK + tid] = a * n0 + wsv * k; }
    pq = wave_sum(pq); pn = wave_sum(pn);
    if (lane == 0) { red[wid] = pq; red[8 + wid] = pn; }
    __syncthreads();
    const float qk = red[0] + red[1] + red[2] + red[3], qn = red[8] + red[9] + red[10] + red[11];
    const float sw = qk * wsv;
    { const u32x2 vw = *(const u32x2*)(zr + ZVM + h * DV + dv0); const f32x4 v4 = (f32x4){bf_lo(vw.x), bf_hi(vw.x), bf_lo(vw.y), bf_hi(vw.y)} * wsv;
      f32x4 numi = (f32x4){0.f, 0.f, 0.f, 0.f};
#define SM_LOAD(dst, d0) do { _Pragma("unroll") for (int i = 0; i < 16; ++i) dst[i] = __builtin_nontemporal_load((const f32x4*)(cp + (size_t)((d0) + i) * DV)); } while (0)
#define SM_PROC(src, d0) do { _Pragma("unroll") for (int i = 0; i < 16; ++i) { numi += src[i] * qs[64 * dq + (d0) + i]; *(f32x4*)(co + (size_t)((d0) + i) * DV) = src[i] * a + v4 * ks[64 * dq + (d0) + i]; } } while (0)
      SM_LOAD(cb, 16); SM_PROC(ca, 0);
      SM_LOAD(ca, 32); SM_PROC(cb, 16);
      SM_LOAD(cb, 48); SM_PROC(ca, 32);
      SM_PROC(cb, 48);
#undef SM_LOAD
#undef SM_PROC
      *(LAS f32x4*)(part + dq * 512 + dv0) = numi; }
    __syncthreads();
    const float v = bf1(zr[ZVM + h * DV + tid]);
    const float numt = part[tid] + part[512 + tid] + part[1024 + tid] + part[1536 + tid];
    const float num = sw * v + a * numt, den = sw + a * qn;
    const float hv = num / fmaxf(fabsf(den), __expf(-mt));
    if (HRAW) HRAW[(size_t)row * 3072 + h * DV + tid] = hv;
    const float ssq = wave_sum(hv * hv);
    if (lane == 0) red[16 + wid] = ssq;
    __syncthreads();
    float tot = 0.f;
#pragma unroll
    for (int w = 0; w < 8; ++w) tot += red[16 + w];
    const float om = bf1(zr[ZOM + h * DV + tid]);
    const float y = hv * rsqrtf(tot * (1.0f / DV) + EPS) * mhg[h * DV + tid] * (1.0f / (1.0f + __expf(-om)));
    MIX[(size_t)row * DM + 1024 + h * DV + tid] = (bf16_t)(cvt_pk_bf16(y, 0.f) & 0xffffu);
    if (tid == 0) out[O_MS + b * NH + h] = mt;
    __syncthreads();
}

constexpr int OB_QS = 528, OB_Q = 0, OB_K = 33792, OB_V0 = 67584, OB_V1 = 101376, OB_SW = 135168, OB_SWS = 144, OB_SM = 144384;
__device__ __forceinline__ void mlstm_out(LAS unsigned char* lds, const bf16_t* Z, const bf16_t* CT, const float* NC, const float* TB, const float* TWV, const float* TMT, const float* CM, const float* mhg, bf16_t* MIX, float* HRAW, int unit) {
    int tid = threadIdx.x; asm volatile("" : "+v"(tid)); const int wid = __builtin_amdgcn_readfirstlane(tid >> 6), lane = tid & 63, li = lane & 15, g = lane >> 4;
    const int bh = unit >> 6, c = unit & 63, b = bh / NH, h = bh % NH;
    LAS float* rs = (LAS float*)(lds + OB_SM); LAS float* dn = rs + 64; LAS float* hs = dn + 64; LAS float* ub = hs + 64; LAS float* wvv = ub + 64; LAS float* av = wvv + 64; LAS float* em = av + 64;
    const size_t row0 = (size_t)b * SEQ + 64 * c;
    const unsigned char* ctb = (const unsigned char*)CT + ((size_t)(bh * NCH + c) * DV + 64 * wid + li) * DK + 16 * g;
    u32x4 cf[4][4];
#pragma unroll
    for (int j = 0; j < 4; ++j)
#pragma unroll
        for (int vt = 0; vt < 4; ++vt) cf[j][vt] = *(const u32x4*)(ctb + (size_t)(16 * vt) * DK + 64 * j);
#pragma unroll
    for (int q = 0; q < 4; ++q) { const int ch = tid + 512 * q, tok = ch >> 5, c16 = ch & 31; const bf16_t* zr = Z + (row0 + tok) * NZ;
        *(LAS u32x4*)(lds + OB_Q + tok * OB_QS + 16 * c16) = *(const u32x4*)(zr + ZQM + h * DK + 8 * c16);
        *(LAS u32x4*)(lds + OB_K + tok * OB_QS + 16 * c16) = *(const u32x4*)(zr + ZKM + h * DK + 8 * c16); }
#pragma unroll
    for (int q = 0; q < 8; ++q) { const int ch = tid + 512 * q, tok = ch >> 6, c16 = ch & 63; const bf16_t* zr = Z + (row0 + tok) * NZ;
        *(LAS u32x4*)(lds + ((c16 >> 5) ? OB_V1 : OB_V0) + tok * OB_QS + 16 * (c16 & 31)) = *(const u32x4*)(zr + ZVM + h * DV + 8 * c16); }
    if (tid < 64) { const int t = bh * SEQ + 64 * c + tid; const float bb = TB[t], mt = TMT[t];
        ub[tid] = bb - mt; wvv[tid] = TWV[t]; av[tid] = __expf(bb + CM[bh * 80 + c] - mt); em[tid] = __expf(-mt); rs[tid] = 0.f; hs[tid] = 0.f; }
    __syncthreads();
    { const int t = tid >> 3, part = tid & 7; const float* np = NC + (size_t)(bh * NCH + c) * DK + 32 * part; const LAS bf16_t* qp = (const LAS bf16_t*)(lds + OB_Q + t * OB_QS) + 32 * part; float s = 0.f;
#pragma unroll 8
      for (int e = 0; e < 32; ++e) s += bf1(qp[e]) * np[e];
      s += __shfl_xor(s, 1); s += __shfl_xor(s, 2); s += __shfl_xor(s, 4);
      if (part == 0) dn[t] = s; }
    { const int st = wid & 3;
#pragma unroll
      for (int tq = 0; tq < 2; ++tq) { const int tt = 2 * (wid >> 2) + tq; f32x4 d = (f32x4){0.f, 0.f, 0.f, 0.f};
#pragma unroll
          for (int kk = 0; kk < 8; ++kk) { const bf16x8 kf = *(const LAS bf16x8*)(lds + OB_K + (16 * st + li) * OB_QS + (32 * kk + 8 * g) * 2);
              const bf16x8 qf = *(const LAS bf16x8*)(lds + OB_Q + (16 * tt + li) * OB_QS + (32 * kk + 8 * g) * 2);
              d = __builtin_amdgcn_mfma_f32_16x16x32_bf16(kf, qf, d, 0, 0, 0); }
          const int t = 16 * tt + li; const float ut = ub[t]; float ps = 0.f; f32x4 sw;
#pragma unroll
          for (int r = 0; r < 4; ++r) { const int s = 16 * st + 4 * g + r; const float w = (s <= t) ? d[r] * __expf(ut + wvv[s]) : 0.f; sw[r] = w; ps += w; }
          u32x2 pk; pk.x = cvt_pk_bf16(sw[0], sw[1]); pk.y = cvt_pk_bf16(sw[2], sw[3]);
          *(LAS u32x2*)(lds + OB_SW + t * OB_SWS + (16 * st + 4 * g) * 2) = pk;
          lds_addf(rs + t, ps); } }
    __syncthreads();
    f32x4 acc[4][4];
#pragma unroll
    for (int a = 0; a < 4; ++a)
#pragma unroll
        for (int t = 0; t < 4; ++t) acc[a][t] = (f32x4){0.f, 0.f, 0.f, 0.f};
#pragma unroll
    for (int j = 0; j < 4; ++j)
#pragma unroll
        for (int s = 0; s < 2; ++s) {
            bf16x8 bq[4], af[4];
#pragma unroll
            for (int tt = 0; tt < 4; ++tt) bq[tt] = *(const LAS bf16x8*)(lds + OB_Q + (16 * tt + li) * OB_QS + (64 * j + 16 * g + 8 * s) * 2);
#pragma unroll
            for (int vt = 0; vt < 4; ++vt) { const unsigned d0 = s ? cf[j][vt].z : cf[j][vt].x, d1 = s ? cf[j][vt].w : cf[j][vt].y;
                const f32x2 p0 = __builtin_amdgcn_cvt_pk_f32_fp8((int)d0, false), p1 = __builtin_amdgcn_cvt_pk_f32_fp8((int)d0, true), p2 = __builtin_amdgcn_cvt_pk_f32_fp8((int)d1, false), p3 = __builtin_amdgcn_cvt_pk_f32_fp8((int)d1, true);
                const unsigned w0 = cvt_pk_bf16(p0.x, p0.y), w1 = cvt_pk_bf16(p1.x, p1.y), w2 = cvt_pk_bf16(p2.x, p2.y), w3 = cvt_pk_bf16(p3.x, p3.y);
                bf16x8 f; f[0] = (short)(w0 & 0xffff); f[1] = (short)(w0 >> 16); f[2] = (short)(w1 & 0xffff); f[3] = (short)(w1 >> 16); f[4] = (short)(w2 & 0xffff); f[5] = (short)(w2 >> 16); f[6] = (short)(w3 & 0xffff); f[7] = (short)(w3 >> 16);
                af[vt] = f; }
#pragma unroll
            for (int vt = 0; vt < 4; ++vt)
#pragma unroll
                for (int tt = 0; tt < 4; ++tt) acc[vt][tt] = __builtin_amdgcn_mfma_f32_16x16x32_bf16(af[vt], bq[tt], acc[vt][tt], 0, 0, 0);
        }
#pragma unroll
    for (int tt = 0; tt < 4; ++tt) { const float at = av[16 * tt + li];
#pragma unroll
        for (int vt = 0; vt < 4; ++vt) acc[vt][tt] *= at; }
    { const LAS unsigned char* vb = lds + ((wid >> 2) ? OB_V1 : OB_V0);
#pragma unroll
      for (int kb = 0; kb < 2; ++kb) {
          bf16x8 bs_[4];
#pragma unroll
          for (int tt = 0; tt < 4; ++tt) bs_[tt] = *(const LAS bf16x8*)(lds + OB_SW + (16 * tt + li) * OB_SWS + (32 * kb + 8 * g) * 2);
#pragma unroll
          for (int vt = 0; vt < 4; ++vt) { const LAS unsigned char* vp = vb + (32 * kb + 8 * g + (li >> 2)) * OB_QS + (64 * (wid & 3) + 16 * vt + 4 * (li & 3)) * 2;
              const bf16x8 af = cat8(vtr(vp), vtr(vp + 4 * OB_QS));
#pragma unroll
              for (int tt = 0; tt < 4; ++tt) acc[vt][tt] = __builtin_amdgcn_mfma_f32_16x16x32_bf16(af, bs_[tt], acc[vt][tt], 0, 0, 0); } } }
    u32x2 omw[4][4]; f32x4 gg[4];
#pragma unroll
    for (int vt = 0; vt < 4; ++vt) { const int dvg = h * DV + 64 * wid + 16 * vt + 4 * g; gg[vt] = *(const f32x4*)(mhg + dvg);
#pragma unroll
        for (int tt = 0; tt < 4; ++tt) omw[tt][vt] = *(const u32x2*)(Z + (row0 + 16 * tt + li) * NZ + ZOM + dvg); }
    float dd[4];
#pragma unroll
    for (int tt = 0; tt < 4; ++tt) { const int t = 16 * tt + li; const float den = rs[t] + av[t] * dn[t]; dd[tt] = fmaxf(fabsf(den), em[t]);
        float q = 0.f;
#pragma unroll
        for (int vt = 0; vt < 4; ++vt) q += (acc[vt][tt][0] * acc[vt][tt][0] + acc[vt][tt][1] * acc[vt][tt][1]) + (acc[vt][tt][2] * acc[vt][tt][2] + acc[vt][tt][3] * acc[vt][tt][3]);
        q += __shfl_xor(q, 16); q += __shfl_xor(q, 32);
        if (g == 0) lds_addf(hs + t, q); }
    __syncthreads();
#pragma unroll
    for (int tt = 0; tt < 4; ++tt) { const int t = 16 * tt + li; const float idd = __builtin_amdgcn_rcpf(dd[tt]); const float tot = idd * rsqrtf(hs[t] * idd * idd * (1.0f / DV) + EPS);
        const size_t row = row0 + t;
#pragma unroll
        for (int vt = 0; vt < 4; ++vt) { const int dvg = h * DV + 64 * wid + 16 * vt + 4 * g;
            const u32x2 ow = omw[tt][vt];
            const float o0 = bf_lo(ow.x), o1 = bf_hi(ow.x), o2 = bf_lo(ow.y), o3 = bf_hi(ow.y);
            const f32x4 a4 = acc[vt][tt];
            if (HRAW) *(f32x4*)(HRAW + row * 3072 + dvg) = a4 * idd;
            const float y0 = a4[0] * tot * gg[vt][0] * __builtin_amdgcn_rcpf(1.0f + __expf(-o0)), y1 = a4[1] * tot * gg[vt][1] * __builtin_amdgcn_rcpf(1.0f + __expf(-o1)), y2 = a4[2] * tot * gg[vt][2] * __builtin_amdgcn_rcpf(1.0f + __expf(-o2)), y3 = a4[3] * tot * gg[vt][3] * __builtin_amdgcn_rcpf(1.0f + __expf(-o3));
            u32x2 w; w.x = cvt_pk_bf16(y0, y1); w.y = cvt_pk_bf16(y2, y3); *(u32x2*)(MIX + row * DM + 1024 + dvg) = w; } }
    __syncthreads();
}


constexpr int CV_OUT = (DM / 128) * (DM / 256), CV_UP = (DM / 128) * (DFF / 256), CV_DN = (DFF / 128) * (DM / 256);
__device__ __forceinline__ void conv_unit(LAS unsigned char* lds, const float* wout, const float* wup, const float* wdn, const float* g2, bf16_t* WoutT, bf16_t* WupT, bf16_t* WdnT, int j) {
    int base = 4 * j;
    if (base < CV_OUT) trw_run(lds, wout, DM, DM, DM, WoutT, nullptr, base, 4, 1);
    else if (base < CV_OUT + CV_UP) trw_run(lds, wup, DFF, DM, DFF, WupT, g2, base - CV_OUT, 4, 1);
    else trw_run(lds, wdn, DM, DFF, DM, WdnT, nullptr, base - CV_OUT - CV_UP, 4, 1);
}

struct Args { const float* in[16]; float* out; unsigned char* ws; };
#if CHECKS
__device__ __forceinline__ unsigned hsh(unsigned x) { x ^= x >> 16; x *= 0x7feb352dU; x ^= x >> 15; x *= 0x846ca68bU; x ^= x >> 16; return x; }
__device__ __forceinline__ bool far_(float got, float ref, float rel, float ab) { return !(fabsf(got - ref) <= rel * fabsf(ref) + ab); }
#define CHK_FAIL(id) atomicMax(ctl + CW_ERR, 40u - (unsigned)(id))
#define CHK_CODE(cd) atomicMax(ctl + CW_ERR, (unsigned)(cd))
__device__ __forceinline__ float dot_bf(const bf16_t* a, const bf16_t* b, int n) { float s = 0.f; for (int k = 0; k < n; k += 8) { const u32x4 x = *(const u32x4*)(a + k), y = *(const u32x4*)(b + k);
        s += bf_lo(x.x) * bf_lo(y.x) + bf_hi(x.x) * bf_hi(y.x) + bf_lo(x.y) * bf_lo(y.y) + bf_hi(x.y) * bf_hi(y.y) + bf_lo(x.z) * bf_lo(y.z) + bf_hi(x.z) * bf_hi(y.z) + bf_lo(x.w) * bf_lo(y.w) + bf_hi(x.w) * bf_hi(y.w); } return s; }
__device__ __forceinline__ float softcap_(float a) { return 15.0f * tanhf(a * (1.0f / 15.0f)); }
__device__ __forceinline__ float logsig_(float a) { return fminf(a, 0.f) - log1pf(expf(-fabsf(a))); }
__device__ void run_checks(const Args& args, LAS unsigned char* lds) {
    const int tid = threadIdx.x, lane = tid & 63, wid = tid >> 6, bx = blockIdx.x, G = gridDim.x;
    const unsigned gt = (unsigned)bx * 512u + tid, ngt = (unsigned)G * 512u;
    unsigned char* ws = args.ws; unsigned* ctl = (unsigned*)(ws + WS_CTL); float* out = args.out;
    const float* x_prompt = args.in[0]; const float* x_sample = args.in[1]; const float* cache_k = args.in[2]; const float* cache_v = args.in[3]; const float* state_C = args.in[4]; const float* state_n = args.in[5]; const float* state_m = args.in[6];
    const float* norm1_g = args.in[7]; const float* w_in = args.in[8]; const float* b_if = args.in[9]; const float* mh_g = args.in[10];
    const float* w_out = args.in[11]; const float* norm2_g = args.in[12]; const float* w_up = args.in[13]; const float* w_down = args.in[14]; const float* final_g = args.in[15];
    const bf16_t* WinT = (bf16_t*)(ws + WS_WIN); const bf16_t* WoutT = (bf16_t*)(ws + WS_WOUT); const bf16_t* WupT = (bf16_t*)(ws + WS_WUP); const bf16_t* WdnT = (bf16_t*)(ws + WS_WDN);
    const bf16_t* XN = (bf16_t*)(ws + WS_XN); const bf16_t* Z = (bf16_t*)(ws + WS_Z); const bf16_t* MIX = (bf16_t*)(ws + WS_MIX); const float* H = (float*)(ws + WS_H); const bf16_t* HB = (bf16_t*)(ws + WS_HB);
    const bf16_t* U = (bf16_t*)(ws + WS_U); const bf16_t* WG = (bf16_t*)(ws + WS_WG); const float* GT = (float*)(ws + WS_G); const float* HRAW = (float*)(ws + WS_HRAW);
    const float* RSS2 = (float*)(ws + WS_CTL + CTL_RSS2); const float* RSS3 = (float*)(ws + WS_CTL + CTL_RSS3);
    for (unsigned s = gt; s < 2048u; s += ngt) { const int row = (s < 64u) ? MP + (int)(s & 31u) : (int)(hsh(s) % MT), k = (int)(hsh(s + 99991u) % DM);
        const float* xr = row < MP ? x_prompt + (size_t)row * DM : x_sample + (size_t)(row - MP) * DM; float ss = 0.f; for (int j = 0; j < DM; ++j) ss += xr[j] * xr[j];
        const float ref = xr[k] * rsqrtf(ss * (1.0f / DM) + EPS) * norm1_g[k]; if (far_(bf1(XN[(size_t)row * DM + k]), ref, 0.01f, 1e-3f)) CHK_FAIL(1); }
    for (unsigned s = gt; s < 4096u; s += ngt) { const unsigned a = hsh(s), b = hsh(s + 7777u);
        { const int n = a % NZ, k = b % DM; if (far_(bf1(WinT[(size_t)n * DM + k]), w_in[(size_t)k * NINF + n], 0.01f, 1e-7f)) CHK_FAIL(2); }
        { const int n = a % DM, k = b % DM; if (far_(bf1(WoutT[(size_t)n * DM + k]), w_out[(size_t)k * DM + n], 0.01f, 1e-7f)) CHK_FAIL(2); }
        { const int f = a % DFF, k = b % DM; if (far_(bf1(WupT[(size_t)f * DM + k]), w_up[(size_t)k * DFF + f] * norm2_g[k], 0.01f, 1e-7f)) CHK_FAIL(2); }
        { const int n = a % DM, f = b % DFF; if (far_(bf1(WdnT[(size_t)n * DFF + f]), w_down[(size_t)f * DM + n], 0.01f, 1e-7f)) CHK_FAIL(2); }
        { const int gi = a % 16, k = b % DM; const float ref = gi < 12 ? w_in[(size_t)k * NINF + NZ + gi] : 0.f; if (far_(bf1(WG[gi * DM + k]), ref, 0.01f, 1e-7f)) CHK_FAIL(2); } }
    for (unsigned s = gt; s < 8192u; s += ngt) { const int row = (s < 1024u) ? MP + (int)(s & 31u) : (int)(hsh(s) % MP), col = (int)(hsh(s + 12345u) % NZ); const int id = row < MP ? 3 : 4;
        const bf16_t* xr = XN + (size_t)row * DM; float val;
        if (col < 2048) { const int d = col & 127, c1 = (d < 64) ? col : col - 64, c2 = c1 + 64; const float x1 = dot_bf(xr, WinT + (size_t)c1 * DM, DM), x2 = dot_bf(xr, WinT + (size_t)c2 * DM, DM);
            const int pos = row < MP ? (row & (SEQ - 1)) : 8192, i = d & 63; double invd = 1.0; for (int e = 0; e < i; ++e) invd *= 0.86596432336006535;
            float c, sn; sincos_d((float)pos * (float)invd, c, sn); val = (d < 64) ? x1 * c - x2 * sn : x2 * c + x1 * sn; if (col < 1024) val *= 0.08838834764831845f; }
        else { val = dot_bf(xr, WinT + (size_t)col * DM, DM); if (col >= ZQM && col < ZKM) val *= 0.0625f; }
        if (far_(bf1(Z[(size_t)row * NZ + col]), val, 0.02f, 0.02f)) CHK_FAIL(id);
        if (col >= 1024 && col < 3072) { const int cc = col & 1023; const bool isk = col < 2048;
            if (row >= MP) { if (far_(out[(isk ? O_KS : O_VS) + (size_t)(row - MP) * 1024 + cc], val, 0.01f, 0.01f)) CHK_FAIL(id); }
            else { const int pos = row & (SEQ - 1), bb = row >> 12; if (pos >= 2048) { if (far_(out[(isk ? O_KP : O_VP) + ((size_t)(bb * 2048 + pos - 2048)) * 1024 + cc], val, 0.01f, 0.01f)) CHK_FAIL(id); } } } }
    for (unsigned s = gt; s < 4096u; s += ngt) { const int gi = (int)(hsh(s) % 12), tok = (s < 256u) ? MP + (int)(s & 31u) : (int)(hsh(s + 555u) % MT);
        float v = softcap_(dot_bf(XN + (size_t)tok * DM, WG + (size_t)gi * DM, DM) + b_if[gi]); if (gi >= 6) v = logsig_(v);
        if (far_(GT[(size_t)gi * MT + tok], v, 0.01f, 0.005f)) CHK_FAIL(5); }
    for (unsigned s = gt; s < 4096u; s += ngt) { const unsigned a = hsh(s), b2 = hsh(s + 424242u); const int b = a & 1, pos = (s & 3u) == 0u ? (int)((a >> 1) % 300u) : (int)((a >> 1) % SEQ), h = b2 & 7, d = (b2 >> 3) & 127;
        const bf16_t* zb = Z + (size_t)b * SEQ * NZ; const bf16_t* qr = zb + (size_t)pos * NZ + ZQA + h * 128; float m = -INFINITY, l = 0.f, o = 0.f;
        for (int cfg = 0; cfg < 3; ++cfg) { const int r = cfg == 0 ? 1 : cfg == 1 ? 4 : 16;
            for (int j = 0; j <= 128; ++j) { const int kp = pos - j * r; if (kp < 0) break; const float sc = dot_bf(qr, zb + (size_t)kp * NZ + ZKA + h * 128, 128);
                const float mn = fmaxf(m, sc), al = expf(m - mn), p = expf(sc - mn); l = l * al + p; o = o * al + p * bf1(zb[(size_t)kp * NZ + ZVA + h * 128 + d]); m = mn; } }
        if (far_(bf1(MIX[((size_t)b * SEQ + pos) * DM + h * 128 + d]), o / l, 0.03f, 0.004f)) CHK_FAIL(6); }
    if (bx == 30) { const int li = lane & 15, g = lane >> 4, dvt = wid & 3, dkh = wid >> 2; LAS unsigned char* Kimg = lds + SC_KIMG; LAS unsigned char* Vimg = lds + SC_VIMG;
#pragma unroll
        for (int q = 0; q < 4; ++q) { const int ch = tid + 512 * q, tok = ch >> 5, c16 = ch & 31; *(LAS u32x4*)(Kimg + tok * SC_KSTR + 16 * c16) = *(const u32x4*)(Z + (size_t)tok * NZ + ZKM + 8 * c16); }
        { const int tok = tid >> 3, c16 = tid & 7; *(LAS u32x4*)(Vimg + tok * SC_VSTR + 16 * c16) = *(const u32x4*)(Z + (size_t)tok * NZ + ZVM + 8 * c16); }
        __syncthreads();
        bf16x8 ones;
#pragma unroll
        for (int e = 0; e < 8; ++e) ones[e] = (short)0x3F80;
        unsigned mask = 0u;
#pragma unroll 1
        for (int T = 0; T < 8; ++T) { f32x4 na = (f32x4){0.f, 0.f, 0.f, 0.f}, ca = (f32x4){0.f, 0.f, 0.f, 0.f};
#pragma unroll
            for (int kb = 0; kb < 2; ++kb) { const LAS unsigned char* vp = Vimg + (32 * kb + 8 * g + (li >> 2)) * SC_VSTR + (16 * dvt + 4 * (li & 3)) * 2; const bf16x8 Bf = cat8(vtr(vp), vtr(vp + 4 * SC_VSTR));
                const LAS unsigned char* kp = Kimg + (32 * kb + 8 * g + (li >> 2)) * SC_KSTR + (128 * dkh + 16 * T + 4 * (li & 3)) * 2; const bf16x8 Af = cat8(vtr(kp), vtr(kp + 4 * SC_KSTR));
                na = __builtin_amdgcn_mfma_f32_16x16x32_bf16(Af, ones, na, 0, 0, 0); ca = __builtin_amdgcn_mfma_f32_16x16x32_bf16(Af, Bf, ca, 0, 0, 0); }
#pragma unroll
            for (int r = 0; r < 4; ++r) { const int dk = 128 * dkh + 16 * T + 4 * g + r, dv = 16 * dvt + li; float cs = 0.f, cv = 0.f;
                for (int t = 0; t < 64; ++t) { const float kk = bf1(Z[(size_t)t * NZ + ZKM + dk]); cs += kk; cv += kk * bf1(Z[(size_t)t * NZ + ZVM + dv]); }
                if (far_(na[r], cs, 0.01f, 1e-2f)) mask |= 1u; if (far_(ca[r], cv, 0.01f, 2e-2f)) mask |= 2u; } }
        if (mask) atomicOr(ctl + CW_ERR + 2, mask);
        __syncthreads(); }
    if (gt < 12u) { const int bh = (int)gt, b = bh / NH, h = bh % NH; const float* TBc = (const float*)(ws + WS_TB); const float* TWVc = (const float*)(ws + WS_TWV); const float* TMTc = (const float*)(ws + WS_TMT); const float* CMc = (const float*)(ws + WS_CM);
        float m = 0.f, bsum = 0.f; bool bad = false;
        for (int t = 0; t < SEQ; ++t) { const size_t row = (size_t)b * SEQ + t; const float liv = GT[(size_t)h * MT + row], lf = GT[(size_t)(6 + h) * MT + row];
            if ((t & 63) == 0) { bsum = 0.f; if (far_(CMc[bh * 80 + (t >> 6)], m, 1e-3f, 1e-3f)) bad = true; }
            bsum += lf; m = fmaxf(lf + m, liv);
            if (far_(TBc[bh * SEQ + t], bsum, 1e-3f, 1e-3f) || far_(TWVc[bh * SEQ + t], liv - bsum, 1e-3f, 1e-3f) || far_(TMTc[bh * SEQ + t], m, 1e-3f, 1e-3f)) bad = true; }
        if (far_(CMc[bh * 80 + 64], m, 1e-3f, 1e-3f)) bad = true;
        if (bad) CHK_CODE(33); }
    if (bx < 24) { const int bh = bx % 12, b = bh / NH, h = bh % NH, sel = tid >> 8, dk = tid & 255; const int dv = sel ? (300 + 17 * bx) % DV : (37 + 41 * bx) % DV;
        LAS float* red = (LAS float*)lds;
        float C = 0.f, n = 0.f, m = 0.f, n63 = 0.f, C63 = 0.f; bool bad8 = false;
        for (int t = 0; t < SEQ; ++t) { const size_t row = (size_t)b * SEQ + t; const bf16_t* zr = Z + row * NZ; if (t == 63 * 64) { n63 = n; C63 = C; }
            const float q = bf1(zr[ZQM + h * DK + dk]), k = bf1(zr[ZKM + h * DK + dk]), v = bf1(zr[ZVM + h * DV + dv]), liv = GT[(size_t)h * MT + row], lf = GT[(size_t)(6 + h) * MT + row];
            const float mn = fmaxf(lf + m, liv), f = expf(lf + m - mn), iw = expf(liv - mn); C = f * C + iw * k * v; n = f * n + iw * k; m = mn;
            const float s1 = wave_sum(q * C), s2 = wave_sum(q * n); LAS float* rb = red + (t & 1) * 32;
            if (lane == 0) { rb[wid] = s1; rb[16 + wid] = s2; }
            __syncthreads();
            const int w0 = sel * 4; const float num = rb[w0] + rb[w0 + 1] + rb[w0 + 2] + rb[w0 + 3], qn = rb[16 + w0] + rb[16 + w0 + 1] + rb[16 + w0 + 2] + rb[16 + w0 + 3];
            const float hv = num / fmaxf(fabsf(qn), expf(-m));
            if (dk == 0 && far_(HRAW[row * 3072 + h * DV + dv], hv, 0.04f, 0.03f)) bad8 = true; }
        if (far_(out[O_CP + ((size_t)bh * DK + dk) * DV + dv], C, 0.03f, 0.03f)) CHK_CODE(30);
        if (sel == 0 && far_(out[O_NP + (size_t)bh * DK + dk], n, 0.03f, 0.03f)) CHK_CODE(31);
        if (sel == 0 && far_(((const float*)(ws + WS_NC))[(size_t)(bh * NCH + 63) * DK + dk], n63, 0.03f, 0.03f)) CHK_CODE(31);
        if (far_(bf1(((const bf16_t*)(ws + WS_CT))[((size_t)(bh * NCH + 63) * DV + dv) * DK + dk]), C63, 0.03f, 0.03f)) CHK_CODE(30);
        if (tid == 0 && far_(out[O_MP + bh], m, 0.01f, 0.01f)) CHK_CODE(32);
        if (bad8) CHK_CODE(29);
        __syncthreads(); }
    for (unsigned s = gt; s < 4096u; s += ngt) { const unsigned a = hsh(s), b2 = hsh(s + 31337u); const int row = (s < 128u) ? MP + (int)(s & 31u) : (int)(a % MP), h = b2 % NH, dv = (b2 >> 8) % DV;
        const float* hr = HRAW + (size_t)row * 3072 + h * DV; float ss = 0.f; for (int j = 0; j < DV; ++j) ss += hr[j] * hr[j];
        const float om = bf1(Z[(size_t)row * NZ + ZOM + h * DV + dv]); const float ref = hr[dv] * rsqrtf(ss * (1.0f / DV) + EPS) * mh_g[h * DV + dv] / (1.0f + expf(-om));
        if (far_(bf1(MIX[(size_t)row * DM + 1024 + h * DV + dv]), ref, 0.02f, 0.005f)) CHK_CODE(28); }
    for (unsigned s = gt; s < 2048u; s += ngt) { const unsigned a = hsh(s); const int b = a & 31, h = (a >> 5) & 7, d = (a >> 8) & 127;
        const bf16_t* qr = Z + (size_t)(MP + b) * NZ + ZQA + h * 128; float m = -INFINITY, l = 0.f, o = 0.f;
        for (int cfg = 0; cfg < 3; ++cfg) { const int r = cfg == 0 ? 1 : cfg == 1 ? 4 : 16;
            for (int j = 0; j <= 128; ++j) { const int dist = j * r; const float* kp = dist == 0 ? out + O_KS + (size_t)b * 1024 + h * 128 : cache_k + ((size_t)b * 2048 + 2048 - dist) * 1024 + h * 128;
                const float* vp = dist == 0 ? out + O_VS + (size_t)b * 1024 + h * 128 : cache_v + ((size_t)b * 2048 + 2048 - dist) * 1024 + h * 128;
                float sc = 0.f; for (int e = 0; e < 128; ++e) sc += bf1(qr[e]) * kp[e];
                const float mn = fmaxf(m, sc), al = expf(m - mn), p = expf(sc - mn); l = l * al + p; o = o * al + p * vp[d]; m = mn; } }
        if (far_(bf1(MIX[(size_t)(MP + b) * DM + h * 128 + d]), o / l, 0.02f, 0.004f)) CHK_CODE(27); }
    for (unsigned s = gt; s < 2048u; s += ngt) { const unsigned a = hsh(s), b2 = hsh(s + 99u); const int b = a & 31, h = (a >> 5) % NH, dv = (a >> 9) % DV, dkx = b2 % DK; const int row = MP + b; const bf16_t* zr = Z + (size_t)row * NZ;
        const float liv = GT[(size_t)h * MT + row], lf = GT[(size_t)(6 + h) * MT + row], m0 = state_m[b * NH + h]; const float mt = fmaxf(lf + m0, liv), aa = expf(lf + m0 - mt), wsv = expf(liv - mt);
        const float* c0 = state_C + (size_t)(b * NH + h) * DK * DV; const float* n0 = state_n + (size_t)(b * NH + h) * DK; float qk = 0.f, qn = 0.f, qc = 0.f;
        for (int k = 0; k < DK; ++k) { const float q = bf1(zr[ZQM + h * DK + k]); qk += q * bf1(zr[ZKM + h * DK + k]); qn += q * n0[k]; qc += q * c0[(size_t)k * DV + dv]; }
        const float v = bf1(zr[ZVM + h * DV + dv]), sw = qk * wsv, num = sw * v + aa * qc, den = sw + aa * qn, hv = num / fmaxf(fabsf(den), expf(-mt));
        if (far_(HRAW[(size_t)row * 3072 + h * DV + dv], hv, 0.02f, 0.005f)) CHK_CODE(26);
        const float kx = bf1(zr[ZKM + h * DK + dkx]);
        if (far_(out[O_CS + ((size_t)(b * NH + h) * DK + dkx) * DV + dv], aa * c0[(size_t)dkx * DV + dv] + wsv * kx * v, 1e-3f, 1e-5f)) CHK_CODE(26);
        if (far_(out[O_NS + (size_t)(b * NH + h) * DK + dkx], aa * n0[dkx] + wsv * kx, 1e-3f, 1e-5f)) CHK_CODE(26);
        if (far_(out[O_MS + b * NH + h], mt, 1e-4f, 1e-5f)) CHK_CODE(26); }
    for (unsigned s = gt; s < 4096u; s += ngt) { const int row = (s < 256u) ? MP + (int)(s & 31u) : (int)(hsh(s) % MP), col = (int)(hsh(s + 777u) % DM);
        const float xv = row < MP ? x_prompt[(size_t)row * DM + col] : x_sample[(size_t)(row - MP) * DM + col]; const float ref = xv + dot_bf(MIX + (size_t)row * DM, WoutT + (size_t)col * DM, DM);
        if (far_(H[(size_t)row * DM + col], ref, 0.01f, 0.01f)) CHK_CODE(25); if (far_(bf1(HB[(size_t)row * DM + col]), ref, 0.01f, 0.01f)) CHK_CODE(25);
        if (s < 512u) { float ss = 0.f; for (int j = 0; j < DM; ++j) { const float hv = H[(size_t)row * DM + j]; ss += hv * hv; } if (far_(RSS2[row], ss, 2e-3f, 1e-2f)) CHK_CODE(25); } }
    for (unsigned s = gt; s < 4096u; s += ngt) { const int row = (s < 256u) ? MP + (int)(s & 31u) : (int)(hsh(s) % MP), f = (int)(hsh(s + 4242u) % DFF);
        const float r = rsqrtf(RSS2[row] * (1.0f / DM) + EPS); float v = fmaxf(r * dot_bf(HB + (size_t)row * DM, WupT + (size_t)f * DM, DM), 0.f); v = v * v;
        if (far_(bf1(U[(size_t)row * DFF + f]), v, 0.03f, 0.01f)) CHK_CODE(24); }
    for (unsigned s = gt; s < 2048u; s += ngt) { const int row = (s < 128u) ? MP + (int)(s & 31u) : (int)(hsh(s) % MP), col = (int)(hsh(s + 9u) % DM);
        const float pre = H[(size_t)row * DM + col] + dot_bf(U + (size_t)row * DFF, WdnT + (size_t)col * DFF, DFF);
        if (row < MP) { const float ref = pre * rsqrtf(RSS3[row] * (1.0f / DM) + EPS) * final_g[col]; if (!(row == 0 && col == 0) && far_(out[O_Y + (size_t)row * DM + col], ref, 0.02f, 0.01f)) CHK_CODE(23); }
        else { const int col2 = (col + 1234) % DM; const float pre2 = H[(size_t)row * DM + col2] + dot_bf(U + (size_t)row * DFF, WdnT + (size_t)col2 * DFF, DFF);
            const float y1 = out[O_Y + (size_t)row * DM + col] / final_g[col], y2 = out[O_Y + (size_t)row * DM + col2] / final_g[col2];
            if (far_(y1 * pre2, y2 * pre, 0.04f, 0.03f)) CHK_CODE(23); } }
}
#endif

__global__ void __launch_bounds__(512, 2) hymba_fwd(Args args) {
    extern __shared__ __attribute__((aligned(16))) unsigned char lds_raw[];
    LAS unsigned char* lds = (LAS unsigned char*)lds_raw;
    const int tid = threadIdx.x, lane = tid & 63, wid = __builtin_amdgcn_readfirstlane(tid >> 6);
    const int G = gridDim.x, bx = blockIdx.x, vcu = (G % 8 == 0) ? (bx % 8) * (G / 8) + bx / 8 : bx;
    unsigned char* ws = args.ws;
    unsigned* ctl = (unsigned*)(ws + WS_CTL);
    volatile LAS unsigned* MISC = (volatile LAS unsigned*)(lds + MISC_OFF);
    if (tid < 64) MISC[tid] = 0u;
    __syncthreads();
    XcdBarrier bar = xcd_barrier_post(ctl + CW_BAR, MISC + 8);
#if PROF
#define STAMP(k) do { if (bx == 0 && tid == 0) { const unsigned long long t_ = __builtin_amdgcn_s_memrealtime(); MISC[32] = (unsigned)t_; MISC[33] = (unsigned)(t_ >> 32); } } while (0)
#define PRE(k) do { if ((k) == PROF && bx == 0 && tid == 0) { const unsigned long long t_ = __builtin_amdgcn_s_memrealtime(); const unsigned long long p_ = ((unsigned long long)MISC[33] << 32) | MISC[32]; const unsigned long long w_ = 3ull * (t_ - p_); \
        while (__builtin_amdgcn_s_memrealtime() - t_ < w_) __builtin_amdgcn_s_sleep(8); } } while (0)
#else
#define STAMP(k) do { } while (0)
#define PRE(k) do { } while (0)
#endif
    STAMP(0);

    const float* x_prompt = args.in[0]; const float* x_sample = args.in[1];
    const float* norm1_g = args.in[7]; const float* w_in = args.in[8]; const float* b_if = args.in[9];
    const float* w_out = args.in[11]; const float* norm2_g = args.in[12]; const float* w_up = args.in[13]; const float* w_down = args.in[14]; const float* final_g = args.in[15];
    float* out = args.out;
    bf16_t* WinT = (bf16_t*)(ws + WS_WIN); bf16_t* WoutT = (bf16_t*)(ws + WS_WOUT); bf16_t* WupT = (bf16_t*)(ws + WS_WUP); bf16_t* WdnT = (bf16_t*)(ws + WS_WDN);
    bf16_t* XN = (bf16_t*)(ws + WS_XN); bf16_t* Z = (bf16_t*)(ws + WS_Z); bf16_t* MIX = (bf16_t*)(ws + WS_MIX); float* H = (float*)(ws + WS_H); bf16_t* HB = (bf16_t*)(ws + WS_HB);
    bf16_t* U = (bf16_t*)(ws + WS_U); bf16_t* WG = (bf16_t*)(ws + WS_WG); float* ROPE = (float*)(ws + WS_ROPE); float* GT = (float*)(ws + WS_G);
    float* RSS2 = (float*)(ws + WS_CTL + CTL_RSS2); float* RSS3 = (float*)(ws + WS_CTL + CTL_RSS3); float* ACCB = (float*)(ws + WS_CTL + CTL_ACC);

    { P0Args a{x_prompt, x_sample, norm1_g, w_in, w_out, norm2_g, w_up, w_down, WinT, WoutT, WupT, WdnT, XN, WG, ROPE};
      p0_prologue(a, vcu, G, wid, lane);
      trw_run(lds, w_in, NINF, DM, NZ, WinT, nullptr, bx, ((DM / 128) * (NZ / 256) - bx + G - 1) / G, G); }
    PRE(1);
    xcd_barrier(bar);
    STAMP(1);

    { pg8::Gemm g{XN, WinT, MP, NZ, DM}; pg8::StaticOrder S; S.init(MP, NZ, G, bx);
      EpiInProj E{Z, ROPE, out + O_KP, out + O_VP};
      pg8::InterleavedOrder SI{S};
      pg8::gemm_phase<EpiInProj, pg8::InterleavedOrder>(lds, g, SI, E);
      SkInProj Es{Z, ROPE, out + O_KS, out + O_VS};
      SkGates Eg{b_if, GT};
      for (int u2 = bx; u2 < 48 * 8 + 33 * 8; u2 += G) { if (u2 < 384) skinny_unit<2>(lds, XN + (size_t)MP * DM, WinT, DM, 0, DM, Es, u2 >> 3, u2 & 7); else skinny_unit<1>(lds, WG, XN, DM, 0, DM, Eg, (u2 - 384) >> 3, (u2 - 384) & 7); }
    }
    PRE(2);
    xcd_barrier(bar);
    STAMP(2);

    bf16_t* CT = (bf16_t*)(ws + WS_CT); float* NC = (float*)(ws + WS_NC); float* TB = (float*)(ws + WS_TB); float* TWV = (float*)(ws + WS_TWV); float* TMT = (float*)(ws + WS_TMT); float* CMb = (float*)(ws + WS_CM);
    float* HRAW = CHECKS ? (float*)(ws + WS_HRAW) : nullptr;
    const float* cache_k = args.in[2]; const float* cache_v = args.in[3]; const float* state_C = args.in[4]; const float* state_n = args.in[5]; const float* state_m = args.in[6]; const float* mh_g = args.in[10];

    { if (bx < 96) mlstm_scan(lds, Z, GT, CT, NC, TB, TWV, TMT, CMb, out, bx);
      for (;;) {
          if (tid == 0) MISC[16] = atomicAdd(&ctl[CW_Q2], 1u);
          __syncthreads();
          const unsigned item = (unsigned)__builtin_amdgcn_readfirstlane((int)MISC[16]);
          __syncthreads();
          if (item >= 704u + (unsigned)((CV_OUT + CV_UP) / 4)) break;
          if (item < 192u) smlstm_unit(lds, Z, GT, state_C, state_n, state_m, mh_g, out, MIX, HRAW, (int)item);
          else if (item < 448u) attn_unit(lds, Z, MIX, (int)item - 192);
          else if (item < 704u) sattn_unit(lds, Z, cache_k, cache_v, out, MIX, (int)item - 448);
          else conv_unit(lds, w_out, w_up, w_down, norm2_g, WoutT, WupT, WdnT, (int)item - 704);
      } }
    PRE(3);
    xcd_barrier(bar);
    STAMP(3);

    for (;;) {
        if (tid == 0) MISC[16] = atomicAdd(&ctl[CW_Q2 + 64], 1u);
        __syncthreads();
        const unsigned item = (unsigned)__builtin_amdgcn_readfirstlane((int)MISC[16]);
        __syncthreads();
        if (item >= 1280u) break;
        const unsigned grp = item / 5u, r = item % 5u;
        if (r < 3u) mlstm_out(lds, Z, CT, NC, TB, TWV, TMT, CMb, mh_g, MIX, HRAW, (int)(3u * grp + r));
        else conv_unit(lds, w_out, w_up, w_down, norm2_g, WoutT, WupT, WdnT, (int)((CV_OUT + CV_UP) / 4 + 2u * grp + (r - 3u)));
    }
    PRE(4);
    xcd_barrier(bar);
    STAMP(4);

    { pg8::Gemm g{MIX, WoutT, MP, DM, DM}; pg8::StaticOrder S; S.init(MP, DM, G, bx);
      EpiOutProj E{x_prompt, H, HB, RSS2};
      pg8::gemm_phase<EpiOutProj>(lds, g, S, E);
      SkOutProj Es{x_sample, H, HB, RSS2};
      for (int u2 = bx; u2 < 16 * 8; u2 += G) skinny_unit<2>(lds, MIX + (size_t)MP * DM, WoutT, DM, 0, DM, Es, u2 >> 3, u2 & 7); }
    PRE(5);
    xcd_barrier(bar);
    STAMP(5);

    constexpr int MH = MP / 2;
    { pg8::Gemm g{HB, WupT, MH, DFF, DM}; pg8::StaticOrder S; S.init(MH, DFF, G, bx);
      EpiUp E{U, RSS2, 0};
      pg8::gemm_phase<EpiUp>(lds, g, S, E);
      SkUp Es{U, RSS2};
      for (int u2 = bx; u2 < 64 * 8; u2 += G) skinny_unit<2>(lds, HB + (size_t)MP * DM, WupT, DM, 0, DM, Es, u2 >> 3, u2 & 7); }
    PRE(6);
    xcd_barrier(bar);
    STAMP(6);
    { pg8::Gemm g{U, WdnT, MH, DM, DFF}; pg8::StaticOrder S; S.init(MH, DM, G, bx);
      EpiDownNorm E{HB, out + O_Y, RSS3, ctl + CW_Q2 + 768, final_g, 0};
      pg8::gemm_phase<EpiDownNorm>(lds, g, S, E);
      SkDown Es{ACCB};
      for (int u2 = bx; u2 < 512; u2 += G) { const int kc = u2 >> 7, j32 = u2 & 127; skinny_unit<2>(lds, U + (size_t)MP * DFF, WdnT, DFF, 4096 * kc, 4096, Es, j32 >> 3, j32 & 7); } }
    { pg8::Gemm g{HB + (size_t)MH * DM, WupT, MH, DFF, DM}; pg8::StaticOrder S; S.init(MH, DFF, G, bx);
      EpiUp E{U, RSS2, MH / 256};
      pg8::gemm_phase<EpiUp>(lds, g, S, E); }
    xcd_barrier(bar);
    { const int gw = vcu * 8 + wid, ngw = G * 8; const bf16_t* YB = MIX;
      for (int m = MP + gw; m < MT; m += ngw) {
          float* yr = out + O_Y + (size_t)m * DM; f32x4 v[8][2]; float r;
          if (m < MP) { const bf16_t* yb = YB + (size_t)m * DM;
#pragma unroll
              for (int c = 0; c < 8; ++c) { const u32x4 w = *(const u32x4*)(yb + 512 * c + 8 * lane); v[c][0] = (f32x4){bf_lo(w.x), bf_hi(w.x), bf_lo(w.y), bf_hi(w.y)}; v[c][1] = (f32x4){bf_lo(w.z), bf_hi(w.z), bf_lo(w.w), bf_hi(w.w)}; }
              r = rsqrtf(RSS3[m] * (1.0f / DM) + EPS);
          } else { const bf16_t* hr = HB + (size_t)m * DM; const float* ar = ACCB + (size_t)(m - MP) * DM; float ss = 0.f;
#pragma unroll
              for (int c = 0; c < 8; ++c) { const u32x4 w = *(const u32x4*)(hr + 512 * c + 8 * lane);
                  v[c][0] = (f32x4){bf_lo(w.x), bf_hi(w.x), bf_lo(w.y), bf_hi(w.y)} + *(const f32x4*)(ar + 512 * c + 8 * lane); v[c][1] = (f32x4){bf_lo(w.z), bf_hi(w.z), bf_lo(w.w), bf_hi(w.w)} + *(const f32x4*)(ar + 512 * c + 8 * lane + 4);
                  ss += (v[c][0][0] * v[c][0][0] + v[c][0][1] * v[c][0][1]) + (v[c][0][2] * v[c][0][2] + v[c][0][3] * v[c][0][3]) + (v[c][1][0] * v[c][1][0] + v[c][1][1] * v[c][1][1]) + (v[c][1][2] * v[c][1][2] + v[c][1][3] * v[c][1][3]); }
              r = rsqrtf(wave_sum(ss) * (1.0f / DM) + EPS); }
#pragma unroll
          for (int c = 0; c < 8; ++c) { const f32x4 g0 = *(const f32x4*)(final_g + 512 * c + 8 * lane), g1v = *(const f32x4*)(final_g + 512 * c + 8 * lane + 4);
              *(f32x4*)(yr + 512 * c + 8 * lane) = v[c][0] * r * g0; *(f32x4*)(yr + 512 * c + 8 * lane + 4) = v[c][1] * r * g1v; }
      } }
    { pg8::Gemm g{U + (size_t)MH * DFF, WdnT, MH, DM, DFF}; pg8::StaticOrder S; S.init(MH, DM, G, bx);
      EpiDownNorm E{HB, out + O_Y, RSS3, ctl + CW_Q2 + 768, final_g, MH / 256};
      pg8::gemm_phase<EpiDownNorm>(lds, g, S, E); }

#if PROF
    PRE(8);
    xcd_barrier(bar);
#endif
#if CHECKS
    PRE(8);
    xcd_barrier(bar);
    STAMP(8);
    run_checks(args, lds);
    PRE(9);
    xcd_barrier(bar);
    STAMP(9);
    if (bx == 0 && tid == 0) { const unsigned code = __hip_atomic_load(ctl + CW_ERR, __ATOMIC_RELAXED, __HIP_MEMORY_SCOPE_AGENT); const unsigned msk = __hip_atomic_load(ctl + CW_ERR + 2, __ATOMIC_RELAXED, __HIP_MEMORY_SCOPE_AGENT);
        if (msk) out[0] = (float)(60u + msk) * 10000.0f; else if (code) out[0] = (float)code * 10000.0f; }
#endif
}

extern "C" void kernel_launch(void* const* d_in, const int* in_sizes, int n_in, void* d_out, int out_size, void* d_ws, size_t ws_size, hipStream_t stream) {
    static int grid = 0;
    if (grid == 0) {
        if (n_in != 16 || out_size != (int)O_END || ws_size < WS_NEED) { fprintf(stderr, "kernel_launch: unexpected shapes (n_in %d, out %d, ws %zu)\n", n_in, out_size, ws_size); grid = -1; return; }
        int dev = 0, cus = 0, per_cu = 0;
        if (hipGetDevice(&dev) != hipSuccess || hipDeviceGetAttribute(&cus, hipDeviceAttributeMultiprocessorCount, dev) != hipSuccess) { grid = -1; return; }
        if (hipFuncSetAttribute((const void*)hymba_fwd, hipFuncAttributeMaxDynamicSharedMemorySize, LDS_BYTES) != hipSuccess) { fprintf(stderr, "kernel_launch: hipFuncSetAttribute failed\n"); grid = -1; return; }
        if (hipOccupancyMaxActiveBlocksPerMultiprocessor(&per_cu, (const void*)hymba_fwd, 512, LDS_BYTES) != hipSuccess || per_cu < 1) { fprintf(stderr, "kernel_launch: occupancy query says %d\n", per_cu); }
        (void)hipGetLastError();
        grid = cus;
    }
    if (grid < 0) return;
    (void)in_sizes;
    hipMemsetAsync((char*)d_ws + WS_CTL, 0, CTL_ZERO_BYTES, stream);
    Args a{};
    for (int i = 0; i < 16; ++i) a.in[i] = (const float*)d_in[i];
    a.out = (float*)d_out; a.ws = (unsigned char*)d_ws;
    hipLaunchKernelGGL(hymba_fwd, dim3(grid), dim3(512), LDS_BYTES, stream, a);
}
```

```cpp
#include <hip/hip_runtime.h>
#include <cstdio>
#include <cstdint>

#define LAS __attribute__((address_space(3)))
typedef unsigned short bf16_t;
typedef short bf16x8 __attribute__((ext_vector_type(8)));
typedef short s16x4 __attribute__((ext_vector_type(4)));
typedef float f32x4 __attribute__((ext_vector_type(4)));
typedef float f32x2 __attribute__((ext_vector_type(2)));
typedef unsigned u32x4 __attribute__((ext_vector_type(4)));
typedef unsigned u32x2 __attribute__((ext_vector_type(2)));

constexpr int DM = 4096, SEQ = 4096, NB = 2, MP = NB * SEQ  , MS = 32, MT = MP + MS  , MPAD = 8448;
constexpr int NZ = 12288, NINF = 12300, DFF = 16384;
constexpr int ZQA = 0, ZKA = 1024, ZVA = 2048, ZQM = 3072, ZKM = 4608, ZVM = 6144, ZOM = 9216;
constexpr int NH = 6, DK = 256, DV = 512, LCH = 64, NCH = 64;
constexpr float EPS = 1e-6f;
constexpr size_t O_Y = 0, O_KP = 33685504, O_VP = 37879808, O_CP = 42074112, O_NP = 43646976, O_MP = 43650048, O_KS = 43650060, O_VS = 43682828,
                 O_CS = 43715596, O_NS = 68881420, O_MS = 68930572, O_END = 68930764;

constexpr size_t MiB = 1u << 20;
constexpr size_t WS_CTL = 0, CTL_ZERO_BYTES = 1 * MiB;
constexpr int CW_BAR = 0;
constexpr int CW_Q2 = 4096;
constexpr size_t CTL_RSS2 = 64 * 1024, CTL_RSS3 = 128 * 1024, CTL_ACC = 512 * 1024;
constexpr size_t WS_ROPE = 2 * MiB;
constexpr size_t WS_WG = 5 * MiB;
constexpr size_t WS_G = 6 * MiB;
constexpr size_t WS_TB = 7 * MiB, WS_TWV = 7 * MiB + 256 * 1024, WS_TMT = 7 * MiB + 512 * 1024, WS_CM = 7 * MiB + 768 * 1024;
constexpr size_t WS_NC = 8 * MiB;
constexpr size_t WS_WIN = 16 * MiB, WS_WOUT = 112 * MiB, WS_WUP = 144 * MiB, WS_WDN = 272 * MiB;
constexpr size_t WS_XN = 400 * MiB, WS_Z = 466 * MiB, WS_MIX = 660 * MiB, WS_H = 726 * MiB, WS_HB = 855 * MiB, WS_CT = 921 * MiB, WS_END = 1114 * MiB;
#ifndef CHECKS
#define CHECKS 0
#endif
#ifndef PROF
#define PROF 0
#endif
constexpr size_t WS_U = CHECKS ? 1114 * MiB : 400 * MiB;
constexpr size_t WS_HRAW = 1380 * MiB;
constexpr size_t WS_NEED = CHECKS ? 1480 * MiB : WS_END;
constexpr int CW_ERR = 8192;
constexpr size_t WS_DBG = 1477 * MiB;

constexpr int LDS_BYTES = 153600, MISC_OFF = 153088;

__device__ __forceinline__ unsigned cvt_pk_bf16(float lo, float hi) { unsigned r; asm volatile("v_cvt_pk_bf16_f32 %0, %1, %2" : "=v"(r) : "v"(lo), "v"(hi)); return r; }
__device__ __forceinline__ float bf_lo(unsigned w) { return __uint_as_float(w << 16); }
__device__ __forceinline__ float bf_hi(unsigned w) { return __uint_as_float(w & 0xffff0000u); }
__device__ __forceinline__ float bf1(bf16_t b) { return __uint_as_float(((unsigned)b) << 16); }
__device__ __forceinline__ float wave_sum(float v) {
#pragma unroll
    for (int o = 1; o < 64; o <<= 1) v += __shfl_xor(v, o);
    return v;
}
__device__ __forceinline__ float wave_max(float v) {
#pragma unroll
    for (int o = 1; o < 64; o <<= 1) v = fmaxf(v, __shfl_xor(v, o));
    return v;
}
__device__ __forceinline__ void lds_addf(LAS float* p, float v) { (void)__hip_atomic_fetch_add(p, v, __ATOMIC_RELAXED, __HIP_MEMORY_SCOPE_WORKGROUP); }
typedef short v4i16_t __attribute__((ext_vector_type(4)));
__device__ __forceinline__ s16x4 vtr(const LAS unsigned char* p) { return __builtin_bit_cast(s16x4, __builtin_amdgcn_ds_read_tr16_b64_v4i16((LAS v4i16_t*)p)); }
__device__ __forceinline__ bf16x8 cat8(s16x4 a, s16x4 b) { bf16x8 r; r[0] = a[0]; r[1] = a[1]; r[2] = a[2]; r[3] = a[3]; r[4] = b[0]; r[5] = b[1]; r[6] = b[2]; r[7] = b[3]; return r; }

#define XB_TMO      128
#define XB_XCNT(j)  (256  + 64 * (j))
#define XB_XSUB(j)  (1280 + 64 * (j))
#define XB_XGEN(j)  (2304 + 64 * (j))
#define XB_TOP      3328
#define XB_TOPGEN   3392
#define XCD_BAR_WORDS 3456
#define XB_SPIN_CAP (1u << 18)
__device__ __forceinline__ unsigned xb_ld(unsigned* p)              { return __hip_atomic_load(p, __ATOMIC_RELAXED, __HIP_MEMORY_SCOPE_AGENT); }
__device__ __forceinline__ unsigned xb_add(unsigned* p, unsigned v) { return __hip_atomic_fetch_add(p, v, __ATOMIC_RELAXED, __HIP_MEMORY_SCOPE_AGENT); }
__device__ __forceinline__ unsigned xb_xcc_id() { return (unsigned)__builtin_amdgcn_s_getreg((3 << 11) | 20) & 0xFu; }
#define XB_SPIN(cond, bar) do { unsigned _sp = 0; while (cond) { __builtin_amdgcn_s_sleep(1); \
    if ((++_sp & 255u) == 0u) { if (xb_ld(&(bar)[XB_TMO])) break; if (_sp > XB_SPIN_CAP) { atomicAdd(&(bar)[XB_TMO], 1u); break; } } } } while (0)
struct XcdBarrier { unsigned* bar; unsigned x; volatile LAS unsigned* st; };
__device__ __forceinline__ XcdBarrier xcd_barrier_post(unsigned* bar, volatile LAS unsigned* st) {
    XcdBarrier b; b.bar = bar; b.x = xb_xcc_id(); b.st = st;
    if (threadIdx.x == 0) (void)xb_add(&bar[XB_XCNT(b.x)], 1u);
    return b;
}
__device__ __forceinline__ void xcd_barrier_complete(unsigned* bar, unsigned x, unsigned& nloc, unsigned& nx) {
    const unsigned G = gridDim.x * gridDim.y * gridDim.z;
    unsigned sum, cnt, mine, sp = 0u;
    for (;;) {
        sum = 0u; cnt = 0u; mine = 0u;
#pragma unroll
        for (unsigned j = 0; j < 16; ++j) { const unsigned c = xb_ld(&bar[XB_XCNT(j)]); sum += c; cnt += (c > 0u) ? 1u : 0u; mine = (j == x) ? c : mine; }
        if (sum == G) break;
        __builtin_amdgcn_s_sleep(1);
        if ((++sp & 255u) == 0u) { if (xb_ld(&bar[XB_TMO])) break; if (sp > XB_SPIN_CAP) { atomicAdd(&bar[XB_TMO], 1u); break; } }
    }
    nloc = mine > 0u ? mine : 1u; nx = cnt > 0u ? cnt : 1u;
}
__device__ __forceinline__ void xcd_barrier(const XcdBarrier& b) {
    asm volatile("s_waitcnt vmcnt(0)" ::: "memory");
    __syncthreads();
    if (threadIdx.x == 0) {
        unsigned* bar = b.bar;
        __builtin_amdgcn_s_waitcnt(0);
        unsigned nloc = b.st[0], nx = b.st[1];
        if (nloc == 0u) { xcd_barrier_complete(bar, b.x, nloc, nx); b.st[0] = nloc; b.st[1] = nx; }
        const unsigned old = xb_add(&bar[XB_XSUB(b.x)], 1u);
        const unsigned gen = old / nloc;
        if (old + 1u == (gen + 1u) * nloc) {
            __builtin_amdgcn_fence(__ATOMIC_RELEASE, "agent");
            asm volatile("s_waitcnt vmcnt(0)" ::: "memory");
            const unsigned og = xb_add(&bar[XB_TOP], 1u);
            const unsigned tg = og / nx;
            if (og + 1u == (tg + 1u) * nx) xb_add(&bar[XB_TOPGEN], 1u);
            else XB_SPIN(xb_ld(&bar[XB_TOPGEN]) == tg, bar);
            __builtin_amdgcn_fence(__ATOMIC_ACQUIRE, "agent");
            xb_add(&bar[XB_XGEN(b.x)], 1u);
            asm volatile("s_waitcnt vmcnt(0)" ::: "memory");
        } else {
            XB_SPIN(xb_ld(&bar[XB_XGEN(b.x)]) == gen, bar);
            __builtin_amdgcn_fence(__ATOMIC_ACQUIRE, "agent");
            asm volatile("s_waitcnt vmcnt(0)" ::: "memory");
        }
    }
    __syncthreads();
}

namespace pg8 {
constexpr int BM = 256, BK = 64, HALF = 128, HTB = HALF * BK * 2, STAGE_BYTES = 8 * HTB, NXCD = 8, WGM = 8;
__host__ __device__ __forceinline__ int lds_byte(int r, int c) { const int st = (r >> 4) * 2 + (c >> 5), rr = r & 15, cc = c & 31, ob = rr * 64 + cc * 2; return st * 1024 + (ob ^ (((ob >> 9) & 1) << 5)); }
__host__ __device__ __forceinline__ void stage_rc(int b, int& R, int& C) { const int st = b / 1024, sb = b % 1024, swz = sb ^ (((sb >> 9) & 1) << 5); R = (st >> 1) * 16 + swz / 64; C = (st & 1) * 32 + (swz % 64) / 2; }
__host__ __device__ __forceinline__ int perm32(int rho) { const int n = rho >> 4, i = rho & 15; return 8 * (i >> 2) + 4 * n + (i & 3); }
struct Unit { int pm, pn; };
struct Gemm { const bf16_t* A; const bf16_t* Bt; int M, N, K; };
struct StaticOrder {
    int nM, nN, nwg, G, c;
    __host__ __device__ void init(int M, int N, int G_, int c_) { nM = M / BM; nN = N / BM; nwg = nM * nN; G = G_; c = c_; }
    __host__ __device__ bool next(int i, Unit& u) const {
        const long L = (long)i * G + c; if (L >= nwg) return false;
        int wgid = (int)L; { const int q = nwg / NXCD, r = nwg % NXCD, xcd = wgid % NXCD, off = wgid / NXCD; wgid = (xcd < r ? xcd * (q + 1) : r * (q + 1) + (xcd - r) * q) + off; }
        const int nig = WGM * nN, gid = wgid / nig, fm = gid * WGM, gsz = (nM - fm) < WGM ? (nM - fm) : WGM;
        u.pm = fm + ((wgid % nig) % gsz); u.pn = (wgid % nig) / gsz; return true;
    }
};
struct InterleavedOrder { StaticOrder S;
    __host__ __device__ bool next(int i, Unit& u) const { if (!S.next(i, u)) return false; u.pn = 2 * (u.pn % 24) + u.pn / 24; return true; } };
template <int BMODE> __host__ __device__ __forceinline__ int bmap_row(int R) {
    if (BMODE == 0) return R;
    const int p = (R & ~31) + perm32(R & 31);
    if (BMODE == 1) return p;
    return (p >> 6) * 128 + (p & 63);
}
template <class Epi, class Sched = StaticOrder, bool ALIGN_EPI = true, bool SP2 = true>
__device__ __forceinline__ void gemm_phase(LAS unsigned char* lds, const Gemm g, const Sched& S, const Epi& E) {
    int tid = threadIdx.x; asm volatile("" : "+v"(tid)); const int wid = __builtin_amdgcn_readfirstlane(tid >> 6), lane = tid & 63, wr = wid >> 2, wc = wid & 3, fr = lane & 15, fq = lane >> 4;
    const int K = g.K, nt = K / BK;
    unsigned voffA[2], voffB[2];
#pragma unroll
    for (int i = 0; i < 2; ++i) { int R, C; stage_rc(tid * 16 + i * 8192, R, C); const int Rb = bmap_row<Epi::BMODE>(R);
        voffA[i] = (unsigned)(R * K + C) * 2u; voffB[i] = (unsigned)(Rb * K + C) * 2u; }
    const size_t kstep = (size_t)(BK * 2);
    const size_t hstep = (size_t)HALF * K * 2;
    const size_t hstepB = (size_t)(Epi::BMODE == 2 ? 64 : 128) * K * 2;
    const size_t tstep = 2 * hstep;
    const unsigned ldsw = (unsigned)wid * 1024u;
    const int aoff = lds_byte(wr * 64 + fr, fq * 8), boff = lds_byte(wc * 32 + fr, fq * 8);
#define PG8_SA(b, h) (((b) * 2 + (h)) * HTB)
#define PG8_SB(b, h) ((4 + (b) * 2 + (h)) * HTB)
#define PG8_STAGE(bufoff, gbase, voff) do { _Pragma("unroll") for (int _i = 0; _i < 2; ++_i) \
        __builtin_amdgcn_global_load_lds((const unsigned*)((const char*)(gbase) + (voff)[_i]), (LAS unsigned*)(lds + (bufoff) + ldsw + _i * 8192), 16, 0, 0); } while (0)
#define PG8_LDA(dst, b, h) do { _Pragma("unroll") for (int m = 0; m < 4; ++m) _Pragma("unroll") for (int k = 0; k < 2; ++k) dst[m][k] = *(const LAS bf16x8*)(lds + PG8_SA(b, h) + aoff + m * 2048 + k * 1024); } while (0)
#define PG8_LDB(dst, b, h) do { _Pragma("unroll") for (int n = 0; n < 2; ++n) _Pragma("unroll") for (int k = 0; k < 2; ++k) dst[n][k] = *(const LAS bf16x8*)(lds + PG8_SB(b, h) + boff + n * 2048 + k * 1024); } while (0)
#define PG8_MMA(ai, bj, At, Bt) do { __builtin_amdgcn_s_setprio(1); _Pragma("unroll") for (int m = 0; m < 4; ++m) _Pragma("unroll") for (int n = 0; n < 2; ++n) _Pragma("unroll") for (int k = 0; k < 2; ++k) \
        acc[ai][bj][m][n] = __builtin_amdgcn_mfma_f32_16x16x32_bf16(Bt[n][k], At[m][k], acc[ai][bj][m][n], 0, 0, 0); __builtin_amdgcn_s_setprio(0); } while (0)
#define PG8_WAIT_V(n) asm volatile("s_waitcnt vmcnt(" #n ")" ::: "memory")
#define PG8_WAIT_L(n) asm volatile("s_waitcnt lgkmcnt(" #n ")" ::: "memory")
#define PG8_BAR __builtin_amdgcn_s_barrier()
#define PG8_SCHED __builtin_amdgcn_sched_barrier(0)
    Unit cur, nxt; int ui = 0;
    if (!S.next(0, cur)) return;
    f32x4 acc[2][2][4][2];
#pragma unroll
    for (int a = 0; a < 2; ++a)
#pragma unroll
        for (int b = 0; b < 2; ++b)
#pragma unroll
            for (int m = 0; m < 4; ++m)
#pragma unroll
                for (int n = 0; n < 2; ++n) acc[a][b][m][n] = (f32x4){0.f, 0.f, 0.f, 0.f};
    bf16x8 At[4][2], B0[2][2], B1[2][2];
    const char* cA = (const char*)g.A + (size_t)cur.pm * tstep; const char* cB = (const char*)g.Bt + (size_t)cur.pn * tstep;
    if constexpr (SP2) {
        PG8_STAGE(PG8_SB(0, 0), cB, voffB); PG8_STAGE(PG8_SB(0, 1), cB + hstepB, voffB); PG8_STAGE(PG8_SA(0, 0), cA, voffA); PG8_STAGE(PG8_SA(0, 1), cA + hstep, voffA);
        if (wr == 1) PG8_BAR;
        PG8_WAIT_V(2); PG8_BAR;
        PG8_STAGE(PG8_SB(1, 0), cB + kstep, voffB); PG8_STAGE(PG8_SA(1, 0), cA + kstep, voffA); PG8_STAGE(PG8_SB(1, 1), cB + hstepB + kstep, voffB);
        PG8_WAIT_V(6); PG8_BAR;
    } else {
        PG8_STAGE(PG8_SB(0, 0), cB, voffB); PG8_STAGE(PG8_SA(0, 0), cA, voffA); PG8_STAGE(PG8_SB(0, 1), cB + hstepB, voffB); PG8_STAGE(PG8_SA(0, 1), cA + hstep, voffA);
        if (wr == 1) PG8_BAR;
        PG8_WAIT_V(4); PG8_BAR;
        PG8_STAGE(PG8_SB(1, 0), cB + kstep, voffB); PG8_STAGE(PG8_SA(1, 0), cA + kstep, voffA); PG8_STAGE(PG8_SB(1, 1), cB + hstepB + kstep, voffB);
        PG8_WAIT_V(6); PG8_BAR;
    }
    for (;;) {
        const bool has_next = S.next(ui + 1, nxt);
        const char* nA = has_next ? (const char*)g.A + (size_t)nxt.pm * tstep : cA; const char* nB = has_next ? (const char*)g.Bt + (size_t)nxt.pn * tstep : cB;
        for (int t = 0; t < nt; t += 2) {
            const bool last = (t == nt - 2);
            const char* a1 = cA + (size_t)(t + 1) * kstep;
            const char* a2 = last ? nA : cA + (size_t)(t + 2) * kstep; const char* b2 = last ? nB : cB + (size_t)(t + 2) * kstep;
            const char* a3 = a2 + kstep; const char* b3 = b2 + kstep;
            if constexpr (SP2) {
            PG8_LDB(B0, 0, 0); PG8_LDB(B1, 0, 1); PG8_SCHED; PG8_LDA(At, 0, 0); PG8_STAGE(PG8_SA(1, 1), a1 + hstep, voffA);
            PG8_WAIT_V(8); PG8_WAIT_L(0); PG8_BAR; PG8_MMA(0, 0, At, B0); PG8_MMA(0, 1, At, B1); PG8_BAR; PG8_SCHED;
            PG8_LDA(At, 0, 1); PG8_STAGE(PG8_SB(0, 0), b2, voffB); PG8_STAGE(PG8_SB(0, 1), b2 + hstepB, voffB); PG8_STAGE(PG8_SA(0, 0), a2, voffA);
            PG8_WAIT_V(8); PG8_WAIT_L(0); PG8_BAR; PG8_MMA(1, 0, At, B0); PG8_MMA(1, 1, At, B1); PG8_BAR; PG8_SCHED;
            PG8_LDB(B0, 1, 0); PG8_LDB(B1, 1, 1); PG8_SCHED; PG8_LDA(At, 1, 0); PG8_STAGE(PG8_SA(0, 1), a2 + hstep, voffA);
            PG8_WAIT_V(8); PG8_WAIT_L(0); PG8_BAR; PG8_MMA(0, 0, At, B0); PG8_MMA(0, 1, At, B1); PG8_BAR; PG8_SCHED;
            PG8_LDA(At, 1, 1); PG8_STAGE(PG8_SB(1, 0), b3, voffB); PG8_STAGE(PG8_SB(1, 1), b3 + hstepB, voffB); PG8_STAGE(PG8_SA(1, 0), a3, voffA);
            PG8_WAIT_V(8); PG8_WAIT_L(0); PG8_BAR; PG8_MMA(1, 0, At, B0); PG8_MMA(1, 1, At, B1); PG8_BAR; PG8_SCHED;
            } else {
            PG8_LDB(B0, 0, 0); PG8_SCHED; PG8_LDA(At, 0, 0); PG8_STAGE(PG8_SA(1, 1), a1 + hstep, voffA);
            PG8_WAIT_L(8); PG8_BAR; PG8_WAIT_L(0); PG8_MMA(0, 0, At, B0); PG8_BAR; PG8_SCHED;
            PG8_LDB(B1, 0, 1); PG8_STAGE(PG8_SB(0, 0), b2, voffB);
            PG8_BAR; PG8_WAIT_L(0); PG8_MMA(0, 1, At, B1); PG8_BAR;
            PG8_LDA(At, 0, 1); PG8_STAGE(PG8_SA(0, 0), a2, voffA);
            PG8_BAR; PG8_WAIT_L(0); PG8_MMA(1, 0, At, B0); PG8_BAR; PG8_SCHED;
            PG8_STAGE(PG8_SB(0, 1), b2 + hstepB, voffB);
            PG8_WAIT_V(6); PG8_BAR; PG8_MMA(1, 1, At, B1); PG8_BAR;
            PG8_LDB(B0, 1, 0); PG8_SCHED; PG8_LDA(At, 1, 0); PG8_STAGE(PG8_SA(0, 1), a2 + hstep, voffA);
            PG8_WAIT_L(8); PG8_BAR; PG8_WAIT_L(0); PG8_MMA(0, 0, At, B0); PG8_BAR; PG8_SCHED;
            PG8_LDB(B1, 1, 1); PG8_STAGE(PG8_SB(1, 0), b3, voffB);
            PG8_BAR; PG8_WAIT_L(0); PG8_MMA(0, 1, At, B1); PG8_BAR;
            PG8_LDA(At, 1, 1); PG8_STAGE(PG8_SA(1, 0), a3, voffA);
            PG8_BAR; PG8_WAIT_L(0); PG8_MMA(1, 0, At, B0); PG8_BAR; PG8_SCHED;
            PG8_STAGE(PG8_SB(1, 1), b3 + hstepB, voffB);
            PG8_WAIT_V(6); PG8_BAR; PG8_MMA(1, 1, At, B1); PG8_BAR;
            }
        }
        if constexpr (ALIGN_EPI) { if (wr == 0) PG8_BAR; }
        if constexpr (Epi::FUSED) E.fused(acc, cur, wr, wc, fr, fq, wid, lane); else E(acc, cur, wr, wc, fr, fq);
        if (!has_next) break;
#pragma unroll
        for (int a = 0; a < 2; ++a)
#pragma unroll
            for (int b = 0; b < 2; ++b)
#pragma unroll
                for (int m = 0; m < 4; ++m)
#pragma unroll
                    for (int n = 0; n < 2; ++n) acc[a][b][m][n] = (f32x4){0.f, 0.f, 0.f, 0.f};
        cur = nxt; cA = nA; cB = nB; ++ui;
        if constexpr (ALIGN_EPI) { if (wr == 1) PG8_BAR; }
    }
    PG8_WAIT_V(0);
    if constexpr (!ALIGN_EPI) { if (wr == 0) PG8_BAR; }
    PG8_BAR;
#undef PG8_SA
#undef PG8_SB
#undef PG8_STAGE
#undef PG8_LDA
#undef PG8_LDB
#undef PG8_MMA
#undef PG8_WAIT_V
#undef PG8_WAIT_L
#undef PG8_BAR
#undef PG8_SCHED
}
}

struct EpiInProj {
    static constexpr bool FUSED = false;
    static constexpr int BMODE = 2;
    bf16_t* Z; const float* rope; float* kout; float* vout;
    __device__ __forceinline__ void operator()(const f32x4 (&acc)[2][2][4][2], const pg8::Unit& u, int wr, int wc, int fr, int fq) const {
        const int pn = u.pn, hsel = wc >> 1, i0 = 32 * (wc & 1) + 8 * fq;
        const int colb = 256 * pn + 128 * hsel + i0;
#pragma unroll
        for (int ai = 0; ai < 2; ++ai)
#pragma unroll
            for (int m = 0; m < 4; ++m) {
                const int row = 256 * u.pm + 128 * ai + 64 * wr + 16 * m + fr;
                const int pos = row & (SEQ - 1), bb = row >> 12;
                f32x4 a0 = acc[ai][0][m][0], a1 = acc[ai][0][m][1], b0 = acc[ai][1][m][0], b1 = acc[ai][1][m][1];
                if (pn < 8) {
                    const float* rt = rope + (size_t)pos * 128 + i0;
                    const f32x4 c0 = *(const f32x4*)(rt), c1 = *(const f32x4*)(rt + 4), s0 = *(const f32x4*)(rt + 64), s1 = *(const f32x4*)(rt + 68);
                    const f32x4 o0 = a0 * c0 - b0 * s0, o1 = a1 * c1 - b1 * s1, p0 = b0 * c0 + a0 * s0, p1 = b1 * c1 + a1 * s1;
                    a0 = o0; a1 = o1; b0 = p0; b1 = p1;
                    if (pn < 4) { const float sc = 0.08838834764831845f; a0 *= sc; a1 *= sc; b0 *= sc; b1 *= sc; }
                } else if (pn >= 12 && pn < 18) { const float sc = 0.0625f; a0 *= sc; a1 *= sc; b0 *= sc; b1 *= sc; }
                bf16_t* zp = Z + (size_t)row * NZ + colb;
                u32x4 w; w.x = cvt_pk_bf16(a0[0], a0[1]); w.y = cvt_pk_bf16(a0[2], a0[3]); w.z = cvt_pk_bf16(a1[0], a1[1]); w.w = cvt_pk_bf16(a1[2], a1[3]);
                *(u32x4*)zp = w;
                w.x = cvt_pk_bf16(b0[0], b0[1]); w.y = cvt_pk_bf16(b0[2], b0[3]); w.z = cvt_pk_bf16(b1[0], b1[1]); w.w = cvt_pk_bf16(b1[2], b1[3]);
                *(u32x4*)(zp + 64) = w;
                if (pn >= 4 && pn < 12 && pos >= 2048) {
                    float* ob = (pn < 8) ? kout : vout; const int head = 2 * ((pn - 4) & 3) + hsel;
                    float* op = ob + ((size_t)(bb * 2048 + pos - 2048) * 8 + head) * 128 + i0;
                    *(f32x4*)op = a0; *(f32x4*)(op + 4) = a1; *(f32x4*)(op + 64) = b0; *(f32x4*)(op + 68) = b1;
                }
                asm volatile("" ::: "memory");
            }
    }
};
struct EpiOutProj {
    static constexpr bool FUSED = false;
    static constexpr int BMODE = 0;
    const float* X; float* H; bf16_t* HB; float* rss;
    __device__ __forceinline__ void operator()(const f32x4 (&acc)[2][2][4][2], const pg8::Unit& u, int wr, int wc, int fr, int fq) const {
        const int col0 = 256 * u.pn + 32 * wc + 4 * fq;
#pragma unroll
        for (int ai = 0; ai < 2; ++ai)
#pragma unroll
            for (int m = 0; m < 4; ++m) {
                const int row = 256 * u.pm + 128 * ai + 64 * wr + 16 * m + fr; const size_t off = (size_t)row * DM + col0; float ss = 0.f;
#pragma unroll
                for (int bj = 0; bj < 2; ++bj)
#pragma unroll
                    for (int n = 0; n < 2; ++n) { const size_t o = off + bj * 128 + n * 16; const f32x4 hv = *(const f32x4*)(X + o) + acc[ai][bj][m][n];
                        u32x2 w; w.x = cvt_pk_bf16(hv[0], hv[1]); w.y = cvt_pk_bf16(hv[2], hv[3]); *(u32x2*)(HB + o) = w;
                        ss += (hv[0] * hv[0] + hv[1] * hv[1]) + (hv[2] * hv[2] + hv[3] * hv[3]); }
                ss += __shfl_xor(ss, 16); ss += __shfl_xor(ss, 32);
                if (fq == 0) atomicAdd(rss + row, ss);
                asm volatile("" ::: "memory");
            }
    }
};
struct EpiUp {
    static constexpr bool FUSED = false;
    static constexpr int BMODE = 1;
    bf16_t* U; const float* rss; int pm0;
    __device__ __forceinline__ void operator()(const f32x4 (&acc)[2][2][4][2], const pg8::Unit& u, int wr, int wc, int fr, int fq) const {
        const int col0 = 256 * u.pn + 32 * wc + 8 * fq;
        float rr[2][4];
#pragma unroll
        for (int ai = 0; ai < 2; ++ai)
#pragma unroll
            for (int m = 0; m < 4; ++m) rr[ai][m] = rss[256 * (u.pm + pm0) + 128 * ai + 64 * wr + 16 * m + fr];
#pragma unroll
        for (int ai = 0; ai < 2; ++ai)
#pragma unroll
            for (int m = 0; m < 4; ++m) rr[ai][m] = rsqrtf(rr[ai][m] * (1.0f / DM) + EPS);
        asm volatile("" ::: "memory");
#pragma unroll
        for (int ai = 0; ai < 2; ++ai)
#pragma unroll
            for (int m = 0; m < 4; ++m) {
                const int row = 256 * (u.pm + pm0) + 128 * ai + 64 * wr + 16 * m + fr;
                const float r = rr[ai][m];
                bf16_t* up = U + (size_t)row * DFF + col0;
#pragma unroll
                for (int bj = 0; bj < 2; ++bj) { f32x4 v0 = acc[ai][bj][m][0] * r, v1 = acc[ai][bj][m][1] * r;
#pragma unroll
                    for (int j = 0; j < 4; ++j) { const float a = fmaxf(v0[j], 0.f), b = fmaxf(v1[j], 0.f); v0[j] = a * a; v1[j] = b * b; }
                    u32x4 w; w.x = cvt_pk_bf16(v0[0], v0[1]); w.y = cvt_pk_bf16(v0[2], v0[3]); w.z = cvt_pk_bf16(v1[0], v1[1]); w.w = cvt_pk_bf16(v1[2], v1[3]);
                    *(u32x4*)(up + bj * 128) = w; }
            }
    }
};
struct EpiDown {
    static constexpr bool FUSED = false;
    static constexpr int BMODE = 0;
    const bf16_t* HB; bf16_t* YB; float* rss; int pm0;
    __device__ __forceinline__ void operator()(const f32x4 (&acc)[2][2][4][2], const pg8::Unit& u, int wr, int wc, int fr, int fq) const {
        const int col0 = 256 * u.pn + 32 * wc + 4 * fq;
#pragma unroll
        for (int ai = 0; ai < 2; ++ai)
#pragma unroll
            for (int m = 0; m < 4; ++m) {
                const int row = 256 * (u.pm + pm0) + 128 * ai + 64 * wr + 16 * m + fr; const size_t off = (size_t)row * DM + col0; float ss = 0.f;
#pragma unroll
                for (int bj = 0; bj < 2; ++bj)
#pragma unroll
                    for (int n = 0; n < 2; ++n) { const size_t o = off + bj * 128 + n * 16; const u32x2 hw = *(const u32x2*)(HB + o);
                        const f32x4 hv = (f32x4){bf_lo(hw.x), bf_hi(hw.x), bf_lo(hw.y), bf_hi(hw.y)} + acc[ai][bj][m][n];
                        u32x2 w; w.x = cvt_pk_bf16(hv[0], hv[1]); w.y = cvt_pk_bf16(hv[2], hv[3]); *(u32x2*)(YB + o) = w;
                        ss += (hv[0] * hv[0] + hv[1] * hv[1]) + (hv[2] * hv[2] + hv[3] * hv[3]); }
                ss += __shfl_xor(ss, 16); ss += __shfl_xor(ss, 32);
                if (fq == 0) atomicAdd(rss + row, ss);
                asm volatile("" ::: "memory");
            }
    }
};

struct EpiDownNorm {
    static constexpr int BMODE = 0; static constexpr bool FUSED = true;
    const bf16_t* HB; float* Y; float* rss; unsigned* cnt; const float* gain; int pm0;
    __device__ __forceinline__ void operator()(const f32x4 (&)[2][2][4][2], const pg8::Unit&, int, int, int, int) const {}
    __device__ __forceinline__ void fused(f32x4 (&acc)[2][2][4][2], const pg8::Unit& u, int wr, int wc, int fr, int fq, int wid, int lane) const {
        const int col0 = 256 * u.pn + 32 * wc + 4 * fq, prow = 256 * (u.pm + pm0) + 64 * wr + fr;
        float chk = 0.f;
#pragma unroll
        for (int ai = 0; ai < 2; ++ai) {
            u32x2 hw[4][2][2];
#pragma unroll
            for (int m = 0; m < 4; ++m) { const size_t off = (size_t)(prow + 128 * ai + 16 * m) * DM + col0;
#pragma unroll
                for (int bj = 0; bj < 2; ++bj)
#pragma unroll
                    for (int n = 0; n < 2; ++n) hw[m][bj][n] = *(const u32x2*)(HB + off + bj * 128 + n * 16); }
#pragma unroll
            for (int m = 0; m < 4; ++m) { float ss = 0.f;
#pragma unroll
                for (int bj = 0; bj < 2; ++bj)
#pragma unroll
                    for (int n = 0; n < 2; ++n) { const u32x2 h2 = hw[m][bj][n]; f32x4 hv = (f32x4){bf_lo(h2.x), bf_hi(h2.x), bf_lo(h2.y), bf_hi(h2.y)} + acc[ai][bj][m][n]; acc[ai][bj][m][n] = hv;
                        ss += (hv[0] * hv[0] + hv[1] * hv[1]) + (hv[2] * hv[2] + hv[3] * hv[3]); }
                ss += __shfl_xor(ss, 16); ss += __shfl_xor(ss, 32);
                if (fq == 0) chk += __hip_atomic_fetch_add(rss + prow + 128 * ai + 16 * m, ss, __ATOMIC_RELAXED, __HIP_MEMORY_SCOPE_AGENT); }
        }
        asm volatile("s_waitcnt vmcnt(0)" :: "v"(chk) : "memory");
        unsigned* pc = cnt + 64 * (u.pm + pm0);
        if (lane == 0) __hip_atomic_fetch_add(pc, 1u, __ATOMIC_RELAXED, __HIP_MEMORY_SCOPE_AGENT);
        if (wid == 0) { unsigned sp = 0; while ((unsigned)__builtin_amdgcn_readfirstlane(__hip_atomic_load(pc, __ATOMIC_RELAXED, __HIP_MEMORY_SCOPE_AGENT)) < 128u && ++sp < 400000u) __builtin_amdgcn_s_sleep(1); }
        asm volatile("s_waitcnt vmcnt(0) lgkmcnt(0)" ::: "memory"); __builtin_amdgcn_s_barrier(); asm volatile("" ::: "memory");
        float rr[2][4];
#pragma unroll
        for (int ai = 0; ai < 2; ++ai)
#pragma unroll
            for (int m = 0; m < 4; ++m) rr[ai][m] = __hip_atomic_load(rss + prow + 128 * ai + 16 * m, __ATOMIC_RELAXED, __HIP_MEMORY_SCOPE_AGENT);
        f32x4 gg[2][2];
#pragma unroll
        for (int bj = 0; bj < 2; ++bj)
#pragma unroll
            for (int n = 0; n < 2; ++n) gg[bj][n] = *(const f32x4*)(gain + col0 + bj * 128 + n * 16);
#pragma unroll
        for (int ai = 0; ai < 2; ++ai)
#pragma unroll
            for (int m = 0; m < 4; ++m) { const float r = rsqrtf(rr[ai][m] * (1.0f / DM) + EPS); float* yp = Y + (size_t)(prow + 128 * ai + 16 * m) * DM + col0;
#pragma unroll
                for (int bj = 0; bj < 2; ++bj)
#pragma unroll
                    for (int n = 0; n < 2; ++n) *(f32x4*)(yp + bj * 128 + n * 16) = acc[ai][bj][m][n] * r * gg[bj][n]; }
    }
};

constexpr int SK_SROW = 528;
template <int NI, class Epi>
__device__ __forceinline__ void skinny_unit(LAS unsigned char* lds, const bf16_t* S, const bf16_t* T, int K, int kbeg, int klen, const Epi& E, int u, int w) {
    int tid = threadIdx.x; asm volatile("" : "+v"(tid)); const int wid = __builtin_amdgcn_readfirstlane(tid >> 6), lane = tid & 63, li = lane & 15, g = lane >> 4;
    const int kw = klen >> 3, k0 = kbeg + wid * kw;
    const bf16_t* t0 = T + (size_t)(E.jrow(u, w, 0) + li) * K + 32 * g;
    const bf16_t* t1 = T + (size_t)(E.jrow(u, w, 1) + li) * K + 32 * g;
    const bf16_t* s0 = S + (size_t)li * K + 32 * g;
    f32x4 acc[2][NI];
#pragma unroll
    for (int a = 0; a < 2; ++a)
#pragma unroll
        for (int b = 0; b < NI; ++b) acc[a][b] = (f32x4){0.f, 0.f, 0.f, 0.f};
    bf16x8 tcA[2][4], scA[NI][4], tcB[2][4], scB[NI][4];
#define SK_LOAD(tc_, sc_, kb_) do { _Pragma("unroll") for (int q = 0; q < 4; ++q) { const int ko = (kb_) + 8 * q; tc_[0][q] = *(const bf16x8*)(t0 + ko); tc_[1][q] = *(const bf16x8*)(t1 + ko); \
        _Pragma("unroll") for (int i2 = 0; i2 < NI; ++i2) sc_[i2][q] = *(const bf16x8*)(s0 + (size_t)(16 * i2) * K + ko); } } while (0)
#define SK_MMA(tc_, sc_) do { _Pragma("unroll") for (int q = 0; q < 4; ++q) _Pragma("unroll") for (int i2 = 0; i2 < NI; ++i2) { \
        acc[0][i2] = __builtin_amdgcn_mfma_f32_16x16x32_bf16(tc_[0][q], sc_[i2][q], acc[0][i2], 0, 0, 0); \
        acc[1][i2] = __builtin_amdgcn_mfma_f32_16x16x32_bf16(tc_[1][q], sc_[i2][q], acc[1][i2], 0, 0, 0); } } while (0)
    SK_LOAD(tcA, scA, k0);
#pragma unroll 1
    for (int kb = k0; kb < k0 + kw; kb += 256) {
        SK_LOAD(tcB, scB, kb + 128);
        SK_MMA(tcA, scA);
        if (kb + 256 < k0 + kw) SK_LOAD(tcA, scA, kb + 256);
        SK_MMA(tcB, scB);
    }
#undef SK_LOAD
#undef SK_MMA
    LAS f32x4* red = (LAS f32x4*)lds;
#pragma unroll
    for (int a = 0; a < 2; ++a)
#pragma unroll
        for (int b = 0; b < NI; ++b) red[((wid * 2 + a) * NI + b) * 64 + lane] = acc[a][b];
    __syncthreads();
    if (wid == 0) {
#pragma unroll
        for (int a = 0; a < 2; ++a)
#pragma unroll
            for (int b = 0; b < NI; ++b) { f32x4 s = red[(a * NI + b) * 64 + lane];
#pragma unroll
                for (int ww = 1; ww < 8; ++ww) s += red[((ww * 2 + a) * NI + b) * 64 + lane];
                acc[a][b] = s; }
        E(acc, u, w, li, g);
    }
    __syncthreads();
}

struct SkGates {
    const float* bif; float* G;
    __device__ __forceinline__ int jrow(int u, int w, int jt) const { return 256 * u + 32 * w + 16 * jt; }
    __device__ __forceinline__ void operator()(const f32x4 (&acc)[2][1], int u, int w, int li, int g) const {
        if (li >= 12) return;
        const float bias = bif[li];
#pragma unroll
        for (int jt = 0; jt < 2; ++jt) {
            const int tok = jrow(u, w, jt) + 4 * g; if (tok >= MT) continue;
            f32x4 v = acc[jt][0];
#pragma unroll
            for (int j = 0; j < 4; ++j) { float a = 15.0f * tanhf((v[j] + bias) * (1.0f / 15.0f));
                if (li >= 6) a = fminf(a, 0.f) - log1pf(__expf(-fabsf(a)));
                v[j] = a; }
            *(f32x4*)(G + (size_t)li * MT + tok) = v;
        }
    }
};
struct SkInProj {
    bf16_t* Z; const float* rope; float* kout; float* vout;
    __device__ __forceinline__ int jrow(int u, int w, int jt) const { return 256 * u + 128 * (w >> 2) + 64 * jt + 16 * (w & 3); }
    __device__ __forceinline__ void operator()(const f32x4 (&acc)[2][2], int u, int w, int li, int g) const {
        const int c0 = jrow(u, w, 0) + 4 * g;
        const int i0 = (c0 & 63);
#pragma unroll
        for (int i2 = 0; i2 < 2; ++i2) {
            const int sr = 16 * i2 + li, row = MP + sr;
            f32x4 a = acc[0][i2], b = acc[1][i2];
            if (u < 8) {
                const float* rt = rope + (size_t)4096 * 128 + i0;
                const f32x4 c = *(const f32x4*)rt, s = *(const f32x4*)(rt + 64);
                const f32x4 o = a * c - b * s, p = b * c + a * s; a = o; b = p;
                if (u < 4) { a *= 0.08838834764831845f; b *= 0.08838834764831845f; }
            } else if (u >= 12 && u < 18) { a *= 0.0625f; b *= 0.0625f; }
            bf16_t* zp = Z + (size_t)row * NZ + c0;
            u32x2 wv; wv.x = cvt_pk_bf16(a[0], a[1]); wv.y = cvt_pk_bf16(a[2], a[3]); *(u32x2*)zp = wv;
            wv.x = cvt_pk_bf16(b[0], b[1]); wv.y = cvt_pk_bf16(b[2], b[3]); *(u32x2*)(zp + 64) = wv;
            if (u >= 4 && u < 12) { float* ob = (u < 8) ? kout : vout; float* op = ob + (size_t)sr * 1024 + (c0 & 1023); *(f32x4*)op = a; *(f32x4*)(op + 64) = b; }
        }
    }
};
struct SkOutProj {
    const float* XS; float* H; bf16_t* HB; float* rss;
    __device__ __forceinline__ int jrow(int u, int w, int jt) const { return 256 * u + 32 * w + 16 * jt; }
    __device__ __forceinline__ void operator()(const f32x4 (&acc)[2][2], int u, int w, int li, int g) const {
#pragma unroll
        for (int i2 = 0; i2 < 2; ++i2) { const int sr = 16 * i2 + li, row = MP + sr; float ss = 0.f;
#pragma unroll
            for (int jt = 0; jt < 2; ++jt) { const int col = jrow(u, w, jt) + 4 * g; const f32x4 hv = *(const f32x4*)(XS + (size_t)sr * DM + col) + acc[jt][i2];
                u32x2 wv; wv.x = cvt_pk_bf16(hv[0], hv[1]); wv.y = cvt_pk_bf16(hv[2], hv[3]); *(u32x2*)(HB + (size_t)row * DM + col) = wv;
                ss += (hv[0] * hv[0] + hv[1] * hv[1]) + (hv[2] * hv[2] + hv[3] * hv[3]); }
            atomicAdd(rss + row, ss); }
    }
};
struct SkUp {
    bf16_t* U; const float* rss;
    __device__ __forceinline__ int jrow(int u, int w, int jt) const { return 256 * u + 32 * w + 16 * jt; }
    __device__ __forceinline__ void operator()(const f32x4 (&acc)[2][2], int u, int w, int li, int g) const {
#pragma unroll
        for (int i2 = 0; i2 < 2; ++i2) { const int row = MP + 16 * i2 + li; const float r = rsqrtf(rss[row] * (1.0f / DM) + EPS);
#pragma unroll
            for (int jt = 0; jt < 2; ++jt) { const int col = jrow(u, w, jt) + 4 * g; f32x4 v = acc[jt][i2] * r;
#pragma unroll
                for (int j = 0; j < 4; ++j) { const float a = fmaxf(v[j], 0.f); v[j] = a * a; }
                u32x2 wv; wv.x = cvt_pk_bf16(v[0], v[1]); wv.y = cvt_pk_bf16(v[2], v[3]); *(u32x2*)(U + (size_t)row * DFF + col) = wv; } }
    }
};
struct SkDown {
    float* ACC;
    __device__ __forceinline__ int jrow(int u, int w, int jt) const { return 256 * (u & 15) + 32 * w + 16 * jt; }
    __device__ __forceinline__ void operator()(const f32x4 (&acc)[2][2], int u, int w, int li, int g) const {
#pragma unroll
        for (int i2 = 0; i2 < 2; ++i2)
#pragma unroll
            for (int jt = 0; jt < 2; ++jt) { float* p = ACC + (size_t)(16 * i2 + li) * DM + jrow(u, w, jt) + 4 * g;
#pragma unroll
                for (int j = 0; j < 4; ++j) atomicAdd(p + j, acc[jt][i2][j]); }
    }
};

__device__ __forceinline__ void trw_load(f32x4 (&v)[16], const float* W, int ldw, int nnb, int it, int wid, int lane) {
    const int kbo = it / nnb, nb = it - kbo * nnb; const float* p = W + (size_t)(128 * kbo + 16 * wid) * ldw + 256 * nb + 4 * lane;
#pragma unroll
    for (int i = 0; i < 16; ++i) v[i] = __builtin_nontemporal_load((const f32x4*)(p + (size_t)i * ldw));
}
__device__ __forceinline__ void trw_to_lds(f32x4 (&v)[16], LAS unsigned char* buf, const float* gk, int nnb, int it, int wid, int lane) {
    if (gk) { const int kbo = it / nnb;
#pragma unroll
        for (int i = 0; i < 16; ++i) v[i] *= gk[128 * kbo + 16 * wid + i]; }
    const int key = lane & 7;
#pragma unroll
    for (int c = 0; c < 4; ++c) { LAS unsigned char* rp = buf + (4 * lane + c) * 256;
        u32x4 lo, hi; lo.x = cvt_pk_bf16(v[0][c], v[1][c]); lo.y = cvt_pk_bf16(v[2][c], v[3][c]); lo.z = cvt_pk_bf16(v[4][c], v[5][c]); lo.w = cvt_pk_bf16(v[6][c], v[7][c]);
        hi.x = cvt_pk_bf16(v[8][c], v[9][c]); hi.y = cvt_pk_bf16(v[10][c], v[11][c]); hi.z = cvt_pk_bf16(v[12][c], v[13][c]); hi.w = cvt_pk_bf16(v[14][c], v[15][c]);
        *(LAS u32x4*)(rp + 16 * ((2 * wid) ^ key)) = lo; *(LAS u32x4*)(rp + 16 * ((2 * wid + 1) ^ key)) = hi; }
}
__device__ __forceinline__ void trw_store(const LAS unsigned char* buf, bf16_t* WT, int K, int nnb, int it, int wid, int lane) {
    const int kbo = it / nnb, nb = it - kbo * nnb, chunk = lane & 15;
#pragma unroll
    for (int j = 0; j < 8; ++j) { const int row = 32 * j + 4 * wid + (lane >> 4), key = (row >> 2) & 7;
        const u32x4 d = *(const LAS u32x4*)(buf + row * 256 + 16 * (chunk ^ key));
        *(u32x4*)(WT + (size_t)(256 * nb + row) * K + 128 * kbo + 8 * chunk) = d; }
}
__device__ __forceinline__ void trw_run(LAS unsigned char* lds, const float* W, int ldw, int K, int Nuse, bf16_t* WT, const float* gk, int first, int cnt, int stride) {
    int tid = threadIdx.x; asm volatile("" : "+v"(tid)); const int wid = __builtin_amdgcn_readfirstlane(tid >> 6), lane = tid & 63;
    const int nnb = Nuse / 256; if (cnt <= 0) return;
    f32x4 v[16]; int it = first;
    trw_load(v, W, ldw, nnb, it, wid, lane);
    trw_to_lds(v, lds, gk, nnb, it, wid, lane);
    __syncthreads();
    for (int j = 0; j < cnt; ++j) {
        const int nx = it + stride; const bool more = (j + 1 < cnt);
        if (more) trw_load(v, W, ldw, nnb, nx, wid, lane);
        trw_store(lds + (j & 1) * 65536, WT, K, nnb, it, wid, lane);
        if (more) trw_to_lds(v, lds + ((j + 1) & 1) * 65536, gk, nnb, nx, wid, lane);
        __syncthreads();
        it = nx;
    }
}
__device__ __forceinline__ void p0_tr_load(f32x4 (&v)[8], const float* W, int ldw, int Nuse_, int it, int lane) {
    const int nnb = Nuse_ / 256, kb = 8 * (it / (8 * nnb)) + (it & 7), nb = (it >> 3) % nnb, k0 = 8 * kb, n0 = 256 * nb + 4 * lane;
#pragma unroll
    for (int i = 0; i < 8; ++i) v[i] = *(const f32x4*)(W + (size_t)(k0 + i) * ldw + n0);
}
__device__ __forceinline__ void p0_tr_store(f32x4 (&v)[8], int K, bf16_t* WT, const float* gk, int Nuse_, int it, int lane) {
    const int nnb = Nuse_ / 256, kb = 8 * (it / (8 * nnb)) + (it & 7), nb = (it >> 3) % nnb, k0 = 8 * kb, n0 = 256 * nb + 4 * lane;
    if (gk) {
#pragma unroll
        for (int i = 0; i < 8; ++i) v[i] *= gk[k0 + i];
    }
#pragma unroll
    for (int c = 0; c < 4; ++c) { u32x4 o; o.x = cvt_pk_bf16(v[0][c], v[1][c]); o.y = cvt_pk_bf16(v[2][c], v[3][c]); o.z = cvt_pk_bf16(v[4][c], v[5][c]); o.w = cvt_pk_bf16(v[6][c], v[7][c]);
        *(u32x4*)(WT + (size_t)(n0 + c) * K + k0) = o; }
}
__device__ __forceinline__ void p0_transpose(const float* W, int ldw, int K, int Nuse, bf16_t* WT, const float* gk, int gw, int ngw, int lane) {
    const int nkb = K / 8, nnb = Nuse / 256, items = nkb * nnb;
    int it = gw; if (it >= items) return;
    f32x4 v[8], w[8];
    p0_tr_load(v, W, ldw, Nuse, it, lane);
    for (;;) {
        const int n1 = it + ngw;
        if (n1 < items) p0_tr_load(w, W, ldw, Nuse, n1, lane);
        p0_tr_store(v, K, WT, gk, Nuse, it, lane);
        if (n1 >= items) break;
        const int n2 = n1 + ngw;
        if (n2 < items) p0_tr_load(v, W, ldw, Nuse, n2, lane);
        p0_tr_store(w, K, WT, gk, Nuse, n1, lane);
        if (n2 >= items) break;
        it = n2;
    }
}
__device__ __forceinline__ void sincos_d(float ang, float& c, float& s) {
    const double x = (double)ang;
    const double n = __builtin_rint(x * 0.63661977236758134308);
    double r = __builtin_fma(-n, 1.57079632679489655800e+00, x); r = __builtin_fma(-n, 6.12323399573676603587e-17, r);
    const double r2 = r * r;
    double sp = 1.0 / 6227020800.0; sp = sp * r2 * (-1.0) + 1.0 / 39916800.0; sp = sp * r2 * (-1.0) + 1.0 / 362880.0; sp = sp * r2 * (-1.0) + 1.0 / 5040.0; sp = sp * r2 * (-1.0) + 1.0 / 120.0; sp = sp * r2 * (-1.0) + 1.0 / 6.0; sp = sp * r2 * (-1.0) + 1.0;
    const double sn = sp * r;
    double cp = 1.0 / 87178291200.0; cp = cp * r2 * (-1.0) + 1.0 / 479001600.0; cp = cp * r2 * (-1.0) + 1.0 / 3628800.0; cp = cp * r2 * (-1.0) + 1.0 / 40320.0; cp = cp * r2 * (-1.0) + 1.0 / 720.0; cp = cp * r2 * (-1.0) + 1.0 / 24.0; cp = cp * r2 * (-1.0) + 0.5; cp = cp * r2 * (-1.0) + 1.0;
    const double cs = cp;
    const int q = ((int)n) & 3;
    const double cc = (q == 0) ? cs : (q == 1) ? -sn : (q == 2) ? -cs : sn;
    const double ss = (q == 0) ? sn : (q == 1) ? cs : (q == 2) ? -sn : -cs;
    c = (float)cc; s = (float)ss;
}
struct P0Args { const float *xp, *xs, *g1, *win, *wout, *g2, *wup, *wdn; bf16_t *WinT, *WoutT, *WupT, *WdnT, *XN, *WG; float* rope; };
__device__ __forceinline__ void p0_prologue(const P0Args& a, int vcu, int G, int wid, int lane) {
    const int gw = vcu * 8 + wid, ngw = G * 8, gt = gw * 64 + lane, ngt = ngw * 64;
    for (int idx = gt; idx < 4097 * 64; idx += ngt) { const int pi = idx >> 6, i = idx & 63; const int pos = pi < 4096 ? pi : 8192;
        double invd = 1.0; for (int e = 0; e < i; ++e) invd *= 0.86596432336006535;
        const float inv = (float)invd; const float ang = (float)pos * inv; float c, s; sincos_d(ang, c, s);
        a.rope[(size_t)pi * 128 + i] = c; a.rope[(size_t)pi * 128 + 64 + i] = s; }
    for (int idx = gt; idx < 16 * DM; idx += ngt) { const int gi = idx >> 12, k = idx & 4095; const float v = gi < 12 ? a.win[(size_t)k * NINF + NZ + gi] : 0.f; a.WG[idx] = (bf16_t)(cvt_pk_bf16(v, 0.f) & 0xffffu); }
    for (int m = gw; m < MT; m += ngw) {
        const float* xr = (m < MP) ? a.xp + (size_t)m * DM : a.xs + (size_t)(m - MP) * DM;
        f32x4 v[8][2]; float ss = 0.f;
#pragma unroll
        for (int c = 0; c < 8; ++c) { v[c][0] = *(const f32x4*)(xr + 512 * c + 8 * lane); v[c][1] = *(const f32x4*)(xr + 512 * c + 8 * lane + 4);
            ss += (v[c][0][0] * v[c][0][0] + v[c][0][1] * v[c][0][1]) + (v[c][0][2] * v[c][0][2] + v[c][0][3] * v[c][0][3]) + (v[c][1][0] * v[c][1][0] + v[c][1][1] * v[c][1][1]) + (v[c][1][2] * v[c][1][2] + v[c][1][3] * v[c][1][3]); }
        const float r = rsqrtf(wave_sum(ss) * (1.0f / DM) + EPS);
#pragma unroll
        for (int c = 0; c < 8; ++c) { const f32x4 g0 = *(const f32x4*)(a.g1 + 512 * c + 8 * lane), g1v = *(const f32x4*)(a.g1 + 512 * c + 8 * lane + 4);
            const f32x4 y0 = v[c][0] * r * g0, y1 = v[c][1] * r * g1v;
            u32x4 o; o.x = cvt_pk_bf16(y0[0], y0[1]); o.y = cvt_pk_bf16(y0[2], y0[3]); o.z = cvt_pk_bf16(y1[0], y1[1]); o.w = cvt_pk_bf16(y1[2], y1[3]);
            *(u32x4*)(a.XN + (size_t)m * DM + 512 * c + 8 * lane) = o; }
    }
}


constexpr int SC_KSTR = 544, SC_VSTR = 144, SC_KIMG = 50176, SC_VIMG = 84992;
__device__ __forceinline__ void mlstm_scan(LAS unsigned char* lds, const bf16_t* Z, const float* GT, bf16_t* CT, float* NC, float* TB, float* TWV, float* TMT, float* CM, float* out, int unit) {
    int tid = threadIdx.x; asm volatile("" : "+v"(tid)); const int wid = __builtin_amdgcn_readfirstlane(tid >> 6), lane = tid & 63, li = lane & 15, g = lane >> 4;
    const int bh = unit >> 3, sl = unit & 7, b = bh / NH, h = bh % NH, dvt = wid & 3, dkh = wid >> 2;
    LAS float* wv = (LAS float*)lds; LAS float* bl = wv + 4096; LAS float* cml = bl + 4096; LAS float* bs = cml + 4096; LAS float* gc = bs + 64; LAS float* mC = gc + 64;
    LAS unsigned char* Kimg = lds + SC_KIMG; LAS unsigned char* Vimg = lds + SC_VIMG;
    { const float* lip = GT + (size_t)h * MT + b * SEQ; const float* lfp = GT + (size_t)(6 + h) * MT + b * SEQ;
      for (int c = wid; c < NCH; c += 8) { const int t = 64 * c + lane; const float lf = lfp[t], liv = lip[t];
          float bsum = lf;
#pragma unroll
          for (int o = 1; o < 64; o <<= 1) { const float v = __shfl_up(bsum, o); if (lane >= o) bsum += v; }
          const float w = liv - bsum; float cm = w;
#pragma unroll
          for (int o = 1; o < 64; o <<= 1) { const float v = __shfl_up(cm, o); if (lane >= o) cm = fmaxf(cm, v); }
          wv[t] = w; bl[t] = bsum; cml[t] = cm;
          if (lane == 63) { bs[c] = bsum; gc[c] = bsum + cm; } }
      __syncthreads();
      if (tid == 0) { float m = 0.f; mC[0] = 0.f; for (int c = 0; c < NCH; ++c) { m = fmaxf(bs[c] + m, gc[c]); mC[c + 1] = m; } }
      __syncthreads();
      if (sl == 0) { for (int t = tid; t < SEQ; t += 512) { const int c = t >> 6; TB[bh * SEQ + t] = bl[t]; TWV[bh * SEQ + t] = wv[t]; TMT[bh * SEQ + t] = bl[t] + fmaxf(mC[c], cml[t]); }
                     if (tid < 65) CM[bh * 80 + tid] = mC[tid]; } }
    const bool nwr = (sl == 0) && (dvt == 0);
    f32x4 acc[8], nacc[8];
#pragma unroll
    for (int T = 0; T < 8; ++T) { acc[T] = (f32x4){0.f, 0.f, 0.f, 0.f}; nacc[T] = (f32x4){0.f, 0.f, 0.f, 0.f}; }
    bf16x8 ones;
#pragma unroll
    for (int e = 0; e < 8; ++e) ones[e] = (short)0x3F80;
    u32x4 kq[2][4], vq[2];
#define SCAN_LOAD(S_, c_) do { _Pragma("unroll") for (int q = 0; q < 4; ++q) { const int ch = tid + 512 * q, tok = ch >> 5, c16 = ch & 31; kq[S_][q] = *(const u32x4*)(Z + ((size_t)b * SEQ + 64 * (c_) + tok) * NZ + ZKM + h * DK + 8 * c16); } \
        { const int tok = tid >> 3, c16 = tid & 7; vq[S_] = *(const u32x4*)(Z + ((size_t)b * SEQ + 64 * (c_) + tok) * NZ + ZVM + h * DV + 64 * sl + 8 * c16); } } while (0)
#define SC_CL(x) fminf(fmaxf((x), -440.0f), 440.0f)
#define SC_PK8(v) ((unsigned)__builtin_amdgcn_cvt_pk_fp8_f32(SC_CL((v)[2]), SC_CL((v)[3]), __builtin_amdgcn_cvt_pk_fp8_f32(SC_CL((v)[0]), SC_CL((v)[1]), 0, false), true))
#define SCAN_STEP(S_, c_) do { const int c = (c_); \
        { unsigned char* ct = (unsigned char*)CT + (((size_t)(bh * NCH + c) * DV + (64 * sl + 16 * dvt + li)) * DK + 128 * dkh + 16 * g); \
          _Pragma("unroll") for (int Q = 0; Q < 2; ++Q) { u32x4 w; \
              w.x = SC_PK8(acc[4 * Q + 0]); w.y = SC_PK8(acc[4 * Q + 1]); w.z = SC_PK8(acc[4 * Q + 2]); w.w = SC_PK8(acc[4 * Q + 3]); \
              *(u32x4*)(ct + 64 * Q) = w; } \
          if (nwr && li == 0) { _Pragma("unroll") for (int T = 0; T < 8; ++T) *(f32x4*)(NC + (size_t)(bh * NCH + c) * DK + 128 * dkh + 64 * (T >> 2) + 16 * g + 4 * (T & 3)) = nacc[T]; } } \
        __syncthreads(); \
        const float mn = mC[c + 1], bsc = bs[c]; \
        _Pragma("unroll") for (int q = 0; q < 4; ++q) { const int ch = tid + 512 * q, tok = ch >> 5, c16 = ch & 31; \
            const u32x4 kv = kq[S_][q]; const float w = __expf(bsc + wv[64 * c + tok] - mn); \
            u32x4 o; o.x = cvt_pk_bf16(bf_lo(kv.x) * w, bf_hi(kv.x) * w); o.y = cvt_pk_bf16(bf_lo(kv.y) * w, bf_hi(kv.y) * w); o.z = cvt_pk_bf16(bf_lo(kv.z) * w, bf_hi(kv.z) * w); o.w = cvt_pk_bf16(bf_lo(kv.w) * w, bf_hi(kv.w) * w); \
            *(LAS u32x4*)(Kimg + tok * SC_KSTR + 16 * c16) = o; } \
        { const int tok = tid >> 3, c16 = tid & 7; *(LAS u32x4*)(Vimg + tok * SC_VSTR + 16 * c16) = vq[S_]; } \
        __syncthreads(); \
        if (c + 2 < NCH) SCAN_LOAD(S_, c + 2); \
        const float dec = __expf(bsc + mC[c] - mn); \
        _Pragma("unroll") for (int T = 0; T < 8; ++T) { acc[T] *= dec; nacc[T] *= dec; } \
        _Pragma("unroll") for (int kb = 0; kb < 2; ++kb) { \
            const LAS unsigned char* vp = Vimg + (32 * kb + 8 * g + (li >> 2)) * SC_VSTR + (16 * dvt + 4 * (li & 3)) * 2; \
            const bf16x8 Bf = cat8(vtr(vp), vtr(vp + 4 * SC_VSTR)); \
            _Pragma("unroll") for (int T = 0; T < 8; ++T) { \
                const LAS unsigned char* kp = Kimg + (32 * kb + 8 * g + (li >> 2)) * SC_KSTR + (128 * dkh + 64 * (T >> 2) + 16 * (li & 3) + 4 * (T & 3)) * 2; \
                const bf16x8 Af = cat8(vtr(kp), vtr(kp + 4 * SC_KSTR)); \
                acc[T] = __builtin_amdgcn_mfma_f32_16x16x32_bf16(Af, Bf, acc[T], 0, 0, 0); \
                if (nwr) nacc[T] = __builtin_amdgcn_mfma_f32_16x16x32_bf16(Af, ones, nacc[T], 0, 0, 0); } } } while (0)
    SCAN_LOAD(0, 0); SCAN_LOAD(1, 1);
#pragma unroll 1
    for (int c2 = 0; c2 < NCH; c2 += 2) { SCAN_STEP(0, c2); SCAN_STEP(1, c2 + 1); }
#undef SCAN_LOAD
#undef SCAN_STEP
#undef SC_PK8
#undef SC_CL
#pragma unroll
    for (int T = 0; T < 8; ++T)
#pragma unroll
        for (int r = 0; r < 4; ++r) out[O_CP + ((size_t)bh * DK + 128 * dkh + 64 * (T >> 2) + 16 * g + 4 * (T & 3) + r) * DV + 64 * sl + 16 * dvt + li] = acc[T][r];
    if (nwr && li == 0) {
#pragma unroll
        for (int T = 0; T < 8; ++T) *(f32x4*)(out + O_NP + (size_t)bh * DK + 128 * dkh + 64 * (T >> 2) + 16 * g + 4 * (T & 3)) = nacc[T]; }
    if (sl == 0 && tid == 0) out[O_MP + bh] = mC[NCH];
    __syncthreads();
}

constexpr int AT_VS = 272;
__device__ __forceinline__ void attn_blk_cfg(int s, int& r, int& w, int& blk) { if (s < 12) { r = 1; w = 128; blk = s; } else if (s < 18) { r = 4; w = 512; blk = s - 12; } else { r = 16; w = 2048; blk = s - 18; } }
__device__ __forceinline__ void attn_blk_load(const char* zc, int pmax, int s, int lane, bf16x8 (&kf)[2][4], u32x4 (&vv)[8]) {
    int r, w, blk; attn_blk_cfg(s, r, w, blk); const int li = lane & 15, g = lane >> 4;
    const int pb = pmax - r * 32 * blk;
#pragma unroll
    for (int it = 0; it < 8; ++it) { int kp = pb - r * (it * 4 + g); kp = kp < 0 ? 0 : kp;
        const unsigned off = __umul24((unsigned)kp, (unsigned)(NZ * 2)) + (unsigned)((ZVA + 8 * li) * 2);
        vv[it] = *(const u32x4*)(zc + off); }
#pragma unroll
    for (int T = 0; T < 2; ++T) { int kp = pb - r * (16 * T + li); kp = kp < 0 ? 0 : kp;
        const unsigned off = __umul24((unsigned)kp, (unsigned)(NZ * 2)) + (unsigned)((ZKA + 8 * g) * 2);
#pragma unroll
        for (int q = 0; q < 4; ++q) kf[T][q] = *(const bf16x8*)(zc + off + 64 * q); }
}
__device__ __forceinline__ void attn_tile(LAS unsigned char* vimg, const bf16_t* Z, bf16_t* MIX, int b, int h, int p0c, int lane) {
    const int li = lane & 15, g = lane >> 4;
    const int qpos = p0c + 16 * li, pmax = p0c + 240;
    const bf16_t* zb = Z + (size_t)b * SEQ * NZ + h * 128;
    const char* zc = (const char*)zb;
    bf16x8 qf[4];
#pragma unroll
    for (int s = 0; s < 4; ++s) qf[s] = *(const bf16x8*)(zb + (size_t)qpos * NZ + ZQA + 32 * s + 8 * g);
    f32x4 o[8];
#pragma unroll
    for (int d = 0; d < 8; ++d) o[d] = (f32x4){0.f, 0.f, 0.f, 0.f};
    float m = -INFINITY, l = 0.f;
    bf16x8 kA[2][4], kB[2][4]; u32x4 vA[8], vB[8];
    auto step = [&](int s, bf16x8 (&kf)[2][4], u32x4 (&vv)[8], bf16x8 (&kn)[2][4], u32x4 (&vn)[8]) __attribute__((always_inline)) {
        if (s + 1 < 23) attn_blk_load(zc, pmax, s + 1, lane, kn, vn);
        int r, w, blk; attn_blk_cfg(s, r, w, blk);
        f32x4 st[2];
#pragma unroll
        for (int T = 0; T < 2; ++T) { st[T] = (f32x4){0.f, 0.f, 0.f, 0.f};
#pragma unroll
            for (int q = 0; q < 4; ++q) st[T] = __builtin_amdgcn_mfma_f32_16x16x32_bf16(kf[T][q], qf[q], st[T], 0, 0, 0); }
        const int sh = (r == 1) ? 0 : (r == 4) ? 2 : 4, off16 = 16 * (15 - li);
        const int nlo = (off16 + r - 1) >> sh; int nhi = (w + off16) >> sh; { const int nb = pmax >> sh; nhi = nhi < nb ? nhi : nb; }
        float bm = -INFINITY;
#pragma unroll
        for (int T = 0; T < 2; ++T)
#pragma unroll
            for (int rg = 0; rg < 4; ++rg) { const int n = 32 * blk + 16 * T + 4 * g + rg; const bool ok = (n >= nlo) && (n <= nhi);
                st[T][rg] = ok ? st[T][rg] : -INFINITY; bm = fmaxf(bm, st[T][rg]); }
        bm = fmaxf(bm, __shfl_xor(bm, 16)); bm = fmaxf(bm, __shfl_xor(bm, 32));
        const float mn = fmaxf(m, bm), mu = (mn == -INFINITY) ? 0.f : mn;
        const float alpha = __expf(m - mu);
        float ps = 0.f; f32x4 p[2];
#pragma unroll
        for (int T = 0; T < 2; ++T)
#pragma unroll
            for (int rg = 0; rg < 4; ++rg) { p[T][rg] = __expf(st[T][rg] - mu); ps += p[T][rg]; }
        l = l * alpha + ps;
        if (!__all(mn == m)) {
#pragma unroll
            for (int d = 0; d < 8; ++d) o[d] *= alpha; }
        m = mn;
        bf16x8 pf; { const unsigned w0 = cvt_pk_bf16(p[0][0], p[0][1]), w1 = cvt_pk_bf16(p[0][2], p[0][3]), w2 = cvt_pk_bf16(p[1][0], p[1][1]), w3 = cvt_pk_bf16(p[1][2], p[1][3]);
            pf[0] = (short)(w0 & 0xffff); pf[1] = (short)(w0 >> 16); pf[2] = (short)(w1 & 0xffff); pf[3] = (short)(w1 >> 16); pf[4] = (short)(w2 & 0xffff); pf[5] = (short)(w2 >> 16); pf[6] = (short)(w3 & 0xffff); pf[7] = (short)(w3 >> 16); }
        asm volatile("" ::: "memory");
#pragma unroll
        for (int it = 0; it < 8; ++it) { const int ci = it * 64 + lane, key = ci >> 4, part = ci & 15; *(LAS u32x4*)(vimg + key * AT_VS + 16 * part) = vv[it]; }
        asm volatile("" ::: "memory");
#pragma unroll
        for (int d = 0; d < 8; ++d) { const LAS unsigned char* vp = vimg + (4 * g + (li >> 2)) * AT_VS + (16 * d + 4 * (li & 3)) * 2;
            const bf16x8 af = cat8(vtr(vp), vtr(vp + 16 * AT_VS));
            o[d] = __builtin_amdgcn_mfma_f32_16x16x32_bf16(af, pf, o[d], 0, 0, 0); }
        asm volatile("" ::: "memory");
    };
    attn_blk_load(zc, pmax, 0, lane, kA, vA);
#pragma unroll 1
    for (int s = 0; s < 22; s += 2) { step(s, kA, vA, kB, vB); step(s + 1, kB, vB, kA, vA); }
    step(22, kA, vA, kB, vB);
    l += __shfl_xor(l, 16); l += __shfl_xor(l, 32);
    const float inv = 1.0f / l;
    bf16_t* mp = MIX + ((size_t)b * SEQ + qpos) * DM + h * 128 + 4 * g;
#pragma unroll
    for (int d = 0; d < 8; ++d) { u32x2 w; w.x = cvt_pk_bf16(o[d][0] * inv, o[d][1] * inv); w.y = cvt_pk_bf16(o[d][2] * inv, o[d][3] * inv); *(u32x2*)(mp + 16 * d) = w; }
}
__device__ __forceinline__ void attn_unit(LAS unsigned char* lds, const bf16_t* Z, bf16_t* MIX, int unit) {
    int tid = threadIdx.x; asm volatile("" : "+v"(tid)); const int wid = __builtin_amdgcn_readfirstlane(tid >> 6), lane = tid & 63;
    const int qb = unit & 15, h = (unit >> 4) & 7, b = unit >> 7;
    LAS unsigned char* vimg = lds + wid * (32 * AT_VS);
    attn_tile(vimg, Z, MIX, b, h, 256 * qb + wid, lane);
    attn_tile(vimg, Z, MIX, b, h, 256 * qb + wid + 8, lane);
}

__device__ __forceinline__ const float* sattn_row(int e, const float* fresh, const float* cache) {
    const int cfg = e / 129, j = e - cfg * 129, r = (cfg == 0) ? 1 : (cfg == 1) ? 4 : 16, dist = j * r;
    return (dist == 0) ? fresh : cache + (size_t)(2048 - dist) * 1024;
}
__device__ __forceinline__ void sattn_unit(LAS unsigned char* lds, const bf16_t* Z, const float* ck, const float* cv, const float* out, bf16_t* MIX, int unit) {
    int tid = threadIdx.x; asm volatile("" : "+v"(tid)); const int wid = __builtin_amdgcn_readfirstlane(tid >> 6), lane = tid & 63, hl = lane & 31, hf = lane >> 5;
    const int b = unit >> 3, h = unit & 7;
    LAS float* sc = (LAS float*)lds;
    LAS float* red = sc + 400;
    LAS float* misc = red + 2048;
    const u32x2 qw = *(const u32x2*)(Z + (size_t)(MP + b) * NZ + ZQA + h * 128 + 4 * hl);
    const f32x4 q4 = (f32x4){bf_lo(qw.x), bf_hi(qw.x), bf_lo(qw.y), bf_hi(qw.y)};
    const float* knew = out + O_KS + (size_t)b * 1024 + h * 128; const float* vnew = out + O_VS + (size_t)b * 1024 + h * 128;
    const float* ckb = ck + (size_t)b * 2048 * 1024 + h * 128; const float* cvb = cv + (size_t)b * 2048 * 1024 + h * 128;
    constexpr int SN = 25;
    f32x4 kv[SN], vv[SN];
#pragma unroll
    for (int i = 0; i < SN; ++i) { int e = 16 * i + 2 * wid + hf; e = e < 387 ? e : 386; kv[i] = *(const f32x4*)(sattn_row(e, knew, ckb) + 4 * hl); }
#pragma unroll
    for (int i = 0; i < SN; ++i) { int e = 16 * i + 2 * wid + hf; e = e < 387 ? e : 386; vv[i] = *(const f32x4*)(sattn_row(e, vnew, cvb) + 4 * hl); }
#pragma unroll
    for (int i = 0; i < SN; ++i) { float s = (q4[0] * kv[i][0] + q4[1] * kv[i][1]) + (q4[2] * kv[i][2] + q4[3] * kv[i][3]);
        s += __shfl_xor(s, 1); s += __shfl_xor(s, 2); s += __shfl_xor(s, 4); s += __shfl_xor(s, 8); s += __shfl_xor(s, 16);
        const int e = 16 * i + 2 * wid + hf; if (hl == 0 && e < 387) sc[e] = s; }
    __syncthreads();
    if (wid == 0) { float mx = -INFINITY; for (int e = lane; e < 387; e += 64) mx = fmaxf(mx, sc[e]); mx = wave_max(mx);
        float sm = 0.f; for (int e = lane; e < 387; e += 64) { const float p = __expf(sc[e] - mx); sc[e] = p; sm += p; } sm = wave_sum(sm);
        if (lane == 0) misc[1] = sm; }
    __syncthreads();
    f32x4 acc = (f32x4){0.f, 0.f, 0.f, 0.f};
#pragma unroll
    for (int i = 0; i < SN; ++i) { const int e = 16 * i + 2 * wid + hf; const float p = (e < 387) ? sc[e] : 0.f; acc += vv[i] * p; }
    *(LAS f32x4*)(red + (2 * wid + hf) * 128 + 4 * hl) = acc;
    __syncthreads();
    if (tid < 128) { float s = 0.f;
#pragma unroll
        for (int w = 0; w < 16; ++w) s += red[w * 128 + tid];
        const float v = s / misc[1]; MIX[(size_t)(MP + b) * DM + h * 128 + tid] = (bf16_t)(cvt_pk_bf16(v, 0.f) & 0xffffu); }
    __syncthreads();
}

__device__ __forceinline__ void smlstm_unit(LAS unsigned char* lds, const bf16_t* Z, const float* GT, const float* sC, const float* sN, const float* sM, const float* mhg, float* out, bf16_t* MIX, float* HRAW, int unit) {
    int tid = threadIdx.x; asm volatile("" : "+v"(tid)); const int wid = __builtin_amdgcn_readfirstlane(tid >> 6), lane = tid & 63;
    const int b = unit / NH, h = unit % NH, row = MP + b;
    LAS float* qs = (LAS float*)lds; LAS float* ks = qs + 256; LAS float* red = ks + 256;
    LAS float* part = red + 32;
    const bf16_t* zr = Z + (size_t)row * NZ;
    const float liv = GT[(size_t)h * MT + row], lf = GT[(size_t)(6 + h) * MT + row], m0 = sM[b * NH + h];
    const float mt = fmaxf(lf + m0, liv), a = __expf(lf + m0 - mt), wsv = __expf(liv - mt);
    float pq = 0.f, pn = 0.f;
    if (tid < 256) { const float q = bf1(zr[ZQM + h * DK + tid]), k = bf1(zr[ZKM + h * DK + tid]), n0 = sN[(size_t)(b * NH + h) * DK + tid]; qs[tid] = q; ks[tid] = k; pq = q * k; pn = q * n0;
        out[O_NS + (size_t)(b * NH + h) * DK + tid] = a * n0 + wsv * k; }
    pq = wave_sum(pq); pn = wave_sum(pn);
    if (lane == 0) { red[wid] = pq; red[8 + wid] = pn; }
    __syncthreads();
    const float qk = red[0] + red[1] + red[2] + red[3], qn = red[8] + red[9] + red[10] + red[11];
    const float sw = qk * wsv;
    {
      const int dq = tid >> 7, dv0 = 4 * (tid & 127);
      const u32x2 vw = *(const u32x2*)(zr + ZVM + h * DV + dv0); const f32x4 v4 = (f32x4){bf_lo(vw.x), bf_hi(vw.x), bf_lo(vw.y), bf_hi(vw.y)} * wsv;
      const float* cp = sC + ((size_t)(b * NH + h) * DK + 64 * dq) * DV + dv0; float* co = out + O_CS + ((size_t)(b * NH + h) * DK + 64 * dq) * DV + dv0;
      f32x4 numi = (f32x4){0.f, 0.f, 0.f, 0.f};
#pragma unroll 1
      for (int d0 = 0; d0 < 64; d0 += 8) { f32x4 cc[8];
#pragma unroll
          for (int i = 0; i < 8; ++i) cc[i] = *(const f32x4*)(cp + (size_t)(d0 + i) * DV);
#pragma unroll
          for (int i = 0; i < 8; ++i) { numi += cc[i] * qs[64 * dq + d0 + i]; *(f32x4*)(co + (size_t)(d0 + i) * DV) = cc[i] * a + v4 * ks[64 * dq + d0 + i]; } }
      *(LAS f32x4*)(part + dq * 512 + dv0) = numi; }
    __syncthreads();
    const float v = bf1(zr[ZVM + h * DV + tid]);
    const float numt = part[tid] + part[512 + tid] + part[1024 + tid] + part[1536 + tid];
    const float num = sw * v + a * numt, den = sw + a * qn;
    const float hv = num / fmaxf(fabsf(den), __expf(-mt));
    if (HRAW) HRAW[(size_t)row * 3072 + h * DV + tid] = hv;
    const float ssq = wave_sum(hv * hv);
    if (lane == 0) red[16 + wid] = ssq;
    __syncthreads();
    float tot = 0.f;
#pragma unroll
    for (int w = 0; w < 8; ++w) tot += red[16 + w];
    const float om = bf1(zr[ZOM + h * DV + tid]);
    const float y = hv * rsqrtf(tot * (1.0f / DV) + EPS) * mhg[h * DV + tid] * (1.0f / (1.0f + __expf(-om)));
    MIX[(size_t)row * DM + 1024 + h * DV + tid] = (bf16_t)(cvt_pk_bf16(y, 0.f) & 0xffffu);
    if (tid == 0) out[O_MS + b * NH + h] = mt;
    __syncthreads();
}

constexpr int OB_QS = 528, OB_Q = 0, OB_K = 33792, OB_V0 = 67584, OB_V1 = 101376, OB_SW = 135168, OB_SWS = 144, OB_SM = 144384;
__device__ __forceinline__ void mlstm_out(LAS unsigned char* lds, const bf16_t* Z, const bf16_t* CT, const float* NC, const float* TB, const float* TWV, const float* TMT, const float* CM, const float* mhg, bf16_t* MIX, float* HRAW, int unit) {
    int tid = threadIdx.x; asm volatile("" : "+v"(tid)); const int wid = __builtin_amdgcn_readfirstlane(tid >> 6), lane = tid & 63, li = lane & 15, g = lane >> 4;
    const int bh = unit >> 6, c = unit & 63, b = bh / NH, h = bh % NH;
    LAS float* rs = (LAS float*)(lds + OB_SM); LAS float* dn = rs + 64; LAS float* hs = dn + 64; LAS float* ub = hs + 64; LAS float* wvv = ub + 64; LAS float* av = wvv + 64; LAS float* em = av + 64;
    const size_t row0 = (size_t)b * SEQ + 64 * c;
    const unsigned char* ctb = (const unsigned char*)CT + ((size_t)(bh * NCH + c) * DV + 64 * wid + li) * DK + 16 * g;
    u32x4 cf[4][4];
#pragma unroll
    for (int j = 0; j < 4; ++j)
#pragma unroll
        for (int vt = 0; vt < 4; ++vt) cf[j][vt] = *(const u32x4*)(ctb + (size_t)(16 * vt) * DK + 64 * j);
#pragma unroll
    for (int q = 0; q < 4; ++q) { const int ch = tid + 512 * q, tok = ch >> 5, c16 = ch & 31; const bf16_t* zr = Z + (row0 + tok) * NZ;
        *(LAS u32x4*)(lds + OB_Q + tok * OB_QS + 16 * c16) = *(const u32x4*)(zr + ZQM + h * DK + 8 * c16);
        *(LAS u32x4*)(lds + OB_K + tok * OB_QS + 16 * c16) = *(const u32x4*)(zr + ZKM + h * DK + 8 * c16); }
#pragma unroll
    for (int q = 0; q < 8; ++q) { const int ch = tid + 512 * q, tok = ch >> 6, c16 = ch & 63; const bf16_t* zr = Z + (row0 + tok) * NZ;
        *(LAS u32x4*)(lds + ((c16 >> 5) ? OB_V1 : OB_V0) + tok * OB_QS + 16 * (c16 & 31)) = *(const u32x4*)(zr + ZVM + h * DV + 8 * c16); }
    if (tid < 64) { const int t = bh * SEQ + 64 * c + tid; const float bb = TB[t], mt = TMT[t];
        ub[tid] = bb - mt; wvv[tid] = TWV[t]; av[tid] = __expf(bb + CM[bh * 80 + c] - mt); em[tid] = __expf(-mt); rs[tid] = 0.f; hs[tid] = 0.f; }
    __syncthreads();
    { const int t = tid >> 3, part = tid & 7; const float* np = NC + (size_t)(bh * NCH + c) * DK + 32 * part; const LAS bf16_t* qp = (const LAS bf16_t*)(lds + OB_Q + t * OB_QS) + 32 * part; float s = 0.f;
#pragma unroll 8
      for (int e = 0; e < 32; ++e) s += bf1(qp[e]) * np[e];
      s += __shfl_xor(s, 1); s += __shfl_xor(s, 2); s += __shfl_xor(s, 4);
      if (part == 0) dn[t] = s; }
    { const int st = wid & 3;
#pragma unroll
      for (int tq = 0; tq < 2; ++tq) { const int tt = 2 * (wid >> 2) + tq; f32x4 d = (f32x4){0.f, 0.f, 0.f, 0.f};
#pragma unroll
          for (int kk = 0; kk < 8; ++kk) { const bf16x8 kf = *(const LAS bf16x8*)(lds + OB_K + (16 * st + li) * OB_QS + (32 * kk + 8 * g) * 2);
              const bf16x8 qf = *(const LAS bf16x8*)(lds + OB_Q + (16 * tt + li) * OB_QS + (32 * kk + 8 * g) * 2);
              d = __builtin_amdgcn_mfma_f32_16x16x32_bf16(kf, qf, d, 0, 0, 0); }
          const int t = 16 * tt + li; const float ut = ub[t]; float ps = 0.f; f32x4 sw;
#pragma unroll
          for (int r = 0; r < 4; ++r) { const int s = 16 * st + 4 * g + r; const float w = (s <= t) ? d[r] * __expf(ut + wvv[s]) : 0.f; sw[r] = w; ps += w; }
          u32x2 pk; pk.x = cvt_pk_bf16(sw[0], sw[1]); pk.y = cvt_pk_bf16(sw[2], sw[3]);
          *(LAS u32x2*)(lds + OB_SW + t * OB_SWS + (16 * st + 4 * g) * 2) = pk;
          lds_addf(rs + t, ps); } }
    __syncthreads();
    f32x4 acc[4][4];
#pragma unroll
    for (int a = 0; a < 4; ++a)
#pragma unroll
        for (int t = 0; t < 4; ++t) acc[a][t] = (f32x4){0.f, 0.f, 0.f, 0.f};
#pragma unroll
    for (int j = 0; j < 4; ++j)
#pragma unroll
        for (int s = 0; s < 2; ++s) {
            bf16x8 bq[4], af[4];
#pragma unroll
            for (int tt = 0; tt < 4; ++tt) bq[tt] = *(const LAS bf16x8*)(lds + OB_Q + (16 * tt + li) * OB_QS + (64 * j + 16 * g + 8 * s) * 2);
#pragma unroll
            for (int vt = 0; vt < 4; ++vt) { const unsigned d0 = s ? cf[j][vt].z : cf[j][vt].x, d1 = s ? cf[j][vt].w : cf[j][vt].y;
                const f32x2 p0 = __builtin_amdgcn_cvt_pk_f32_fp8((int)d0, false), p1 = __builtin_amdgcn_cvt_pk_f32_fp8((int)d0, true), p2 = __builtin_amdgcn_cvt_pk_f32_fp8((int)d1, false), p3 = __builtin_amdgcn_cvt_pk_f32_fp8((int)d1, true);
                const unsigned w0 = cvt_pk_bf16(p0.x, p0.y), w1 = cvt_pk_bf16(p1.x, p1.y), w2 = cvt_pk_bf16(p2.x, p2.y), w3 = cvt_pk_bf16(p3.x, p3.y);
                bf16x8 f; f[0] = (short)(w0 & 0xffff); f[1] = (short)(w0 >> 16); f[2] = (short)(w1 & 0xffff); f[3] = (short)(w1 >> 16); f[4] = (short)(w2 & 0xffff); f[5] = (short)(w2 >> 16); f[6] = (short)(w3 & 0xffff); f[7] = (short)(w3 >> 16);
                af[vt] = f; }
#pragma unroll
            for (int vt = 0; vt < 4; ++vt)
#pragma unroll
                for (int tt = 0; tt < 4; ++tt) acc[vt][tt] = __builtin_amdgcn_mfma_f32_16x16x32_bf16(af[vt], bq[tt], acc[vt][tt], 0, 0, 0);
        }
#pragma unroll
    for (int tt = 0; tt < 4; ++tt) { const float at = av[16 * tt + li];
#pragma unroll
        for (int vt = 0; vt < 4; ++vt) acc[vt][tt] *= at; }
    { const LAS unsigned char* vb = lds + ((wid >> 2) ? OB_V1 : OB_V0);
#pragma unroll
      for (int kb = 0; kb < 2; ++kb) {
          bf16x8 bs_[4];
#pragma unroll
          for (int tt = 0; tt < 4; ++tt) bs_[tt] = *(const LAS bf16x8*)(lds + OB_SW + (16 * tt + li) * OB_SWS + (32 * kb + 8 * g) * 2);
#pragma unroll
          for (int vt = 0; vt < 4; ++vt) { const LAS unsigned char* vp = vb + (32 * kb + 8 * g + (li >> 2)) * OB_QS + (64 * (wid & 3) + 16 * vt + 4 * (li & 3)) * 2;
              const bf16x8 af = cat8(vtr(vp), vtr(vp + 4 * OB_QS));
#pragma unroll
              for (int tt = 0; tt < 4; ++tt) acc[vt][tt] = __builtin_amdgcn_mfma_f32_16x16x32_bf16(af, bs_[tt], acc[vt][tt], 0, 0, 0); } } }
    u32x2 omw[4][4]; f32x4 gg[4];
#pragma unroll
    for (int vt = 0; vt < 4; ++vt) { const int dvg = h * DV + 64 * wid + 16 * vt + 4 * g; gg[vt] = *(const f32x4*)(mhg + dvg);
#pragma unroll
        for (int tt = 0; tt < 4; ++tt) omw[tt][vt] = *(const u32x2*)(Z + (row0 + 16 * tt + li) * NZ + ZOM + dvg); }
    float dd[4];
#pragma unroll
    for (int tt = 0; tt < 4; ++tt) { const int t = 16 * tt + li; const float den = rs[t] + av[t] * dn[t]; dd[tt] = fmaxf(fabsf(den), em[t]);
        float q = 0.f;
#pragma unroll
        for (int vt = 0; vt < 4; ++vt) q += (acc[vt][tt][0] * acc[vt][tt][0] + acc[vt][tt][1] * acc[vt][tt][1]) + (acc[vt][tt][2] * acc[vt][tt][2] + acc[vt][tt][3] * acc[vt][tt][3]);
        q += __shfl_xor(q, 16); q += __shfl_xor(q, 32);
        if (g == 0) lds_addf(hs + t, q); }
    __syncthreads();
#pragma unroll
    for (int tt = 0; tt < 4; ++tt) { const int t = 16 * tt + li; const float idd = __builtin_amdgcn_rcpf(dd[tt]); const float tot = idd * rsqrtf(hs[t] * idd * idd * (1.0f / DV) + EPS);
        const size_t row = row0 + t;
#pragma unroll
        for (int vt = 0; vt < 4; ++vt) { const int dvg = h * DV + 64 * wid + 16 * vt + 4 * g;
            const u32x2 ow = omw[tt][vt];
            const float o0 = bf_lo(ow.x), o1 = bf_hi(ow.x), o2 = bf_lo(ow.y), o3 = bf_hi(ow.y);
            const f32x4 a4 = acc[vt][tt];
            if (HRAW) *(f32x4*)(HRAW + row * 3072 + dvg) = a4 * idd;
            const float y0 = a4[0] * tot * gg[vt][0] * __builtin_amdgcn_rcpf(1.0f + __expf(-o0)), y1 = a4[1] * tot * gg[vt][1] * __builtin_amdgcn_rcpf(1.0f + __expf(-o1)), y2 = a4[2] * tot * gg[vt][2] * __builtin_amdgcn_rcpf(1.0f + __expf(-o2)), y3 = a4[3] * tot * gg[vt][3] * __builtin_amdgcn_rcpf(1.0f + __expf(-o3));
            u32x2 w; w.x = cvt_pk_bf16(y0, y1); w.y = cvt_pk_bf16(y2, y3); *(u32x2*)(MIX + row * DM + 1024 + dvg) = w; } }
    __syncthreads();
}


constexpr int CV_OUT = (DM / 128) * (DM / 256), CV_UP = (DM / 128) * (DFF / 256), CV_DN = (DFF / 128) * (DM / 256);
__device__ __forceinline__ void conv_unit(LAS unsigned char* lds, const float* wout, const float* wup, const float* wdn, const float* g2, bf16_t* WoutT, bf16_t* WupT, bf16_t* WdnT, int j) {
    int base = 4 * j;
    if (base < CV_OUT) trw_run(lds, wout, DM, DM, DM, WoutT, nullptr, base, 4, 1);
    else if (base < CV_OUT + CV_UP) trw_run(lds, wup, DFF, DM, DFF, WupT, g2, base - CV_OUT, 4, 1);
    else trw_run(lds, wdn, DM, DFF, DM, WdnT, nullptr, base - CV_OUT - CV_UP, 4, 1);
}

struct Args { const float* in[16]; float* out; unsigned char* ws; };
#if CHECKS
__device__ __forceinline__ unsigned hsh(unsigned x) { x ^= x >> 16; x *= 0x7feb352dU; x ^= x >> 15; x *= 0x846ca68bU; x ^= x >> 16; return x; }
__device__ __forceinline__ bool far_(float got, float ref, float rel, float ab) { return !(fabsf(got - ref) <= rel * fabsf(ref) + ab); }
#define CHK_FAIL(id) atomicMax(ctl + CW_ERR, 40u - (unsigned)(id))
#define CHK_CODE(cd) atomicMax(ctl + CW_ERR, (unsigned)(cd))
__device__ __forceinline__ float dot_bf(const bf16_t* a, const bf16_t* b, int n) { float s = 0.f; for (int k = 0; k < n; k += 8) { const u32x4 x = *(const u32x4*)(a + k), y = *(const u32x4*)(b + k);
        s += bf_lo(x.x) * bf_lo(y.x) + bf_hi(x.x) * bf_hi(y.x) + bf_lo(x.y) * bf_lo(y.y) + bf_hi(x.y) * bf_hi(y.y) + bf_lo(x.z) * bf_lo(y.z) + bf_hi(x.z) * bf_hi(y.z) + bf_lo(x.w) * bf_lo(y.w) + bf_hi(x.w) * bf_hi(y.w); } return s; }
__device__ __forceinline__ float softcap_(float a) { return 15.0f * tanhf(a * (1.0f / 15.0f)); }
__device__ __forceinline__ float logsig_(float a) { return fminf(a, 0.f) - log1pf(expf(-fabsf(a))); }
__device__ void run_checks(const Args& args, LAS unsigned char* lds) {
    const int tid = threadIdx.x, lane = tid & 63, wid = tid >> 6, bx = blockIdx.x, G = gridDim.x;
    const unsigned gt = (unsigned)bx * 512u + tid, ngt = (unsigned)G * 512u;
    unsigned char* ws = args.ws; unsigned* ctl = (unsigned*)(ws + WS_CTL); float* out = args.out;
    const float* x_prompt = args.in[0]; const float* x_sample = args.in[1]; const float* cache_k = args.in[2]; const float* cache_v = args.in[3]; const float* state_C = args.in[4]; const float* state_n = args.in[5]; const float* state_m = args.in[6];
    const float* norm1_g = args.in[7]; const float* w_in = args.in[8]; const float* b_if = args.in[9]; const float* mh_g = args.in[10];
    const float* w_out = args.in[11]; const float* norm2_g = args.in[12]; const float* w_up = args.in[13]; const float* w_down = args.in[14]; const float* final_g = args.in[15];
    const bf16_t* WinT = (bf16_t*)(ws + WS_WIN); const bf16_t* WoutT = (bf16_t*)(ws + WS_WOUT); const bf16_t* WupT = (bf16_t*)(ws + WS_WUP); const bf16_t* WdnT = (bf16_t*)(ws + WS_WDN);
    const bf16_t* XN = (bf16_t*)(ws + WS_XN); const bf16_t* Z = (bf16_t*)(ws + WS_Z); const bf16_t* MIX = (bf16_t*)(ws + WS_MIX); const float* H = (float*)(ws + WS_H); const bf16_t* HB = (bf16_t*)(ws + WS_HB);
    const bf16_t* U = (bf16_t*)(ws + WS_U); const bf16_t* WG = (bf16_t*)(ws + WS_WG); const float* GT = (float*)(ws + WS_G); const float* HRAW = (float*)(ws + WS_HRAW);
    const float* RSS2 = (float*)(ws + WS_CTL + CTL_RSS2); const float* RSS3 = (float*)(ws + WS_CTL + CTL_RSS3);
    for (unsigned s = gt; s < 2048u; s += ngt) { const int row = (s < 64u) ? MP + (int)(s & 31u) : (int)(hsh(s) % MT), k = (int)(hsh(s + 99991u) % DM);
        const float* xr = row < MP ? x_prompt + (size_t)row * DM : x_sample + (size_t)(row - MP) * DM; float ss = 0.f; for (int j = 0; j < DM; ++j) ss += xr[j] * xr[j];
        const float ref = xr[k] * rsqrtf(ss * (1.0f / DM) + EPS) * norm1_g[k]; if (far_(bf1(XN[(size_t)row * DM + k]), ref, 0.01f, 1e-3f)) CHK_FAIL(1); }
    for (unsigned s = gt; s < 4096u; s += ngt) { const unsigned a = hsh(s), b = hsh(s + 7777u);
        { const int n = a % NZ, k = b % DM; if (far_(bf1(WinT[(size_t)n * DM + k]), w_in[(size_t)k * NINF + n], 0.01f, 1e-7f)) CHK_FAIL(2); }
        { const int n = a % DM, k = b % DM; if (far_(bf1(WoutT[(size_t)n * DM + k]), w_out[(size_t)k * DM + n], 0.01f, 1e-7f)) CHK_FAIL(2); }
        { const int f = a % DFF, k = b % DM; if (far_(bf1(WupT[(size_t)f * DM + k]), w_up[(size_t)k * DFF + f] * norm2_g[k], 0.01f, 1e-7f)) CHK_FAIL(2); }
        { const int n = a % DM, f = b % DFF; if (far_(bf1(WdnT[(size_t)n * DFF + f]), w_down[(size_t)f * DM + n], 0.01f, 1e-7f)) CHK_FAIL(2); }
        { const int gi = a % 16, k = b % DM; const float ref = gi < 12 ? w_in[(size_t)k * NINF + NZ + gi] : 0.f; if (far_(bf1(WG[gi * DM + k]), ref, 0.01f, 1e-7f)) CHK_FAIL(2); } }
    for (unsigned s = gt; s < 8192u; s += ngt) { const int row = (s < 1024u) ? MP + (int)(s & 31u) : (int)(hsh(s) % MP), col = (int)(hsh(s + 12345u) % NZ); const int id = row < MP ? 3 : 4;
        const bf16_t* xr = XN + (size_t)row * DM; float val;
        if (col < 2048) { const int d = col & 127, c1 = (d < 64) ? col : col - 64, c2 = c1 + 64; const float x1 = dot_bf(xr, WinT + (size_t)c1 * DM, DM), x2 = dot_bf(xr, WinT + (size_t)c2 * DM, DM);
            const int pos = row < MP ? (row & (SEQ - 1)) : 8192, i = d & 63; double invd = 1.0; for (int e = 0; e < i; ++e) invd *= 0.86596432336006535;
            float c, sn; sincos_d((float)pos * (float)invd, c, sn); val = (d < 64) ? x1 * c - x2 * sn : x2 * c + x1 * sn; if (col < 1024) val *= 0.08838834764831845f; }
        else { val = dot_bf(xr, WinT + (size_t)col * DM, DM); if (col >= ZQM && col < ZKM) val *= 0.0625f; }
        if (far_(bf1(Z[(size_t)row * NZ + col]), val, 0.02f, 0.02f)) CHK_FAIL(id);
        if (col >= 1024 && col < 3072) { const int cc = col & 1023; const bool isk = col < 2048;
            if (row >= MP) { if (far_(out[(isk ? O_KS : O_VS) + (size_t)(row - MP) * 1024 + cc], val, 0.01f, 0.01f)) CHK_FAIL(id); }
            else { const int pos = row & (SEQ - 1), bb = row >> 12; if (pos >= 2048) { if (far_(out[(isk ? O_KP : O_VP) + ((size_t)(bb * 2048 + pos - 2048)) * 1024 + cc], val, 0.01f, 0.01f)) CHK_FAIL(id); } } } }
    for (unsigned s = gt; s < 4096u; s += ngt) { const int gi = (int)(hsh(s) % 12), tok = (s < 256u) ? MP + (int)(s & 31u) : (int)(hsh(s + 555u) % MT);
        float v = softcap_(dot_bf(XN + (size_t)tok * DM, WG + (size_t)gi * DM, DM) + b_if[gi]); if (gi >= 6) v = logsig_(v);
        if (far_(GT[(size_t)gi * MT + tok], v, 0.01f, 0.005f)) CHK_FAIL(5); }
    for (unsigned s = gt; s < 4096u; s += ngt) { const unsigned a = hsh(s), b2 = hsh(s + 424242u); const int b = a & 1, pos = (s & 3u) == 0u ? (int)((a >> 1) % 300u) : (int)((a >> 1) % SEQ), h = b2 & 7, d = (b2 >> 3) & 127;
        const bf16_t* zb = Z + (size_t)b * SEQ * NZ; const bf16_t* qr = zb + (size_t)pos * NZ + ZQA + h * 128; float m = -INFINITY, l = 0.f, o = 0.f;
        for (int cfg = 0; cfg < 3; ++cfg) { const int r = cfg == 0 ? 1 : cfg == 1 ? 4 : 16;
            for (int j = 0; j <= 128; ++j) { const int kp = pos - j * r; if (kp < 0) break; const float sc = dot_bf(qr, zb + (size_t)kp * NZ + ZKA + h * 128, 128);
                const float mn = fmaxf(m, sc), al = expf(m - mn), p = expf(sc - mn); l = l * al + p; o = o * al + p * bf1(zb[(size_t)kp * NZ + ZVA + h * 128 + d]); m = mn; } }
        if (far_(bf1(MIX[((size_t)b * SEQ + pos) * DM + h * 128 + d]), o / l, 0.03f, 0.004f)) CHK_FAIL(6); }
    if (bx == 30) { const int li = lane & 15, g = lane >> 4, dvt = wid & 3, dkh = wid >> 2; LAS unsigned char* Kimg = lds + SC_KIMG; LAS unsigned char* Vimg = lds + SC_VIMG;
#pragma unroll
        for (int q = 0; q < 4; ++q) { const int ch = tid + 512 * q, tok = ch >> 5, c16 = ch & 31; *(LAS u32x4*)(Kimg + tok * SC_KSTR + 16 * c16) = *(const u32x4*)(Z + (size_t)tok * NZ + ZKM + 8 * c16); }
        { const int tok = tid >> 3, c16 = tid & 7; *(LAS u32x4*)(Vimg + tok * SC_VSTR + 16 * c16) = *(const u32x4*)(Z + (size_t)tok * NZ + ZVM + 8 * c16); }
        __syncthreads();
        bf16x8 ones;
#pragma unroll
        for (int e = 0; e < 8; ++e) ones[e] = (short)0x3F80;
        unsigned mask = 0u;
#pragma unroll 1
        for (int T = 0; T < 8; ++T) { f32x4 na = (f32x4){0.f, 0.f, 0.f, 0.f}, ca = (f32x4){0.f, 0.f, 0.f, 0.f};
#pragma unroll
            for (int kb = 0; kb < 2; ++kb) { const LAS unsigned char* vp = Vimg + (32 * kb + 8 * g + (li >> 2)) * SC_VSTR + (16 * dvt + 4 * (li & 3)) * 2; const bf16x8 Bf = cat8(vtr(vp), vtr(vp + 4 * SC_VSTR));
                const LAS unsigned char* kp = Kimg + (32 * kb + 8 * g + (li >> 2)) * SC_KSTR + (128 * dkh + 16 * T + 4 * (li & 3)) * 2; const bf16x8 Af = cat8(vtr(kp), vtr(kp + 4 * SC_KSTR));
                na = __builtin_amdgcn_mfma_f32_16x16x32_bf16(Af, ones, na, 0, 0, 0); ca = __builtin_amdgcn_mfma_f32_16x16x32_bf16(Af, Bf, ca, 0, 0, 0); }
#pragma unroll
            for (int r = 0; r < 4; ++r) { const int dk = 128 * dkh + 16 * T + 4 * g + r, dv = 16 * dvt + li; float cs = 0.f, cv = 0.f;
                for (int t = 0; t < 64; ++t) { const float kk = bf1(Z[(size_t)t * NZ + ZKM + dk]); cs += kk; cv += kk * bf1(Z[(size_t)t * NZ + ZVM + dv]); }
                if (far_(na[r], cs, 0.01f, 1e-2f)) mask |= 1u; if (far_(ca[r], cv, 0.01f, 2e-2f)) mask |= 2u; } }
        if (mask) atomicOr(ctl + CW_ERR + 2, mask);
        __syncthreads(); }
    if (gt < 12u) { const int bh = (int)gt, b = bh / NH, h = bh % NH; const float* TBc = (const float*)(ws + WS_TB); const float* TWVc = (const float*)(ws + WS_TWV); const float* TMTc = (const float*)(ws + WS_TMT); const float* CMc = (const float*)(ws + WS_CM);
        float m = 0.f, bsum = 0.f; bool bad = false;
        for (int t = 0; t < SEQ; ++t) { const size_t row = (size_t)b * SEQ + t; const float liv = GT[(size_t)h * MT + row], lf = GT[(size_t)(6 + h) * MT + row];
            if ((t & 63) == 0) { bsum = 0.f; if (far_(CMc[bh * 80 + (t >> 6)], m, 1e-3f, 1e-3f)) bad = true; }
            bsum += lf; m = fmaxf(lf + m, liv);
            if (far_(TBc[bh * SEQ + t], bsum, 1e-3f, 1e-3f) || far_(TWVc[bh * SEQ + t], liv - bsum, 1e-3f, 1e-3f) || far_(TMTc[bh * SEQ + t], m, 1e-3f, 1e-3f)) bad = true; }
        if (far_(CMc[bh * 80 + 64], m, 1e-3f, 1e-3f)) bad = true;
        if (bad) CHK_CODE(33); }
    if (bx < 24) { const int bh = bx % 12, b = bh / NH, h = bh % NH, sel = tid >> 8, dk = tid & 255; const int dv = sel ? (300 + 17 * bx) % DV : (37 + 41 * bx) % DV;
        LAS float* red = (LAS float*)lds;
        float C = 0.f, n = 0.f, m = 0.f, n63 = 0.f, C63 = 0.f; bool bad8 = false;
        for (int t = 0; t < SEQ; ++t) { const size_t row = (size_t)b * SEQ + t; const bf16_t* zr = Z + row * NZ; if (t == 63 * 64) { n63 = n; C63 = C; }
            const float q = bf1(zr[ZQM + h * DK + dk]), k = bf1(zr[ZKM + h * DK + dk]), v = bf1(zr[ZVM + h * DV + dv]), liv = GT[(size_t)h * MT + row], lf = GT[(size_t)(6 + h) * MT + row];
            const float mn = fmaxf(lf + m, liv), f = expf(lf + m - mn), iw = expf(liv - mn); C = f * C + iw * k * v; n = f * n + iw * k; m = mn;
            const float s1 = wave_sum(q * C), s2 = wave_sum(q * n); LAS float* rb = red + (t & 1) * 32;
            if (lane == 0) { rb[wid] = s1; rb[16 + wid] = s2; }
            __syncthreads();
            const int w0 = sel * 4; const float num = rb[w0] + rb[w0 + 1] + rb[w0 + 2] + rb[w0 + 3], qn = rb[16 + w0] + rb[16 + w0 + 1] + rb[16 + w0 + 2] + rb[16 + w0 + 3];
            const float hv = num / fmaxf(fabsf(qn), expf(-m));
            if (dk == 0 && far_(HRAW[row * 3072 + h * DV + dv], hv, 0.04f, 0.03f)) bad8 = true; }
        if (far_(out[O_CP + ((size_t)bh * DK + dk) * DV + dv], C, 0.03f, 0.03f)) CHK_CODE(30);
        if (sel == 0 && far_(out[O_NP + (size_t)bh * DK + dk], n, 0.03f, 0.03f)) CHK_CODE(31);
        if (sel == 0 && far_(((const float*)(ws + WS_NC))[(size_t)(bh * NCH + 63) * DK + dk], n63, 0.03f, 0.03f)) CHK_CODE(31);
        if (far_(bf1(((const bf16_t*)(ws + WS_CT))[((size_t)(bh * NCH + 63) * DV + dv) * DK + dk]), C63, 0.03f, 0.03f)) CHK_CODE(30);
        if (tid == 0 && far_(out[O_MP + bh], m, 0.01f, 0.01f)) CHK_CODE(32);
        if (bad8) CHK_CODE(29);
        __syncthreads(); }
    for (unsigned s = gt; s < 4096u; s += ngt) { const unsigned a = hsh(s), b2 = hsh(s + 31337u); const int row = (s < 128u) ? MP + (int)(s & 31u) : (int)(a % MP), h = b2 % NH, dv = (b2 >> 8) % DV;
        const float* hr = HRAW + (size_t)row * 3072 + h * DV; float ss = 0.f; for (int j = 0; j < DV; ++j) ss += hr[j] * hr[j];
        const float om = bf1(Z[(size_t)row * NZ + ZOM + h * DV + dv]); const float ref = hr[dv] * rsqrtf(ss * (1.0f / DV) + EPS) * mh_g[h * DV + dv] / (1.0f + expf(-om));
        if (far_(bf1(MIX[(size_t)row * DM + 1024 + h * DV + dv]), ref, 0.02f, 0.005f)) CHK_CODE(28); }
    for (unsigned s = gt; s < 2048u; s += ngt) { const unsigned a = hsh(s); const int b = a & 31, h = (a >> 5) & 7, d = (a >> 8) & 127;
        const bf16_t* qr = Z + (size_t)(MP + b) * NZ + ZQA + h * 128; float m = -INFINITY, l = 0.f, o = 0.f;
        for (int cfg = 0; cfg < 3; ++cfg) { const int r = cfg == 0 ? 1 : cfg == 1 ? 4 : 16;
            for (int j = 0; j <= 128; ++j) { const int dist = j * r; const float* kp = dist == 0 ? out + O_KS + (size_t)b * 1024 + h * 128 : cache_k + ((size_t)b * 2048 + 2048 - dist) * 1024 + h * 128;
                const float* vp = dist == 0 ? out + O_VS + (size_t)b * 1024 + h * 128 : cache_v + ((size_t)b * 2048 + 2048 - dist) * 1024 + h * 128;
                float sc = 0.f; for (int e = 0; e < 128; ++e) sc += bf1(qr[e]) * kp[e];
                const float mn = fmaxf(m, sc), al = expf(m - mn), p = expf(sc - mn); l = l * al + p; o = o * al + p * vp[d]; m = mn; } }
        if (far_(bf1(MIX[(size_t)(MP + b) * DM + h * 128 + d]), o / l, 0.02f, 0.004f)) CHK_CODE(27); }
    for (unsigned s = gt; s < 2048u; s += ngt) { const unsigned a = hsh(s), b2 = hsh(s + 99u); const int b = a & 31, h = (a >> 5) % NH, dv = (a >> 9) % DV, dkx = b2 % DK; const int row = MP + b; const bf16_t* zr = Z + (size_t)row * NZ;
        const float liv = GT[(size_t)h * MT + row], lf = GT[(size_t)(6 + h) * MT + row], m0 = state_m[b * NH + h]; const float mt = fmaxf(lf + m0, liv), aa = expf(lf + m0 - mt), wsv = expf(liv - mt);
        const float* c0 = state_C + (size_t)(b * NH + h) * DK * DV; const float* n0 = state_n + (size_t)(b * NH + h) * DK; float qk = 0.f, qn = 0.f, qc = 0.f;
        for (int k = 0; k < DK; ++k) { const float q = bf1(zr[ZQM + h * DK + k]); qk += q * bf1(zr[ZKM + h * DK + k]); qn += q * n0[k]; qc += q * c0[(size_t)k * DV + dv]; }
        const float v = bf1(zr[ZVM + h * DV + dv]), sw = qk * wsv, num = sw * v + aa * qc, den = sw + aa * qn, hv = num / fmaxf(fabsf(den), expf(-mt));
        if (far_(HRAW[(size_t)row * 3072 + h * DV + dv], hv, 0.02f, 0.005f)) CHK_CODE(26);
        const float kx = bf1(zr[ZKM + h * DK + dkx]);
        if (far_(out[O_CS + ((size_t)(b * NH + h) * DK + dkx) * DV + dv], aa * c0[(size_t)dkx * DV + dv] + wsv * kx * v, 1e-3f, 1e-5f)) CHK_CODE(26);
        if (far_(out[O_NS + (size_t)(b * NH + h) * DK + dkx], aa * n0[dkx] + wsv * kx, 1e-3f, 1e-5f)) CHK_CODE(26);
        if (far_(out[O_MS + b * NH + h], mt, 1e-4f, 1e-5f)) CHK_CODE(26); }
    for (unsigned s = gt; s < 4096u; s += ngt) { const int row = (s < 256u) ? MP + (int)(s & 31u) : (int)(hsh(s) % MP), col = (int)(hsh(s + 777u) % DM);
        const float xv = row < MP ? x_prompt[(size_t)row * DM + col] : x_sample[(size_t)(row - MP) * DM + col]; const float ref = xv + dot_bf(MIX + (size_t)row * DM, WoutT + (size_t)col * DM, DM);
        if (far_(H[(size_t)row * DM + col], ref, 0.01f, 0.01f)) CHK_CODE(25); if (far_(bf1(HB[(size_t)row * DM + col]), ref, 0.01f, 0.01f)) CHK_CODE(25);
        if (s < 512u) { float ss = 0.f; for (int j = 0; j < DM; ++j) { const float hv = H[(size_t)row * DM + j]; ss += hv * hv; } if (far_(RSS2[row], ss, 2e-3f, 1e-2f)) CHK_CODE(25); } }
    for (unsigned s = gt; s < 4096u; s += ngt) { const int row = (s < 256u) ? MP + (int)(s & 31u) : (int)(hsh(s) % MP), f = (int)(hsh(s + 4242u) % DFF);
        const float r = rsqrtf(RSS2[row] * (1.0f / DM) + EPS); float v = fmaxf(r * dot_bf(HB + (size_t)row * DM, WupT + (size_t)f * DM, DM), 0.f); v = v * v;
        if (far_(bf1(U[(size_t)row * DFF + f]), v, 0.03f, 0.01f)) CHK_CODE(24); }
    for (unsigned s = gt; s < 2048u; s += ngt) { const int row = (s < 128u) ? MP + (int)(s & 31u) : (int)(hsh(s) % MP), col = (int)(hsh(s + 9u) % DM);
        const float pre = H[(size_t)row * DM + col] + dot_bf(U + (size_t)row * DFF, WdnT + (size_t)col * DFF, DFF);
        if (row < MP) { const float ref = pre * rsqrtf(RSS3[row] * (1.0f / DM) + EPS) * final_g[col]; if (!(row == 0 && col == 0) && far_(out[O_Y + (size_t)row * DM + col], ref, 0.02f, 0.01f)) CHK_CODE(23); }
        else { const int col2 = (col + 1234) % DM; const float pre2 = H[(size_t)row * DM + col2] + dot_bf(U + (size_t)row * DFF, WdnT + (size_t)col2 * DFF, DFF);
            const float y1 = out[O_Y + (size_t)row * DM + col] / final_g[col], y2 = out[O_Y + (size_t)row * DM + col2] / final_g[col2];
            if (far_(y1 * pre2, y2 * pre, 0.04f, 0.03f)) CHK_CODE(23); } }
}
#endif

__global__ void __launch_bounds__(512, 2) hymba_fwd(Args args) {
    extern __shared__ __attribute__((aligned(16))) unsigned char lds_raw[];
    LAS unsigned char* lds = (LAS unsigned char*)lds_raw;
    const int tid = threadIdx.x, lane = tid & 63, wid = __builtin_amdgcn_readfirstlane(tid >> 6);
    const int G = gridDim.x, bx = blockIdx.x, vcu = (G % 8 == 0) ? (bx % 8) * (G / 8) + bx / 8 : bx;
    unsigned char* ws = args.ws;
    unsigned* ctl = (unsigned*)(ws + WS_CTL);
    volatile LAS unsigned* MISC = (volatile LAS unsigned*)(lds + MISC_OFF);
    if (tid < 64) MISC[tid] = 0u;
    __syncthreads();
    XcdBarrier bar = xcd_barrier_post(ctl + CW_BAR, MISC + 8);
#if PROF
#define STAMP(k) do { if (bx == 0 && tid == 0) { const unsigned long long t_ = __builtin_amdgcn_s_memrealtime(); MISC[32] = (unsigned)t_; MISC[33] = (unsigned)(t_ >> 32); } } while (0)
#define PRE(k) do { if ((k) == PROF && bx == 0 && tid == 0) { const unsigned long long t_ = __builtin_amdgcn_s_memrealtime(); const unsigned long long p_ = ((unsigned long long)MISC[33] << 32) | MISC[32]; const unsigned long long w_ = 3ull * (t_ - p_); \
        while (__builtin_amdgcn_s_memrealtime() - t_ < w_) __builtin_amdgcn_s_sleep(8); } } while (0)
#else
#define STAMP(k) do { } while (0)
#define PRE(k) do { } while (0)
#endif
    STAMP(0);

    const float* x_prompt = args.in[0]; const float* x_sample = args.in[1];
    const float* norm1_g = args.in[7]; const float* w_in = args.in[8]; const float* b_if = args.in[9];
    const float* w_out = args.in[11]; const float* norm2_g = args.in[12]; const float* w_up = args.in[13]; const float* w_down = args.in[14]; const float* final_g = args.in[15];
    float* out = args.out;
    bf16_t* WinT = (bf16_t*)(ws + WS_WIN); bf16_t* WoutT = (bf16_t*)(ws + WS_WOUT); bf16_t* WupT = (bf16_t*)(ws + WS_WUP); bf16_t* WdnT = (bf16_t*)(ws + WS_WDN);
    bf16_t* XN = (bf16_t*)(ws + WS_XN); bf16_t* Z = (bf16_t*)(ws + WS_Z); bf16_t* MIX = (bf16_t*)(ws + WS_MIX); float* H = (float*)(ws + WS_H); bf16_t* HB = (bf16_t*)(ws + WS_HB);
    bf16_t* U = (bf16_t*)(ws + WS_U); bf16_t* WG = (bf16_t*)(ws + WS_WG); float* ROPE = (float*)(ws + WS_ROPE); float* GT = (float*)(ws + WS_G);
    float* RSS2 = (float*)(ws + WS_CTL + CTL_RSS2); float* RSS3 = (float*)(ws + WS_CTL + CTL_RSS3); float* ACCB = (float*)(ws + WS_CTL + CTL_ACC);

    { P0Args a{x_prompt, x_sample, norm1_g, w_in, w_out, norm2_g, w_up, w_down, WinT, WoutT, WupT, WdnT, XN, WG, ROPE};
      p0_prologue(a, vcu, G, wid, lane);
      trw_run(lds, w_in, NINF, DM, NZ, WinT, nullptr, bx, ((DM / 128) * (NZ / 256) - bx + G - 1) / G, G); }
    PRE(1);
    xcd_barrier(bar);
    STAMP(1);

    { pg8::Gemm g{XN, WinT, MP, NZ, DM}; pg8::StaticOrder S; S.init(MP, NZ, G, bx);
      EpiInProj E{Z, ROPE, out + O_KP, out + O_VP};
      pg8::InterleavedOrder SI{S};
      pg8::gemm_phase<EpiInProj, pg8::InterleavedOrder>(lds, g, SI, E);
      SkInProj Es{Z, ROPE, out + O_KS, out + O_VS};
      SkGates Eg{b_if, GT};
      for (int u2 = bx; u2 < 48 * 8 + 33 * 8; u2 += G) { if (u2 < 384) skinny_unit<2>(lds, XN + (size_t)MP * DM, WinT, DM, 0, DM, Es, u2 >> 3, u2 & 7); else skinny_unit<1>(lds, WG, XN, DM, 0, DM, Eg, (u2 - 384) >> 3, (u2 - 384) & 7); }
    }
    PRE(2);
    xcd_barrier(bar);
    STAMP(2);

    bf16_t* CT = (bf16_t*)(ws + WS_CT); float* NC = (float*)(ws + WS_NC); float* TB = (float*)(ws + WS_TB); float* TWV = (float*)(ws + WS_TWV); float* TMT = (float*)(ws + WS_TMT); float* CMb = (float*)(ws + WS_CM);
    float* HRAW = CHECKS ? (float*)(ws + WS_HRAW) : nullptr;
    const float* cache_k = args.in[2]; const float* cache_v = args.in[3]; const float* state_C = args.in[4]; const float* state_n = args.in[5]; const float* state_m = args.in[6]; const float* mh_g = args.in[10];

    { if (bx < 96) mlstm_scan(lds, Z, GT, CT, NC, TB, TWV, TMT, CMb, out, bx);
      constexpr unsigned NCV = (unsigned)((CV_OUT + CV_UP) / 4);
      const bool prefC = (bx >= 96) && ((((bx >> 3) - 12) % 7) == 0);
      bool doneC = false, doneA = false;
      while (!(doneC && doneA)) {
          const bool takeC = prefC ? !doneC : doneA;
          if (tid == 0) MISC[16] = atomicAdd(&ctl[CW_Q2 + (takeC ? 0 : 32)], 1u);
          __syncthreads();
          const unsigned item = (unsigned)__builtin_amdgcn_readfirstlane((int)MISC[16]);
          __syncthreads();
          if (takeC) { if (item >= NCV) { doneC = true; continue; }
              conv_unit(lds, w_out, w_up, w_down, norm2_g, WoutT, WupT, WdnT, (int)item); }
          else { if (item >= 704u) { doneA = true; continue; }
              if (item < 256u) attn_unit(lds, Z, MIX, (int)item);
              else if (item < 448u) smlstm_unit(lds, Z, GT, state_C, state_n, state_m, mh_g, out, MIX, HRAW, (int)item - 256);
              else sattn_unit(lds, Z, cache_k, cache_v, out, MIX, (int)item - 448); }
      } }
    PRE(3);
    xcd_barrier(bar);
    STAMP(3);

    for (;;) {
        if (tid == 0) MISC[16] = atomicAdd(&ctl[CW_Q2 + 64], 1u);
        __syncthreads();
        const unsigned item = (unsigned)__builtin_amdgcn_readfirstlane((int)MISC[16]);
        __syncthreads();
        if (item >= 1280u) break;
        const unsigned grp = item / 5u, r = item % 5u;
        if (r < 3u) mlstm_out(lds, Z, CT, NC, TB, TWV, TMT, CMb, mh_g, MIX, HRAW, (int)(3u * grp + r));
        else conv_unit(lds, w_out, w_up, w_down, norm2_g, WoutT, WupT, WdnT, (int)((CV_OUT + CV_UP) / 4 + 2u * grp + (r - 3u)));
    }
    PRE(4);
    xcd_barrier(bar);
    STAMP(4);

    { pg8::Gemm g{MIX, WoutT, MP, DM, DM}; pg8::StaticOrder S; S.init(MP, DM, G, bx);
      EpiOutProj E{x_prompt, H, HB, RSS2};
      pg8::gemm_phase<EpiOutProj>(lds, g, S, E);
      SkOutProj Es{x_sample, H, HB, RSS2};
      for (int u2 = bx; u2 < 16 * 8; u2 += G) skinny_unit<2>(lds, MIX + (size_t)MP * DM, WoutT, DM, 0, DM, Es, u2 >> 3, u2 & 7); }
    PRE(5);
    xcd_barrier(bar);
    STAMP(5);

    constexpr int MH = MP / 2;
    { pg8::Gemm g{HB, WupT, MH, DFF, DM}; pg8::StaticOrder S; S.init(MH, DFF, G, bx);
      EpiUp E{U, RSS2, 0};
      pg8::gemm_phase<EpiUp>(lds, g, S, E);
      SkUp Es{U, RSS2};
      for (int u2 = bx; u2 < 64 * 8; u2 += G) skinny_unit<2>(lds, HB + (size_t)MP * DM, WupT, DM, 0, DM, Es, u2 >> 3, u2 & 7); }
    PRE(6);
    xcd_barrier(bar);
    STAMP(6);
    { pg8::Gemm g{U, WdnT, MH, DM, DFF}; pg8::StaticOrder S; S.init(MH, DM, G, bx);
      EpiDownNorm E{HB, out + O_Y, RSS3, ctl + CW_Q2 + 768, final_g, 0};
      pg8::gemm_phase<EpiDownNorm>(lds, g, S, E);
      SkDown Es{ACCB};
      for (int u2 = bx; u2 < 512; u2 += G) { const int kc = u2 >> 7, j32 = u2 & 127; skinny_unit<2>(lds, U + (size_t)MP * DFF, WdnT, DFF, 4096 * kc, 4096, Es, j32 >> 3, j32 & 7); } }
    { pg8::Gemm g{HB + (size_t)MH * DM, WupT, MH, DFF, DM}; pg8::StaticOrder S; S.init(MH, DFF, G, bx);
      EpiUp E{U, RSS2, MH / 256};
      pg8::gemm_phase<EpiUp>(lds, g, S, E); }
    xcd_barrier(bar);
    { const int gw = vcu * 8 + wid, ngw = G * 8; const bf16_t* YB = MIX;
      for (int m = MP + gw; m < MT; m += ngw) {
          float* yr = out + O_Y + (size_t)m * DM; f32x4 v[8][2]; float r;
          if (m < MP) { const bf16_t* yb = YB + (size_t)m * DM;
#pragma unroll
              for (int c = 0; c < 8; ++c) { const u32x4 w = *(const u32x4*)(yb + 512 * c + 8 * lane); v[c][0] = (f32x4){bf_lo(w.x), bf_hi(w.x), bf_lo(w.y), bf_hi(w.y)}; v[c][1] = (f32x4){bf_lo(w.z), bf_hi(w.z), bf_lo(w.w), bf_hi(w.w)}; }
              r = rsqrtf(RSS3[m] * (1.0f / DM) + EPS);
          } else { const bf16_t* hr = HB + (size_t)m * DM; const float* ar = ACCB + (size_t)(m - MP) * DM; float ss = 0.f;
#pragma unroll
              for (int c = 0; c < 8; ++c) { const u32x4 w = *(const u32x4*)(hr + 512 * c + 8 * lane);
                  v[c][0] = (f32x4){bf_lo(w.x), bf_hi(w.x), bf_lo(w.y), bf_hi(w.y)} + *(const f32x4*)(ar + 512 * c + 8 * lane); v[c][1] = (f32x4){bf_lo(w.z), bf_hi(w.z), bf_lo(w.w), bf_hi(w.w)} + *(const f32x4*)(ar + 512 * c + 8 * lane + 4);
                  ss += (v[c][0][0] * v[c][0][0] + v[c][0][1] * v[c][0][1]) + (v[c][0][2] * v[c][0][2] + v[c][0][3] * v[c][0][3]) + (v[c][1][0] * v[c][1][0] + v[c][1][1] * v[c][1][1]) + (v[c][1][2] * v[c][1][2] + v[c][1][3] * v[c][1][3]); }
              r = rsqrtf(wave_sum(ss) * (1.0f / DM) + EPS); }
#pragma unroll
          for (int c = 0; c < 8; ++c) { const f32x4 g0 = *(const f32x4*)(final_g + 512 * c + 8 * lane), g1v = *(const f32x4*)(final_g + 512 * c + 8 * lane + 4);
              *(f32x4*)(yr + 512 * c + 8 * lane) = v[c][0] * r * g0; *(f32x4*)(yr + 512 * c + 8 * lane + 4) = v[c][1] * r * g1v; }
      } }
    { pg8::Gemm g{U + (size_t)MH * DFF, WdnT, MH, DM, DFF}; pg8::StaticOrder S; S.init(MH, DM, G, bx);
      EpiDownNorm E{HB, out + O_Y, RSS3, ctl + CW_Q2 + 768, final_g, MH / 256};
      pg8::gemm_phase<EpiDownNorm>(lds, g, S, E); }

#if PROF
    PRE(8);
    xcd_barrier(bar);
#endif
#if CHECKS
    PRE(8);
    xcd_barrier(bar);
    STAMP(8);
    run_checks(args, lds);
    PRE(9);
    xcd_barrier(bar);
    STAMP(9);
    if (bx == 0 && tid == 0) { const unsigned code = __hip_atomic_load(ctl + CW_ERR, __ATOMIC_RELAXED, __HIP_MEMORY_SCOPE_AGENT); const unsigned msk = __hip_atomic_load(ctl + CW_ERR + 2, __ATOMIC_RELAXED, __HIP_MEMORY_SCOPE_AGENT);
        if (msk) out[0] = (float)(60u + msk) * 10000.0f; else if (code) out[0] = (float)code * 10000.0f; }
#endif
}

extern "C" void kernel_launch(void* const* d_in, const int* in_sizes, int n_in, void* d_out, int out_size, void* d_ws, size_t ws_size, hipStream_t stream) {
    static int grid = 0;
    if (grid == 0) {
        if (n_in != 16 || out_size != (int)O_END || ws_size < WS_NEED) { fprintf(stderr, "kernel_launch: unexpected shapes (n_in %d, out %d, ws %zu)\n", n_in, out_size, ws_size); grid = -1; return; }
        int dev = 0, cus = 0, per_cu = 0;
        if (hipGetDevice(&dev) != hipSuccess || hipDeviceGetAttribute(&cus, hipDeviceAttributeMultiprocessorCount, dev) != hipSuccess) { grid = -1; return; }
        if (hipFuncSetAttribute((const void*)hymba_fwd, hipFuncAttributeMaxDynamicSharedMemorySize, LDS_BYTES) != hipSuccess) { fprintf(stderr, "kernel_launch: hipFuncSetAttribute failed\n"); grid = -1; return; }
        if (hipOccupancyMaxActiveBlocksPerMultiprocessor(&per_cu, (const void*)hymba_fwd, 512, LDS_BYTES) != hipSuccess || per_cu < 1) { fprintf(stderr, "kernel_launch: occupancy query says %d\n", per_cu); }
        (void)hipGetLastError();
        grid = cus;
    }
    if (grid < 0) return;
    (void)in_sizes;
    hipMemsetAsync((char*)d_ws + WS_CTL, 0, CTL_ZERO_BYTES, stream);
    Args a{};
    for (int i = 0; i < 16; ++i) a.in[i] = (const float*)d_in[i];
    a.out = (float*)d_out; a.ws = (unsigned char*)d_ws;
    hipLaunchKernelGGL(hymba_fwd, dim3(grid), dim3(512), LDS_BYTES, stream, a);
}
```

```cpp
#include <hip/hip_runtime.h>
#include <cstdio>
#include <cstdint>

#define LAS __attribute__((address_space(3)))
typedef unsigned short bf16_t;
typedef short bf16x8 __attribute__((ext_vector_type(8)));
typedef short s16x4 __attribute__((ext_vector_type(4)));
typedef float f32x4 __attribute__((ext_vector_type(4)));
typedef float f32x2 __attribute__((ext_vector_type(2)));
typedef unsigned u32x4 __attribute__((ext_vector_type(4)));
typedef unsigned u32x2 __attribute__((ext_vector_type(2)));

constexpr int DM = 4096, SEQ = 4096, NB = 2, MP = NB * SEQ  , MS = 32, MT = MP + MS  , MPAD = 8448;
constexpr int NZ = 12288, NINF = 12300, DFF = 16384;
constexpr int ZQA = 0, ZKA = 1024, ZVA = 2048, ZQM = 3072, ZKM = 4608, ZVM = 6144, ZOM = 9216;
constexpr int NH = 6, DK = 256, DV = 512, LCH = 64, NCH = 64;
constexpr float EPS = 1e-6f;
constexpr size_t O_Y = 0, O_KP = 33685504, O_VP = 37879808, O_CP = 42074112, O_NP = 43646976, O_MP = 43650048, O_KS = 43650060, O_VS = 43682828,
                 O_CS = 43715596, O_NS = 68881420, O_MS = 68930572, O_END = 68930764;

constexpr size_t MiB = 1u << 20;
constexpr size_t WS_CTL = 0, CTL_ZERO_BYTES = 1 * MiB;
constexpr int CW_BAR = 0;
constexpr int CW_Q2 = 4096;
constexpr size_t CTL_RSS2 = 64 * 1024, CTL_RSS3 = 128 * 1024, CTL_ACC = 512 * 1024;
constexpr size_t WS_ROPE = 2 * MiB;
constexpr size_t WS_WG = 5 * MiB;
constexpr size_t WS_G = 6 * MiB;
constexpr size_t WS_TB = 7 * MiB, WS_TWV = 7 * MiB + 256 * 1024, WS_TMT = 7 * MiB + 512 * 1024, WS_CM = 7 * MiB + 768 * 1024;
constexpr size_t WS_NC = 8 * MiB;
constexpr size_t WS_WIN = 16 * MiB, WS_WOUT = 112 * MiB, WS_WUP = 144 * MiB, WS_WDN = 272 * MiB;
constexpr size_t WS_XN = 400 * MiB, WS_Z = 466 * MiB, WS_MIX = 660 * MiB, WS_H = 726 * MiB, WS_HB = 855 * MiB, WS_CT = 921 * MiB, WS_END = 1114 * MiB;
#ifndef CHECKS
#define CHECKS 0
#endif
#ifndef PROF
#define PROF 0
#endif
constexpr size_t WS_U = CHECKS ? 1114 * MiB : 400 * MiB;
constexpr size_t WS_HRAW = 1380 * MiB;
constexpr size_t WS_NEED = CHECKS ? 1480 * MiB : WS_END;
constexpr int CW_ERR = 8192;
constexpr size_t WS_DBG = 1477 * MiB;

constexpr int LDS_BYTES = 153600, MISC_OFF = 153088;

__device__ __forceinline__ unsigned cvt_pk_bf16(float lo, float hi) { unsigned r; asm volatile("v_cvt_pk_bf16_f32 %0, %1, %2" : "=v"(r) : "v"(lo), "v"(hi)); return r; }
__device__ __forceinline__ float bf_lo(unsigned w) { return __uint_as_float(w << 16); }
__device__ __forceinline__ float bf_hi(unsigned w) { return __uint_as_float(w & 0xffff0000u); }
__device__ __forceinline__ float bf1(bf16_t b) { return __uint_as_float(((unsigned)b) << 16); }
__device__ __forceinline__ float wave_sum(float v) {
#pragma unroll
    for (int o = 1; o < 64; o <<= 1) v += __shfl_xor(v, o);
    return v;
}
__device__ __forceinline__ float wave_max(float v) {
#pragma unroll
    for (int o = 1; o < 64; o <<= 1) v = fmaxf(v, __shfl_xor(v, o));
    return v;
}
__device__ __forceinline__ void lds_addf(LAS float* p, float v) { (void)__hip_atomic_fetch_add(p, v, __ATOMIC_RELAXED, __HIP_MEMORY_SCOPE_WORKGROUP); }
typedef short v4i16_t __attribute__((ext_vector_type(4)));
__device__ __forceinline__ s16x4 vtr(const LAS unsigned char* p) { return __builtin_bit_cast(s16x4, __builtin_amdgcn_ds_read_tr16_b64_v4i16((LAS v4i16_t*)p)); }
__device__ __forceinline__ bf16x8 cat8(s16x4 a, s16x4 b) { bf16x8 r; r[0] = a[0]; r[1] = a[1]; r[2] = a[2]; r[3] = a[3]; r[4] = b[0]; r[5] = b[1]; r[6] = b[2]; r[7] = b[3]; return r; }

#define XB_TMO      128
#define XB_XCNT(j)  (256  + 64 * (j))
#define XB_XSUB(j)  (1280 + 64 * (j))
#define XB_XGEN(j)  (2304 + 64 * (j))
#define XB_TOP      3328
#define XB_TOPGEN   3392
#define XCD_BAR_WORDS 3456
#define XB_SPIN_CAP (1u << 18)
__device__ __forceinline__ unsigned xb_ld(unsigned* p)              { return __hip_atomic_load(p, __ATOMIC_RELAXED, __HIP_MEMORY_SCOPE_AGENT); }
__device__ __forceinline__ unsigned xb_add(unsigned* p, unsigned v) { return __hip_atomic_fetch_add(p, v, __ATOMIC_RELAXED, __HIP_MEMORY_SCOPE_AGENT); }
__device__ __forceinline__ unsigned xb_xcc_id() { return (unsigned)__builtin_amdgcn_s_getreg((3 << 11) | 20) & 0xFu; }
#define XB_SPIN(cond, bar) do { unsigned _sp = 0; while (cond) { __builtin_amdgcn_s_sleep(1); \
    if ((++_sp & 255u) == 0u) { if (xb_ld(&(bar)[XB_TMO])) break; if (_sp > XB_SPIN_CAP) { atomicAdd(&(bar)[XB_TMO], 1u); break; } } } } while (0)
struct XcdBarrier { unsigned* bar; unsigned x; volatile LAS unsigned* st; };
__device__ __forceinline__ XcdBarrier xcd_barrier_post(unsigned* bar, volatile LAS unsigned* st) {
    XcdBarrier b; b.bar = bar; b.x = xb_xcc_id(); b.st = st;
    if (threadIdx.x == 0) (void)xb_add(&bar[XB_XCNT(b.x)], 1u);
    return b;
}
__device__ __forceinline__ void xcd_barrier_complete(unsigned* bar, unsigned x, unsigned& nloc, unsigned& nx) {
    const unsigned G = gridDim.x * gridDim.y * gridDim.z;
    unsigned sum, cnt, mine, sp = 0u;
    for (;;) {
        sum = 0u; cnt = 0u; mine = 0u;
#pragma unroll
        for (unsigned j = 0; j < 16; ++j) { const unsigned c = xb_ld(&bar[XB_XCNT(j)]); sum += c; cnt += (c > 0u) ? 1u : 0u; mine = (j == x) ? c : mine; }
        if (sum == G) break;
        __builtin_amdgcn_s_sleep(1);
        if ((++sp & 255u) == 0u) { if (xb_ld(&bar[XB_TMO])) break; if (sp > XB_SPIN_CAP) { atomicAdd(&bar[XB_TMO], 1u); break; } }
    }
    nloc = mine > 0u ? mine : 1u; nx = cnt > 0u ? cnt : 1u;
}
__device__ __forceinline__ void xcd_barrier(const XcdBarrier& b) {
    asm volatile("s_waitcnt vmcnt(0)" ::: "memory");
    __syncthreads();
    if (threadIdx.x == 0) {
        unsigned* bar = b.bar;
        __builtin_amdgcn_s_waitcnt(0);
        unsigned nloc = b.st[0], nx = b.st[1];
        if (nloc == 0u) { xcd_barrier_complete(bar, b.x, nloc, nx); b.st[0] = nloc; b.st[1] = nx; }
        const unsigned old = xb_add(&bar[XB_XSUB(b.x)], 1u);
        const unsigned gen = old / nloc;
        if (old + 1u == (gen + 1u) * nloc) {
            __builtin_amdgcn_fence(__ATOMIC_RELEASE, "agent");
            asm volatile("s_waitcnt vmcnt(0)" ::: "memory");
            const unsigned og = xb_add(&bar[XB_TOP], 1u);
            const unsigned tg = og / nx;
            if (og + 1u == (tg + 1u) * nx) xb_add(&bar[XB_TOPGEN], 1u);
            else XB_SPIN(xb_ld(&bar[XB_TOPGEN]) == tg, bar);
            __builtin_amdgcn_fence(__ATOMIC_ACQUIRE, "agent");
            xb_add(&bar[XB_XGEN(b.x)], 1u);
            asm volatile("s_waitcnt vmcnt(0)" ::: "memory");
        } else {
            XB_SPIN(xb_ld(&bar[XB_XGEN(b.x)]) == gen, bar);
            __builtin_amdgcn_fence(__ATOMIC_ACQUIRE, "agent");
            asm volatile("s_waitcnt vmcnt(0)" ::: "memory");
        }
    }
    __syncthreads();
}

namespace pg8 {
constexpr int BM = 256, BK = 64, HALF = 128, HTB = HALF * BK * 2, STAGE_BYTES = 8 * HTB, NXCD = 8, WGM = 8;
__host__ __device__ __forceinline__ int lds_byte(int r, int c) { const int st = (r >> 4) * 2 + (c >> 5), rr = r & 15, cc = c & 31, ob = rr * 64 + cc * 2; return st * 1024 + (ob ^ (((ob >> 9) & 1) << 5)); }
__host__ __device__ __forceinline__ void stage_rc(int b, int& R, int& C) { const int st = b / 1024, sb = b % 1024, swz = sb ^ (((sb >> 9) & 1) << 5); R = (st >> 1) * 16 + swz / 64; C = (st & 1) * 32 + (swz % 64) / 2; }
__host__ __device__ __forceinline__ int perm32(int rho) { const int n = rho >> 4, i = rho & 15; return 8 * (i >> 2) + 4 * n + (i & 3); }
struct Unit { int pm, pn; };
struct Gemm { const bf16_t* A; const bf16_t* Bt; int M, N, K; };
struct StaticOrder {
    int nM, nN, nwg, G, c;
    __host__ __device__ void init(int M, int N, int G_, int c_) { nM = M / BM; nN = N / BM; nwg = nM * nN; G = G_; c = c_; }
    __host__ __device__ bool next(int i, Unit& u) const {
        const long L = (long)i * G + c; if (L >= nwg) return false;
        int wgid = (int)L; { const int q = nwg / NXCD, r = nwg % NXCD, xcd = wgid % NXCD, off = wgid / NXCD; wgid = (xcd < r ? xcd * (q + 1) : r * (q + 1) + (xcd - r) * q) + off; }
        const int nig = WGM * nN, gid = wgid / nig, fm = gid * WGM, gsz = (nM - fm) < WGM ? (nM - fm) : WGM;
        u.pm = fm + ((wgid % nig) % gsz); u.pn = (wgid % nig) / gsz; return true;
    }
};
struct InterleavedOrder { StaticOrder S;
    __host__ __device__ bool next(int i, Unit& u) const { if (!S.next(i, u)) return false; u.pn = 2 * (u.pn % 24) + u.pn / 24; return true; } };
template <int BMODE> __host__ __device__ __forceinline__ int bmap_row(int R) {
    if (BMODE == 0) return R;
    const int p = (R & ~31) + perm32(R & 31);
    if (BMODE == 1) return p;
    return (p >> 6) * 128 + (p & 63);
}
template <class Epi, class Sched = StaticOrder, bool ALIGN_EPI = true, bool SP2 = true>
__device__ __forceinline__ void gemm_phase(LAS unsigned char* lds, const Gemm g, const Sched& S, const Epi& E) {
    int tid = threadIdx.x; asm volatile("" : "+v"(tid)); const int wid = __builtin_amdgcn_readfirstlane(tid >> 6), lane = tid & 63, wr = wid >> 2, wc = wid & 3, fr = lane & 15, fq = lane >> 4;
    const int K = g.K, nt = K / BK;
    unsigned voffA[2], voffB[2];
#pragma unroll
    for (int i = 0; i < 2; ++i) { int R, C; stage_rc(tid * 16 + i * 8192, R, C); const int Rb = bmap_row<Epi::BMODE>(R);
        voffA[i] = (unsigned)(R * K + C) * 2u; voffB[i] = (unsigned)(Rb * K + C) * 2u; }
    const size_t kstep = (size_t)(BK * 2);
    const size_t hstep = (size_t)HALF * K * 2;
    const size_t hstepB = (size_t)(Epi::BMODE == 2 ? 64 : 128) * K * 2;
    const size_t tstep = 2 * hstep;
    const unsigned ldsw = (unsigned)wid * 1024u;
    const int aoff = lds_byte(wr * 64 + fr, fq * 8), boff = lds_byte(wc * 32 + fr, fq * 8);
#define PG8_SA(b, h) (((b) * 2 + (h)) * HTB)
#define PG8_SB(b, h) ((4 + (b) * 2 + (h)) * HTB)
#define PG8_STAGE(bufoff, gbase, voff) do { _Pragma("unroll") for (int _i = 0; _i < 2; ++_i) \
        __builtin_amdgcn_global_load_lds((const unsigned*)((const char*)(gbase) + (voff)[_i]), (LAS unsigned*)(lds + (bufoff) + ldsw + _i * 8192), 16, 0, 0); } while (0)
#define PG8_LDA(dst, b, h) do { _Pragma("unroll") for (int m = 0; m < 4; ++m) _Pragma("unroll") for (int k = 0; k < 2; ++k) dst[m][k] = *(const LAS bf16x8*)(lds + PG8_SA(b, h) + aoff + m * 2048 + k * 1024); } while (0)
#define PG8_LDB(dst, b, h) do { _Pragma("unroll") for (int n = 0; n < 2; ++n) _Pragma("unroll") for (int k = 0; k < 2; ++k) dst[n][k] = *(const LAS bf16x8*)(lds + PG8_SB(b, h) + boff + n * 2048 + k * 1024); } while (0)
#define PG8_MMA(ai, bj, At, Bt) do { __builtin_amdgcn_s_setprio(1); _Pragma("unroll") for (int m = 0; m < 4; ++m) _Pragma("unroll") for (int n = 0; n < 2; ++n) _Pragma("unroll") for (int k = 0; k < 2; ++k) \
        acc[ai][bj][m][n] = __builtin_amdgcn_mfma_f32_16x16x32_bf16(Bt[n][k], At[m][k], acc[ai][bj][m][n], 0, 0, 0); __builtin_amdgcn_s_setprio(0); } while (0)
#define PG8_WAIT_V(n) asm volatile("s_waitcnt vmcnt(" #n ")" ::: "memory")
#define PG8_WAIT_L(n) asm volatile("s_waitcnt lgkmcnt(" #n ")" ::: "memory")
#define PG8_BAR __builtin_amdgcn_s_barrier()
#define PG8_SCHED __builtin_amdgcn_sched_barrier(0)
    Unit cur, nxt; int ui = 0;
    if (!S.next(0, cur)) return;
    f32x4 acc[2][2][4][2];
#pragma unroll
    for (int a = 0; a < 2; ++a)
#pragma unroll
        for (int b = 0; b < 2; ++b)
#pragma unroll
            for (int m = 0; m < 4; ++m)
#pragma unroll
                for (int n = 0; n < 2; ++n) acc[a][b][m][n] = (f32x4){0.f, 0.f, 0.f, 0.f};
    bf16x8 At[4][2], B0[2][2], B1[2][2];
    const char* cA = (const char*)g.A + (size_t)cur.pm * tstep; const char* cB = (const char*)g.Bt + (size_t)cur.pn * tstep;
    if constexpr (SP2) {
        PG8_STAGE(PG8_SB(0, 0), cB, voffB); PG8_STAGE(PG8_SB(0, 1), cB + hstepB, voffB); PG8_STAGE(PG8_SA(0, 0), cA, voffA); PG8_STAGE(PG8_SA(0, 1), cA + hstep, voffA);
        if (wr == 1) PG8_BAR;
        PG8_WAIT_V(2); PG8_BAR;
        PG8_STAGE(PG8_SB(1, 0), cB + kstep, voffB); PG8_STAGE(PG8_SA(1, 0), cA + kstep, voffA); PG8_STAGE(PG8_SB(1, 1), cB + hstepB + kstep, voffB);
        PG8_WAIT_V(6); PG8_BAR;
    } else {
        PG8_STAGE(PG8_SB(0, 0), cB, voffB); PG8_STAGE(PG8_SA(0, 0), cA, voffA); PG8_STAGE(PG8_SB(0, 1), cB + hstepB, voffB); PG8_STAGE(PG8_SA(0, 1), cA + hstep, voffA);
        if (wr == 1) PG8_BAR;
        PG8_WAIT_V(4); PG8_BAR;
        PG8_STAGE(PG8_SB(1, 0), cB + kstep, voffB); PG8_STAGE(PG8_SA(1, 0), cA + kstep, voffA); PG8_STAGE(PG8_SB(1, 1), cB + hstepB + kstep, voffB);
        PG8_WAIT_V(6); PG8_BAR;
    }
    for (;;) {
        const bool has_next = S.next(ui + 1, nxt);
        const char* nA = has_next ? (const char*)g.A + (size_t)nxt.pm * tstep : cA; const char* nB = has_next ? (const char*)g.Bt + (size_t)nxt.pn * tstep : cB;
        for (int t = 0; t < nt; t += 2) {
            const bool last = (t == nt - 2);
            const char* a1 = cA + (size_t)(t + 1) * kstep;
            const char* a2 = last ? nA : cA + (size_t)(t + 2) * kstep; const char* b2 = last ? nB : cB + (size_t)(t + 2) * kstep;
            const char* a3 = a2 + kstep; const char* b3 = b2 + kstep;
            if constexpr (SP2) {
            PG8_LDB(B0, 0, 0); PG8_LDB(B1, 0, 1); PG8_SCHED; PG8_LDA(At, 0, 0); PG8_STAGE(PG8_SA(1, 1), a1 + hstep, voffA);
            PG8_WAIT_V(8); PG8_WAIT_L(0); PG8_BAR; PG8_MMA(0, 0, At, B0); PG8_MMA(0, 1, At, B1); PG8_BAR; PG8_SCHED;
            PG8_LDA(At, 0, 1); PG8_STAGE(PG8_SB(0, 0), b2, voffB); PG8_STAGE(PG8_SB(0, 1), b2 + hstepB, voffB); PG8_STAGE(PG8_SA(0, 0), a2, voffA);
            PG8_WAIT_V(8); PG8_WAIT_L(0); PG8_BAR; PG8_MMA(1, 0, At, B0); PG8_MMA(1, 1, At, B1); PG8_BAR; PG8_SCHED;
            PG8_LDB(B0, 1, 0); PG8_LDB(B1, 1, 1); PG8_SCHED; PG8_LDA(At, 1, 0); PG8_STAGE(PG8_SA(0, 1), a2 + hstep, voffA);
            PG8_WAIT_V(8); PG8_WAIT_L(0); PG8_BAR; PG8_MMA(0, 0, At, B0); PG8_MMA(0, 1, At, B1); PG8_BAR; PG8_SCHED;
            PG8_LDA(At, 1, 1); PG8_STAGE(PG8_SB(1, 0), b3, voffB); PG8_STAGE(PG8_SB(1, 1), b3 + hstepB, voffB); PG8_STAGE(PG8_SA(1, 0), a3, voffA);
            PG8_WAIT_V(8); PG8_WAIT_L(0); PG8_BAR; PG8_MMA(1, 0, At, B0); PG8_MMA(1, 1, At, B1); PG8_BAR; PG8_SCHED;
            } else {
            PG8_LDB(B0, 0, 0); PG8_SCHED; PG8_LDA(At, 0, 0); PG8_STAGE(PG8_SA(1, 1), a1 + hstep, voffA);
            PG8_WAIT_L(8); PG8_BAR; PG8_WAIT_L(0); PG8_MMA(0, 0, At, B0); PG8_BAR; PG8_SCHED;
            PG8_LDB(B1, 0, 1); PG8_STAGE(PG8_SB(0, 0), b2, voffB);
            PG8_BAR; PG8_WAIT_L(0); PG8_MMA(0, 1, At, B1); PG8_BAR;
            PG8_LDA(At, 0, 1); PG8_STAGE(PG8_SA(0, 0), a2, voffA);
            PG8_BAR; PG8_WAIT_L(0); PG8_MMA(1, 0, At, B0); PG8_BAR; PG8_SCHED;
            PG8_STAGE(PG8_SB(0, 1), b2 + hstepB, voffB);
            PG8_WAIT_V(6); PG8_BAR; PG8_MMA(1, 1, At, B1); PG8_BAR;
            PG8_LDB(B0, 1, 0); PG8_SCHED; PG8_LDA(At, 1, 0); PG8_STAGE(PG8_SA(0, 1), a2 + hstep, voffA);
            PG8_WAIT_L(8); PG8_BAR; PG8_WAIT_L(0); PG8_MMA(0, 0, At, B0); PG8_BAR; PG8_SCHED;
            PG8_LDB(B1, 1, 1); PG8_STAGE(PG8_SB(1, 0), b3, voffB);
            PG8_BAR; PG8_WAIT_L(0); PG8_MMA(0, 1, At, B1); PG8_BAR;
            PG8_LDA(At, 1, 1); PG8_STAGE(PG8_SA(1, 0), a3, voffA);
            PG8_BAR; PG8_WAIT_L(0); PG8_MMA(1, 0, At, B0); PG8_BAR; PG8_SCHED;
            PG8_STAGE(PG8_SB(1, 1), b3 + hstepB, voffB);
            PG8_WAIT_V(6); PG8_BAR; PG8_MMA(1, 1, At, B1); PG8_BAR;
            }
        }
        if constexpr (ALIGN_EPI) { if (wr == 0) PG8_BAR; }
        if constexpr (Epi::FUSED) E.fused(acc, cur, wr, wc, fr, fq, wid, lane); else E(acc, cur, wr, wc, fr, fq);
        if (!has_next) break;
#pragma unroll
        for (int a = 0; a < 2; ++a)
#pragma unroll
            for (int b = 0; b < 2; ++b)
#pragma unroll
                for (int m = 0; m < 4; ++m)
#pragma unroll
                    for (int n = 0; n < 2; ++n) acc[a][b][m][n] = (f32x4){0.f, 0.f, 0.f, 0.f};
        cur = nxt; cA = nA; cB = nB; ++ui;
        if constexpr (ALIGN_EPI) { if (wr == 1) PG8_BAR; }
    }
    PG8_WAIT_V(0);
    if constexpr (!ALIGN_EPI) { if (wr == 0) PG8_BAR; }
    PG8_BAR;
#undef PG8_SA
#undef PG8_SB
#undef PG8_STAGE
#undef PG8_LDA
#undef PG8_LDB
#undef PG8_MMA
#undef PG8_WAIT_V
#undef PG8_WAIT_L
#undef PG8_BAR
#undef PG8_SCHED
}
}

struct EpiInProj {
    static constexpr bool FUSED = false;
    static constexpr int BMODE = 2;
    bf16_t* Z; const float* rope; float* kout; float* vout;
    __device__ __forceinline__ void operator()(const f32x4 (&acc)[2][2][4][2], const pg8::Unit& u, int wr, int wc, int fr, int fq) const {
        const int pn = u.pn, hsel = wc >> 1, i0 = 32 * (wc & 1) + 8 * fq;
        const int colb = 256 * pn + 128 * hsel + i0;
#pragma unroll
        for (int ai = 0; ai < 2; ++ai)
#pragma unroll
            for (int m = 0; m < 4; ++m) {
                const int row = 256 * u.pm + 128 * ai + 64 * wr + 16 * m + fr;
                const int pos = row & (SEQ - 1), bb = row >> 12;
                f32x4 a0 = acc[ai][0][m][0], a1 = acc[ai][0][m][1], b0 = acc[ai][1][m][0], b1 = acc[ai][1][m][1];
                if (pn < 8) {
                    const float* rt = rope + (size_t)pos * 128 + i0;
                    const f32x4 c0 = *(const f32x4*)(rt), c1 = *(const f32x4*)(rt + 4), s0 = *(const f32x4*)(rt + 64), s1 = *(const f32x4*)(rt + 68);
                    const f32x4 o0 = a0 * c0 - b0 * s0, o1 = a1 * c1 - b1 * s1, p0 = b0 * c0 + a0 * s0, p1 = b1 * c1 + a1 * s1;
                    a0 = o0; a1 = o1; b0 = p0; b1 = p1;
                    if (pn < 4) { const float sc = 0.08838834764831845f; a0 *= sc; a1 *= sc; b0 *= sc; b1 *= sc; }
                } else if (pn >= 12 && pn < 18) { const float sc = 0.0625f; a0 *= sc; a1 *= sc; b0 *= sc; b1 *= sc; }
                bf16_t* zp = Z + (size_t)row * NZ + colb;
                u32x4 w; w.x = cvt_pk_bf16(a0[0], a0[1]); w.y = cvt_pk_bf16(a0[2], a0[3]); w.z = cvt_pk_bf16(a1[0], a1[1]); w.w = cvt_pk_bf16(a1[2], a1[3]);
                *(u32x4*)zp = w;
                w.x = cvt_pk_bf16(b0[0], b0[1]); w.y = cvt_pk_bf16(b0[2], b0[3]); w.z = cvt_pk_bf16(b1[0], b1[1]); w.w = cvt_pk_bf16(b1[2], b1[3]);
                *(u32x4*)(zp + 64) = w;
                if (pn >= 4 && pn < 12 && pos >= 2048) {
                    float* ob = (pn < 8) ? kout : vout; const int head = 2 * ((pn - 4) & 3) + hsel;
                    float* op = ob + ((size_t)(bb * 2048 + pos - 2048) * 8 + head) * 128 + i0;
                    *(f32x4*)op = a0; *(f32x4*)(op + 4) = a1; *(f32x4*)(op + 64) = b0; *(f32x4*)(op + 68) = b1;
                }
                asm volatile("" ::: "memory");
            }
    }
};
struct EpiOutProj {
    static constexpr bool FUSED = false;
    static constexpr int BMODE = 0;
    const float* X; float* H; bf16_t* HB; float* rss;
    __device__ __forceinline__ void operator()(const f32x4 (&acc)[2][2][4][2], const pg8::Unit& u, int wr, int wc, int fr, int fq) const {
        const int col0 = 256 * u.pn + 32 * wc + 4 * fq;
#pragma unroll
        for (int ai = 0; ai < 2; ++ai)
#pragma unroll
            for (int m = 0; m < 4; ++m) {
                const int row = 256 * u.pm + 128 * ai + 64 * wr + 16 * m + fr; const size_t off = (size_t)row * DM + col0; float ss = 0.f;
#pragma unroll
                for (int bj = 0; bj < 2; ++bj)
#pragma unroll
                    for (int n = 0; n < 2; ++n) { const size_t o = off + bj * 128 + n * 16; const f32x4 hv = *(const f32x4*)(X + o) + acc[ai][bj][m][n];
                        u32x2 w; w.x = cvt_pk_bf16(hv[0], hv[1]); w.y = cvt_pk_bf16(hv[2], hv[3]); *(u32x2*)(HB + o) = w;
                        ss += (hv[0] * hv[0] + hv[1] * hv[1]) + (hv[2] * hv[2] + hv[3] * hv[3]); }
                ss += __shfl_xor(ss, 16); ss += __shfl_xor(ss, 32);
                if (fq == 0) atomicAdd(rss + row, ss);
                asm volatile("" ::: "memory");
            }
    }
};
struct EpiUp {
    static constexpr bool FUSED = false;
    static constexpr int BMODE = 1;
    bf16_t* U; const float* rss; int pm0;
    __device__ __forceinline__ void operator()(const f32x4 (&acc)[2][2][4][2], const pg8::Unit& u, int wr, int wc, int fr, int fq) const {
        const int col0 = 256 * u.pn + 32 * wc + 8 * fq;
        float rr[2][4];
#pragma unroll
        for (int ai = 0; ai < 2; ++ai)
#pragma unroll
            for (int m = 0; m < 4; ++m) rr[ai][m] = rss[256 * (u.pm + pm0) + 128 * ai + 64 * wr + 16 * m + fr];
#pragma unroll
        for (int ai = 0; ai < 2; ++ai)
#pragma unroll
            for (int m = 0; m < 4; ++m) rr[ai][m] = rsqrtf(rr[ai][m] * (1.0f / DM) + EPS);
        asm volatile("" ::: "memory");
#pragma unroll
        for (int ai = 0; ai < 2; ++ai)
#pragma unroll
            for (int m = 0; m < 4; ++m) {
                const int row = 256 * (u.pm + pm0) + 128 * ai + 64 * wr + 16 * m + fr;
                const float r = rr[ai][m];
                bf16_t* up = U + (size_t)row * DFF + col0;
#pragma unroll
                for (int bj = 0; bj < 2; ++bj) { f32x4 v0 = acc[ai][bj][m][0] * r, v1 = acc[ai][bj][m][1] * r;
#pragma unroll
                    for (int j = 0; j < 4; ++j) { const float a = fmaxf(v0[j], 0.f), b = fmaxf(v1[j], 0.f); v0[j] = a * a; v1[j] = b * b; }
                    u32x4 w; w.x = cvt_pk_bf16(v0[0], v0[1]); w.y = cvt_pk_bf16(v0[2], v0[3]); w.z = cvt_pk_bf16(v1[0], v1[1]); w.w = cvt_pk_bf16(v1[2], v1[3]);
                    *(u32x4*)(up + bj * 128) = w; }
            }
    }
};
struct EpiDown {
    static constexpr bool FUSED = false;
    static constexpr int BMODE = 0;
    const bf16_t* HB; bf16_t* YB; float* rss; int pm0;
    __device__ __forceinline__ void operator()(const f32x4 (&acc)[2][2][4][2], const pg8::Unit& u, int wr, int wc, int fr, int fq) const {
        const int col0 = 256 * u.pn + 32 * wc + 4 * fq;
#pragma unroll
        for (int ai = 0; ai < 2; ++ai)
#pragma unroll
            for (int m = 0; m < 4; ++m) {
                const int row = 256 * (u.pm + pm0) + 128 * ai + 64 * wr + 16 * m + fr; const size_t off = (size_t)row * DM + col0; float ss = 0.f;
#pragma unroll
                for (int bj = 0; bj < 2; ++bj)
#pragma unroll
                    for (int n = 0; n < 2; ++n) { const size_t o = off + bj * 128 + n * 16; const u32x2 hw = *(const u32x2*)(HB + o);
                        const f32x4 hv = (f32x4){bf_lo(hw.x), bf_hi(hw.x), bf_lo(hw.y), bf_hi(hw.y)} + acc[ai][bj][m][n];
                        u32x2 w; w.x = cvt_pk_bf16(hv[0], hv[1]); w.y = cvt_pk_bf16(hv[2], hv[3]); *(u32x2*)(YB + o) = w;
                        ss += (hv[0] * hv[0] + hv[1] * hv[1]) + (hv[2] * hv[2] + hv[3] * hv[3]); }
                ss += __shfl_xor(ss, 16); ss += __shfl_xor(ss, 32);
                if (fq == 0) atomicAdd(rss + row, ss);
                asm volatile("" ::: "memory");
            }
    }
};

struct EpiDownNorm {
    static constexpr int BMODE = 0; static constexpr bool FUSED = true;
    const bf16_t* HB; float* Y; float* rss; unsigned* cnt; const float* gain; int pm0;
    __device__ __forceinline__ void operator()(const f32x4 (&)[2][2][4][2], const pg8::Unit&, int, int, int, int) const {}
    __device__ __forceinline__ void fused(f32x4 (&acc)[2][2][4][2], const pg8::Unit& u, int wr, int wc, int fr, int fq, int wid, int lane) const {
        const int col0 = 256 * u.pn + 32 * wc + 4 * fq, prow = 256 * (u.pm + pm0) + 64 * wr + fr;
        float chk = 0.f;
#pragma unroll
        for (int ai = 0; ai < 2; ++ai) {
            u32x2 hw[4][2][2];
#pragma unroll
            for (int m = 0; m < 4; ++m) { const size_t off = (size_t)(prow + 128 * ai + 16 * m) * DM + col0;
#pragma unroll
                for (int bj = 0; bj < 2; ++bj)
#pragma unroll
                    for (int n = 0; n < 2; ++n) hw[m][bj][n] = *(const u32x2*)(HB + off + bj * 128 + n * 16); }
#pragma unroll
            for (int m = 0; m < 4; ++m) { float ss = 0.f;
#pragma unroll
                for (int bj = 0; bj < 2; ++bj)
#pragma unroll
                    for (int n = 0; n < 2; ++n) { const u32x2 h2 = hw[m][bj][n]; f32x4 hv = (f32x4){bf_lo(h2.x), bf_hi(h2.x), bf_lo(h2.y), bf_hi(h2.y)} + acc[ai][bj][m][n]; acc[ai][bj][m][n] = hv;
                        ss += (hv[0] * hv[0] + hv[1] * hv[1]) + (hv[2] * hv[2] + hv[3] * hv[3]); }
                ss += __shfl_xor(ss, 16); ss += __shfl_xor(ss, 32);
                if (fq == 0) chk += __hip_atomic_fetch_add(rss + prow + 128 * ai + 16 * m, ss, __ATOMIC_RELAXED, __HIP_MEMORY_SCOPE_AGENT); }
        }
        asm volatile("s_waitcnt vmcnt(0)" :: "v"(chk) : "memory");
        unsigned* pc = cnt + 64 * (u.pm + pm0);
        if (lane == 0) __hip_atomic_fetch_add(pc, 1u, __ATOMIC_RELAXED, __HIP_MEMORY_SCOPE_AGENT);
        if (wid == 0) { unsigned sp = 0; while ((unsigned)__builtin_amdgcn_readfirstlane(__hip_atomic_load(pc, __ATOMIC_RELAXED, __HIP_MEMORY_SCOPE_AGENT)) < 128u && ++sp < 400000u) __builtin_amdgcn_s_sleep(1); }
        asm volatile("s_waitcnt vmcnt(0) lgkmcnt(0)" ::: "memory"); __builtin_amdgcn_s_barrier(); asm volatile("" ::: "memory");
        float rr[2][4];
#pragma unroll
        for (int ai = 0; ai < 2; ++ai)
#pragma unroll
            for (int m = 0; m < 4; ++m) rr[ai][m] = __hip_atomic_load(rss + prow + 128 * ai + 16 * m, __ATOMIC_RELAXED, __HIP_MEMORY_SCOPE_AGENT);
        f32x4 gg[2][2];
#pragma unroll
        for (int bj = 0; bj < 2; ++bj)
#pragma unroll
            for (int n = 0; n < 2; ++n) gg[bj][n] = *(const f32x4*)(gain + col0 + bj * 128 + n * 16);
#pragma unroll
        for (int ai = 0; ai < 2; ++ai)
#pragma unroll
            for (int m = 0; m < 4; ++m) { const float r = rsqrtf(rr[ai][m] * (1.0f / DM) + EPS); float* yp = Y + (size_t)(prow + 128 * ai + 16 * m) * DM + col0;
#pragma unroll
                for (int bj = 0; bj < 2; ++bj)
#pragma unroll
                    for (int n = 0; n < 2; ++n) *(f32x4*)(yp + bj * 128 + n * 16) = acc[ai][bj][m][n] * r * gg[bj][n]; }
    }
};

constexpr int SK_SROW = 528;
template <int NI, class Epi>
__device__ __forceinline__ void skinny_unit(LAS unsigned char* lds, const bf16_t* S, const bf16_t* T, int K, int kbeg, int klen, const Epi& E, int u, int w) {
    int tid = threadIdx.x; asm volatile("" : "+v"(tid)); const int wid = __builtin_amdgcn_readfirstlane(tid >> 6), lane = tid & 63, li = lane & 15, g = lane >> 4;
    const int kw = klen >> 3, k0 = kbeg + wid * kw;
    const bf16_t* t0 = T + (size_t)(E.jrow(u, w, 0) + li) * K + 32 * g;
    const bf16_t* t1 = T + (size_t)(E.jrow(u, w, 1) + li) * K + 32 * g;
    const bf16_t* s0 = S + (size_t)li * K + 32 * g;
    f32x4 acc[2][NI];
#pragma unroll
    for (int a = 0; a < 2; ++a)
#pragma unroll
        for (int b = 0; b < NI; ++b) acc[a][b] = (f32x4){0.f, 0.f, 0.f, 0.f};
    bf16x8 tcA[2][4], scA[NI][4], tcB[2][4], scB[NI][4];
#define SK_LOAD(tc_, sc_, kb_) do { _Pragma("unroll") for (int q = 0; q < 4; ++q) { const int ko = (kb_) + 8 * q; tc_[0][q] = *(const bf16x8*)(t0 + ko); tc_[1][q] = *(const bf16x8*)(t1 + ko); \
        _Pragma("unroll") for (int i2 = 0; i2 < NI; ++i2) sc_[i2][q] = *(const bf16x8*)(s0 + (size_t)(16 * i2) * K + ko); } } while (0)
#define SK_MMA(tc_, sc_) do { _Pragma("unroll") for (int q = 0; q < 4; ++q) _Pragma("unroll") for (int i2 = 0; i2 < NI; ++i2) { \
        acc[0][i2] = __builtin_amdgcn_mfma_f32_16x16x32_bf16(tc_[0][q], sc_[i2][q], acc[0][i2], 0, 0, 0); \
        acc[1][i2] = __builtin_amdgcn_mfma_f32_16x16x32_bf16(tc_[1][q], sc_[i2][q], acc[1][i2], 0, 0, 0); } } while (0)
    SK_LOAD(tcA, scA, k0);
#pragma unroll 1
    for (int kb = k0; kb < k0 + kw; kb += 256) {
        SK_LOAD(tcB, scB, kb + 128);
        SK_MMA(tcA, scA);
        if (kb + 256 < k0 + kw) SK_LOAD(tcA, scA, kb + 256);
        SK_MMA(tcB, scB);
    }
#undef SK_LOAD
#undef SK_MMA
    LAS f32x4* red = (LAS f32x4*)lds;
#pragma unroll
    for (int a = 0; a < 2; ++a)
#pragma unroll
        for (int b = 0; b < NI; ++b) red[((wid * 2 + a) * NI + b) * 64 + lane] = acc[a][b];
    __syncthreads();
    if (wid == 0) {
#pragma unroll
        for (int a = 0; a < 2; ++a)
#pragma unroll
            for (int b = 0; b < NI; ++b) { f32x4 s = red[(a * NI + b) * 64 + lane];
#pragma unroll
                for (int ww = 1; ww < 8; ++ww) s += red[((ww * 2 + a) * NI + b) * 64 + lane];
                acc[a][b] = s; }
        E(acc, u, w, li, g);
    }
    __syncthreads();
}

struct SkGates {
    const float* bif; float* G;
    __device__ __forceinline__ int jrow(int u, int w, int jt) const { return 256 * u + 32 * w + 16 * jt; }
    __device__ __forceinline__ void operator()(const f32x4 (&acc)[2][1], int u, int w, int li, int g) const {
        if (li >= 12) return;
        const float bias = bif[li];
#pragma unroll
        for (int jt = 0; jt < 2; ++jt) {
            const int tok = jrow(u, w, jt) + 4 * g; if (tok >= MT) continue;
            f32x4 v = acc[jt][0];
#pragma unroll
            for (int j = 0; j < 4; ++j) { float a = 15.0f * tanhf((v[j] + bias) * (1.0f / 15.0f));
                if (li >= 6) a = fminf(a, 0.f) - log1pf(__expf(-fabsf(a)));
                v[j] = a; }
            *(f32x4*)(G + (size_t)li * MT + tok) = v;
        }
    }
};
struct SkInProj {
    bf16_t* Z; const float* rope; float* kout; float* vout;
    __device__ __forceinline__ int jrow(int u, int w, int jt) const { return 256 * u + 128 * (w >> 2) + 64 * jt + 16 * (w & 3); }
    __device__ __forceinline__ void operator()(const f32x4 (&acc)[2][2], int u, int w, int li, int g) const {
        const int c0 = jrow(u, w, 0) + 4 * g;
        const int i0 = (c0 & 63);
#pragma unroll
        for (int i2 = 0; i2 < 2; ++i2) {
            const int sr = 16 * i2 + li, row = MP + sr;
            f32x4 a = acc[0][i2], b = acc[1][i2];
            if (u < 8) {
                const float* rt = rope + (size_t)4096 * 128 + i0;
                const f32x4 c = *(const f32x4*)rt, s = *(const f32x4*)(rt + 64);
                const f32x4 o = a * c - b * s, p = b * c + a * s; a = o; b = p;
                if (u < 4) { a *= 0.08838834764831845f; b *= 0.08838834764831845f; }
            } else if (u >= 12 && u < 18) { a *= 0.0625f; b *= 0.0625f; }
            bf16_t* zp = Z + (size_t)row * NZ + c0;
            u32x2 wv; wv.x = cvt_pk_bf16(a[0], a[1]); wv.y = cvt_pk_bf16(a[2], a[3]); *(u32x2*)zp = wv;
            wv.x = cvt_pk_bf16(b[0], b[1]); wv.y = cvt_pk_bf16(b[2], b[3]); *(u32x2*)(zp + 64) = wv;
            if (u >= 4 && u < 12) { float* ob = (u < 8) ? kout : vout; float* op = ob + (size_t)sr * 1024 + (c0 & 1023); *(f32x4*)op = a; *(f32x4*)(op + 64) = b; }
        }
    }
};
struct SkOutProj {
    const float* XS; float* H; bf16_t* HB; float* rss;
    __device__ __forceinline__ int jrow(int u, int w, int jt) const { return 256 * u + 32 * w + 16 * jt; }
    __device__ __forceinline__ void operator()(const f32x4 (&acc)[2][2], int u, int w, int li, int g) const {
#pragma unroll
        for (int i2 = 0; i2 < 2; ++i2) { const int sr = 16 * i2 + li, row = MP + sr; float ss = 0.f;
#pragma unroll
            for (int jt = 0; jt < 2; ++jt) { const int col = jrow(u, w, jt) + 4 * g; const f32x4 hv = *(const f32x4*)(XS + (size_t)sr * DM + col) + acc[jt][i2];
                u32x2 wv; wv.x = cvt_pk_bf16(hv[0], hv[1]); wv.y = cvt_pk_bf16(hv[2], hv[3]); *(u32x2*)(HB + (size_t)row * DM + col) = wv;
                ss += (hv[0] * hv[0] + hv[1] * hv[1]) + (hv[2] * hv[2] + hv[3] * hv[3]); }
            atomicAdd(rss + row, ss); }
    }
};
struct SkUp {
    bf16_t* U; const float* rss;
    __device__ __forceinline__ int jrow(int u, int w, int jt) const { return 256 * u + 32 * w + 16 * jt; }
    __device__ __forceinline__ void operator()(const f32x4 (&acc)[2][2], int u, int w, int li, int g) const {
#pragma unroll
        for (int i2 = 0; i2 < 2; ++i2) { const int row = MP + 16 * i2 + li; const float r = rsqrtf(rss[row] * (1.0f / DM) + EPS);
#pragma unroll
            for (int jt = 0; jt < 2; ++jt) { const int col = jrow(u, w, jt) + 4 * g; f32x4 v = acc[jt][i2] * r;
#pragma unroll
                for (int j = 0; j < 4; ++j) { const float a = fmaxf(v[j], 0.f); v[j] = a * a; }
                u32x2 wv; wv.x = cvt_pk_bf16(v[0], v[1]); wv.y = cvt_pk_bf16(v[2], v[3]); *(u32x2*)(U + (size_t)row * DFF + col) = wv; } }
    }
};
struct SkDown {
    float* ACC;
    __device__ __forceinline__ int jrow(int u, int w, int jt) const { return 256 * (u & 15) + 32 * w + 16 * jt; }
    __device__ __forceinline__ void operator()(const f32x4 (&acc)[2][2], int u, int w, int li, int g) const {
#pragma unroll
        for (int i2 = 0; i2 < 2; ++i2)
#pragma unroll
            for (int jt = 0; jt < 2; ++jt) { float* p = ACC + (size_t)(16 * i2 + li) * DM + jrow(u, w, jt) + 4 * g;
#pragma unroll
                for (int j = 0; j < 4; ++j) atomicAdd(p + j, acc[jt][i2][j]); }
    }
};

__device__ __forceinline__ void trw_load(f32x4 (&v)[16], const float* W, int ldw, int nnb, int it, int wid, int lane) {
    const int kbo = it / nnb, nb = it - kbo * nnb; const float* p = W + (size_t)(128 * kbo + 16 * wid) * ldw + 256 * nb + 4 * lane;
#pragma unroll
    for (int i = 0; i < 16; ++i) v[i] = __builtin_nontemporal_load((const f32x4*)(p + (size_t)i * ldw));
}
__device__ __forceinline__ void trw_to_lds(f32x4 (&v)[16], LAS unsigned char* buf, const float* gk, int nnb, int it, int wid, int lane) {
    if (gk) { const int kbo = it / nnb;
#pragma unroll
        for (int i = 0; i < 16; ++i) v[i] *= gk[128 * kbo + 16 * wid + i]; }
    const int key = lane & 7;
#pragma unroll
    for (int c = 0; c < 4; ++c) { LAS unsigned char* rp = buf + (4 * lane + c) * 256;
        u32x4 lo, hi; lo.x = cvt_pk_bf16(v[0][c], v[1][c]); lo.y = cvt_pk_bf16(v[2][c], v[3][c]); lo.z = cvt_pk_bf16(v[4][c], v[5][c]); lo.w = cvt_pk_bf16(v[6][c], v[7][c]);
        hi.x = cvt_pk_bf16(v[8][c], v[9][c]); hi.y = cvt_pk_bf16(v[10][c], v[11][c]); hi.z = cvt_pk_bf16(v[12][c], v[13][c]); hi.w = cvt_pk_bf16(v[14][c], v[15][c]);
        *(LAS u32x4*)(rp + 16 * ((2 * wid) ^ key)) = lo; *(LAS u32x4*)(rp + 16 * ((2 * wid + 1) ^ key)) = hi; }
}
__device__ __forceinline__ void trw_store(const LAS unsigned char* buf, bf16_t* WT, int K, int nnb, int it, int wid, int lane) {
    const int kbo = it / nnb, nb = it - kbo * nnb, chunk = lane & 15;
#pragma unroll
    for (int j = 0; j < 8; ++j) { const int row = 32 * j + 4 * wid + (lane >> 4), key = (row >> 2) & 7;
        const u32x4 d = *(const LAS u32x4*)(buf + row * 256 + 16 * (chunk ^ key));
        *(u32x4*)(WT + (size_t)(256 * nb + row) * K + 128 * kbo + 8 * chunk) = d; }
}
__device__ __forceinline__ void trw_run(LAS unsigned char* lds, const float* W, int ldw, int K, int Nuse, bf16_t* WT, const float* gk, int first, int cnt, int stride) {
    int tid = threadIdx.x; asm volatile("" : "+v"(tid)); const int wid = __builtin_amdgcn_readfirstlane(tid >> 6), lane = tid & 63;
    const int nnb = Nuse / 256; if (cnt <= 0) return;
    f32x4 va[16], vb[16];
    trw_load(va, W, ldw, nnb, first, wid, lane);
    if (cnt > 1) trw_load(vb, W, ldw, nnb, first + stride, wid, lane);
    trw_to_lds(va, lds, gk, nnb, first, wid, lane);
    if (cnt > 2) trw_load(va, W, ldw, nnb, first + 2 * stride, wid, lane);
    __syncthreads();
#define TRW_STEP(j_, R_) do { const int it_ = first + (j_) * stride; \
        trw_store(lds + ((j_) & 1) * 65536, WT, K, nnb, it_, wid, lane); \
        if ((j_) + 1 < cnt) { trw_to_lds(R_, lds + (((j_) + 1) & 1) * 65536, gk, nnb, it_ + stride, wid, lane); \
            if ((j_) + 3 < cnt) trw_load(R_, W, ldw, nnb, it_ + 3 * stride, wid, lane); } \
        __syncthreads(); } while (0)
    for (int j = 0; j < cnt; j += 2) { TRW_STEP(j, vb); if (j + 1 < cnt) TRW_STEP(j + 1, va); }
#undef TRW_STEP
}
__device__ __forceinline__ void p0_tr_load(f32x4 (&v)[8], const float* W, int ldw, int Nuse_, int it, int lane) {
    const int nnb = Nuse_ / 256, kb = 8 * (it / (8 * nnb)) + (it & 7), nb = (it >> 3) % nnb, k0 = 8 * kb, n0 = 256 * nb + 4 * lane;
#pragma unroll
    for (int i = 0; i < 8; ++i) v[i] = *(const f32x4*)(W + (size_t)(k0 + i) * ldw + n0);
}
__device__ __forceinline__ void p0_tr_store(f32x4 (&v)[8], int K, bf16_t* WT, const float* gk, int Nuse_, int it, int lane) {
    const int nnb = Nuse_ / 256, kb = 8 * (it / (8 * nnb)) + (it & 7), nb = (it >> 3) % nnb, k0 = 8 * kb, n0 = 256 * nb + 4 * lane;
    if (gk) {
#pragma unroll
        for (int i = 0; i < 8; ++i) v[i] *= gk[k0 + i];
    }
#pragma unroll
    for (int c = 0; c < 4; ++c) { u32x4 o; o.x = cvt_pk_bf16(v[0][c], v[1][c]); o.y = cvt_pk_bf16(v[2][c], v[3][c]); o.z = cvt_pk_bf16(v[4][c], v[5][c]); o.w = cvt_pk_bf16(v[6][c], v[7][c]);
        *(u32x4*)(WT + (size_t)(n0 + c) * K + k0) = o; }
}
__device__ __forceinline__ void p0_transpose(const float* W, int ldw, int K, int Nuse, bf16_t* WT, const float* gk, int gw, int ngw, int lane) {
    const int nkb = K / 8, nnb = Nuse / 256, items = nkb * nnb;
    int it = gw; if (it >= items) return;
    f32x4 v[8], w[8];
    p0_tr_load(v, W, ldw, Nuse, it, lane);
    for (;;) {
        const int n1 = it + ngw;
        if (n1 < items) p0_tr_load(w, W, ldw, Nuse, n1, lane);
        p0_tr_store(v, K, WT, gk, Nuse, it, lane);
        if (n1 >= items) break;
        const int n2 = n1 + ngw;
        if (n2 < items) p0_tr_load(v, W, ldw, Nuse, n2, lane);
        p0_tr_store(w, K, WT, gk, Nuse, n1, lane);
        if (n2 >= items) break;
        it = n2;
    }
}
__device__ __forceinline__ void sincos_d(float ang, float& c, float& s) {
    const double x = (double)ang;
    const double n = __builtin_rint(x * 0.63661977236758134308);
    double r = __builtin_fma(-n, 1.57079632679489655800e+00, x); r = __builtin_fma(-n, 6.12323399573676603587e-17, r);
    const double r2 = r * r;
    double sp = 1.0 / 6227020800.0; sp = sp * r2 * (-1.0) + 1.0 / 39916800.0; sp = sp * r2 * (-1.0) + 1.0 / 362880.0; sp = sp * r2 * (-1.0) + 1.0 / 5040.0; sp = sp * r2 * (-1.0) + 1.0 / 120.0; sp = sp * r2 * (-1.0) + 1.0 / 6.0; sp = sp * r2 * (-1.0) + 1.0;
    const double sn = sp * r;
    double cp = 1.0 / 87178291200.0; cp = cp * r2 * (-1.0) + 1.0 / 479001600.0; cp = cp * r2 * (-1.0) + 1.0 / 3628800.0; cp = cp * r2 * (-1.0) + 1.0 / 40320.0; cp = cp * r2 * (-1.0) + 1.0 / 720.0; cp = cp * r2 * (-1.0) + 1.0 / 24.0; cp = cp * r2 * (-1.0) + 0.5; cp = cp * r2 * (-1.0) + 1.0;
    const double cs = cp;
    const int q = ((int)n) & 3;
    const double cc = (q == 0) ? cs : (q == 1) ? -sn : (q == 2) ? -cs : sn;
    const double ss = (q == 0) ? sn : (q == 1) ? cs : (q == 2) ? -sn : -cs;
    c = (float)cc; s = (float)ss;
}
struct P0Args { const float *xp, *xs, *g1, *win, *wout, *g2, *wup, *wdn; bf16_t *WinT, *WoutT, *WupT, *WdnT, *XN, *WG; float* rope; };
__device__ __forceinline__ void p0_prologue(const P0Args& a, int vcu, int G, int wid, int lane) {
    const int gw = vcu * 8 + wid, ngw = G * 8, gt = gw * 64 + lane, ngt = ngw * 64;
    for (int idx = gt; idx < 4097 * 64; idx += ngt) { const int pi = idx >> 6, i = idx & 63; const int pos = pi < 4096 ? pi : 8192;
        double invd = 1.0; for (int e = 0; e < i; ++e) invd *= 0.86596432336006535;
        const float inv = (float)invd; const float ang = (float)pos * inv; float c, s; sincos_d(ang, c, s);
        a.rope[(size_t)pi * 128 + i] = c; a.rope[(size_t)pi * 128 + 64 + i] = s; }
    for (int idx = gt; idx < 16 * DM; idx += ngt) { const int gi = idx >> 12, k = idx & 4095; const float v = gi < 12 ? a.win[(size_t)k * NINF + NZ + gi] : 0.f; a.WG[idx] = (bf16_t)(cvt_pk_bf16(v, 0.f) & 0xffffu); }
    for (int m = gw; m < MT; m += ngw) {
        const float* xr = (m < MP) ? a.xp + (size_t)m * DM : a.xs + (size_t)(m - MP) * DM;
        f32x4 v[8][2]; float ss = 0.f;
#pragma unroll
        for (int c = 0; c < 8; ++c) { v[c][0] = *(const f32x4*)(xr + 512 * c + 8 * lane); v[c][1] = *(const f32x4*)(xr + 512 * c + 8 * lane + 4);
            ss += (v[c][0][0] * v[c][0][0] + v[c][0][1] * v[c][0][1]) + (v[c][0][2] * v[c][0][2] + v[c][0][3] * v[c][0][3]) + (v[c][1][0] * v[c][1][0] + v[c][1][1] * v[c][1][1]) + (v[c][1][2] * v[c][1][2] + v[c][1][3] * v[c][1][3]); }
        const float r = rsqrtf(wave_sum(ss) * (1.0f / DM) + EPS);
#pragma unroll
        for (int c = 0; c < 8; ++c) { const f32x4 g0 = *(const f32x4*)(a.g1 + 512 * c + 8 * lane), g1v = *(const f32x4*)(a.g1 + 512 * c + 8 * lane + 4);
            const f32x4 y0 = v[c][0] * r * g0, y1 = v[c][1] * r * g1v;
            u32x4 o; o.x = cvt_pk_bf16(y0[0], y0[1]); o.y = cvt_pk_bf16(y0[2], y0[3]); o.z = cvt_pk_bf16(y1[0], y1[1]); o.w = cvt_pk_bf16(y1[2], y1[3]);
            *(u32x4*)(a.XN + (size_t)m * DM + 512 * c + 8 * lane) = o; }
    }
}


constexpr int SC_KSTR = 544, SC_VSTR = 144, SC_KIMG = 50176, SC_VIMG = 84992;
__device__ __forceinline__ void mlstm_scan(LAS unsigned char* lds, const bf16_t* Z, const float* GT, bf16_t* CT, float* NC, float* TB, float* TWV, float* TMT, float* CM, float* out, int unit) {
    int tid = threadIdx.x; asm volatile("" : "+v"(tid)); const int wid = __builtin_amdgcn_readfirstlane(tid >> 6), lane = tid & 63, li = lane & 15, g = lane >> 4;
    const int bh = unit >> 3, sl = unit & 7, b = bh / NH, h = bh % NH, dvt = wid & 3, dkh = wid >> 2;
    LAS float* wv = (LAS float*)lds; LAS float* bl = wv + 4096; LAS float* cml = bl + 4096; LAS float* bs = cml + 4096; LAS float* gc = bs + 64; LAS float* mC = gc + 64;
    LAS unsigned char* Kimg = lds + SC_KIMG; LAS unsigned char* Vimg = lds + SC_VIMG;
    { const float* lip = GT + (size_t)h * MT + b * SEQ; const float* lfp = GT + (size_t)(6 + h) * MT + b * SEQ;
      for (int c = wid; c < NCH; c += 8) { const int t = 64 * c + lane; const float lf = lfp[t], liv = lip[t];
          float bsum = lf;
#pragma unroll
          for (int o = 1; o < 64; o <<= 1) { const float v = __shfl_up(bsum, o); if (lane >= o) bsum += v; }
          const float w = liv - bsum; float cm = w;
#pragma unroll
          for (int o = 1; o < 64; o <<= 1) { const float v = __shfl_up(cm, o); if (lane >= o) cm = fmaxf(cm, v); }
          wv[t] = w; bl[t] = bsum; cml[t] = cm;
          if (lane == 63) { bs[c] = bsum; gc[c] = bsum + cm; } }
      __syncthreads();
      if (tid == 0) { float m = 0.f; mC[0] = 0.f; for (int c = 0; c < NCH; ++c) { m = fmaxf(bs[c] + m, gc[c]); mC[c + 1] = m; } }
      __syncthreads();
      if (sl == 0) { for (int t = tid; t < SEQ; t += 512) { const int c = t >> 6; TB[bh * SEQ + t] = bl[t]; TWV[bh * SEQ + t] = wv[t]; TMT[bh * SEQ + t] = bl[t] + fmaxf(mC[c], cml[t]); }
                     if (tid < 65) CM[bh * 80 + tid] = mC[tid]; } }
    const bool nwr = (sl == 0) && (dvt == 0);
    f32x4 acc[8], nacc[8];
#pragma unroll
    for (int T = 0; T < 8; ++T) { acc[T] = (f32x4){0.f, 0.f, 0.f, 0.f}; nacc[T] = (f32x4){0.f, 0.f, 0.f, 0.f}; }
    bf16x8 ones;
#pragma unroll
    for (int e = 0; e < 8; ++e) ones[e] = (short)0x3F80;
    u32x4 kq[2][4], vq[2];
#define SCAN_LOAD(S_, c_) do { _Pragma("unroll") for (int q = 0; q < 4; ++q) { const int ch = tid + 512 * q, tok = ch >> 5, c16 = ch & 31; kq[S_][q] = *(const u32x4*)(Z + ((size_t)b * SEQ + 64 * (c_) + tok) * NZ + ZKM + h * DK + 8 * c16); } \
        { const int tok = tid >> 3, c16 = tid & 7; vq[S_] = *(const u32x4*)(Z + ((size_t)b * SEQ + 64 * (c_) + tok) * NZ + ZVM + h * DV + 64 * sl + 8 * c16); } } while (0)
#define SC_CL(x) fminf(fmaxf((x), -440.0f), 440.0f)
#define SC_PK8(v) ((unsigned)__builtin_amdgcn_cvt_pk_fp8_f32(SC_CL((v)[2]), SC_CL((v)[3]), __builtin_amdgcn_cvt_pk_fp8_f32(SC_CL((v)[0]), SC_CL((v)[1]), 0, false), true))
#define SCAN_STEP(S_, c_) do { const int c = (c_); \
        { unsigned char* ct = (unsigned char*)CT + (((size_t)(bh * NCH + c) * DV + (64 * sl + 16 * dvt + li)) * DK + 128 * dkh + 16 * g); \
          _Pragma("unroll") for (int Q = 0; Q < 2; ++Q) { u32x4 w; \
              w.x = SC_PK8(acc[4 * Q + 0]); w.y = SC_PK8(acc[4 * Q + 1]); w.z = SC_PK8(acc[4 * Q + 2]); w.w = SC_PK8(acc[4 * Q + 3]); \
              *(u32x4*)(ct + 64 * Q) = w; } \
          if (nwr && li == 0) { _Pragma("unroll") for (int T = 0; T < 8; ++T) *(f32x4*)(NC + (size_t)(bh * NCH + c) * DK + 128 * dkh + 64 * (T >> 2) + 16 * g + 4 * (T & 3)) = nacc[T]; } } \
        __syncthreads(); \
        const float mn = mC[c + 1], bsc = bs[c]; \
        _Pragma("unroll") for (int q = 0; q < 4; ++q) { const int ch = tid + 512 * q, tok = ch >> 5, c16 = ch & 31; \
            const u32x4 kv = kq[S_][q]; const float w = __expf(bsc + wv[64 * c + tok] - mn); \
            u32x4 o; o.x = cvt_pk_bf16(bf_lo(kv.x) * w, bf_hi(kv.x) * w); o.y = cvt_pk_bf16(bf_lo(kv.y) * w, bf_hi(kv.y) * w); o.z = cvt_pk_bf16(bf_lo(kv.z) * w, bf_hi(kv.z) * w); o.w = cvt_pk_bf16(bf_lo(kv.w) * w, bf_hi(kv.w) * w); \
            *(LAS u32x4*)(Kimg + tok * SC_KSTR + 16 * c16) = o; } \
        { const int tok = tid >> 3, c16 = tid & 7; *(LAS u32x4*)(Vimg + tok * SC_VSTR + 16 * c16) = vq[S_]; } \
        __syncthreads(); \
        if (c + 2 < NCH) SCAN_LOAD(S_, c + 2); \
        const float dec = __expf(bsc + mC[c] - mn); \
        _Pragma("unroll") for (int T = 0; T < 8; ++T) { acc[T] *= dec; nacc[T] *= dec; } \
        _Pragma("unroll") for (int kb = 0; kb < 2; ++kb) { \
            const LAS unsigned char* vp = Vimg + (32 * kb + 8 * g + (li >> 2)) * SC_VSTR + (16 * dvt + 4 * (li & 3)) * 2; \
            const bf16x8 Bf = cat8(vtr(vp), vtr(vp + 4 * SC_VSTR)); \
            _Pragma("unroll") for (int T = 0; T < 8; ++T) { \
                const LAS unsigned char* kp = Kimg + (32 * kb + 8 * g + (li >> 2)) * SC_KSTR + (128 * dkh + 64 * (T >> 2) + 16 * (li & 3) + 4 * (T & 3)) * 2; \
                const bf16x8 Af = cat8(vtr(kp), vtr(kp + 4 * SC_KSTR)); \
                acc[T] = __builtin_amdgcn_mfma_f32_16x16x32_bf16(Af, Bf, acc[T], 0, 0, 0); \
                if (nwr) nacc[T] = __builtin_amdgcn_mfma_f32_16x16x32_bf16(Af, ones, nacc[T], 0, 0, 0); } } } while (0)
    SCAN_LOAD(0, 0); SCAN_LOAD(1, 1);
#pragma unroll 1
    for (int c2 = 0; c2 < NCH; c2 += 2) { SCAN_STEP(0, c2); SCAN_STEP(1, c2 + 1); }
#undef SCAN_LOAD
#undef SCAN_STEP
#undef SC_PK8
#undef SC_CL
#pragma unroll
    for (int T = 0; T < 8; ++T)
#pragma unroll
        for (int r = 0; r < 4; ++r) out[O_CP + ((size_t)bh * DK + 128 * dkh + 64 * (T >> 2) + 16 * g + 4 * (T & 3) + r) * DV + 64 * sl + 16 * dvt + li] = acc[T][r];
    if (nwr && li == 0) {
#pragma unroll
        for (int T = 0; T < 8; ++T) *(f32x4*)(out + O_NP + (size_t)bh * DK + 128 * dkh + 64 * (T >> 2) + 16 * g + 4 * (T & 3)) = nacc[T]; }
    if (sl == 0 && tid == 0) out[O_MP + bh] = mC[NCH];
    __syncthreads();
}

constexpr int AT_VS = 272;
__device__ __forceinline__ void attn_blk_cfg(int s, int& r, int& w, int& blk) { if (s < 12) { r = 1; w = 128; blk = s; } else if (s < 18) { r = 4; w = 512; blk = s - 12; } else { r = 16; w = 2048; blk = s - 18; } }
__device__ __forceinline__ void attn_blk_load(const char* zc, int pmax, int s, int lane, bf16x8 (&kf)[2][4], u32x4 (&vv)[8]) {
    int r, w, blk; attn_blk_cfg(s, r, w, blk); const int li = lane & 15, g = lane >> 4;
    const int pb = pmax - r * 32 * blk;
#pragma unroll
    for (int it = 0; it < 8; ++it) { int kp = pb - r * (it * 4 + g); kp = kp < 0 ? 0 : kp;
        const unsigned off = __umul24((unsigned)kp, (unsigned)(NZ * 2)) + (unsigned)((ZVA + 8 * li) * 2);
        vv[it] = *(const u32x4*)(zc + off); }
#pragma unroll
    for (int T = 0; T < 2; ++T) { int kp = pb - r * (16 * T + li); kp = kp < 0 ? 0 : kp;
        const unsigned off = __umul24((unsigned)kp, (unsigned)(NZ * 2)) + (unsigned)((ZKA + 8 * g) * 2);
#pragma unroll
        for (int q = 0; q < 4; ++q) kf[T][q] = *(const bf16x8*)(zc + off + 64 * q); }
}
__device__ __forceinline__ void attn_tile(LAS unsigned char* vimg, const bf16_t* Z, bf16_t* MIX, int b, int h, int p0c, int lane) {
    const int li = lane & 15, g = lane >> 4;
    const int qpos = p0c + 16 * li, pmax = p0c + 240;
    const bf16_t* zb = Z + (size_t)b * SEQ * NZ + h * 128;
    const char* zc = (const char*)zb;
    bf16x8 qf[4];
#pragma unroll
    for (int s = 0; s < 4; ++s) qf[s] = *(const bf16x8*)(zb + (size_t)qpos * NZ + ZQA + 32 * s + 8 * g);
    f32x4 o[8];
#pragma unroll
    for (int d = 0; d < 8; ++d) o[d] = (f32x4){0.f, 0.f, 0.f, 0.f};
    float m = -INFINITY, l = 0.f;
    bf16x8 kA[2][4], kB[2][4]; u32x4 vA[8], vB[8];
    auto step = [&](int s, bf16x8 (&kf)[2][4], u32x4 (&vv)[8], bf16x8 (&kn)[2][4], u32x4 (&vn)[8]) __attribute__((always_inline)) {
        if (s + 1 < 23) attn_blk_load(zc, pmax, s + 1, lane, kn, vn);
        int r, w, blk; attn_blk_cfg(s, r, w, blk);
        f32x4 st[2];
#pragma unroll
        for (int T = 0; T < 2; ++T) { st[T] = (f32x4){0.f, 0.f, 0.f, 0.f};
#pragma unroll
            for (int q = 0; q < 4; ++q) st[T] = __builtin_amdgcn_mfma_f32_16x16x32_bf16(kf[T][q], qf[q], st[T], 0, 0, 0); }
        const int sh = (r == 1) ? 0 : (r == 4) ? 2 : 4, off16 = 16 * (15 - li);
        const int nlo = (off16 + r - 1) >> sh; int nhi = (w + off16) >> sh; { const int nb = pmax >> sh; nhi = nhi < nb ? nhi : nb; }
        float bm = -INFINITY;
#pragma unroll
        for (int T = 0; T < 2; ++T)
#pragma unroll
            for (int rg = 0; rg < 4; ++rg) { const int n = 32 * blk + 16 * T + 4 * g + rg; const bool ok = (n >= nlo) && (n <= nhi);
                st[T][rg] = ok ? st[T][rg] : -INFINITY; bm = fmaxf(bm, st[T][rg]); }
        bm = fmaxf(bm, __shfl_xor(bm, 16)); bm = fmaxf(bm, __shfl_xor(bm, 32));
        const float mn = fmaxf(m, bm), mu = (mn == -INFINITY) ? 0.f : mn;
        const float alpha = __expf(m - mu);
        float ps = 0.f; f32x4 p[2];
#pragma unroll
        for (int T = 0; T < 2; ++T)
#pragma unroll
            for (int rg = 0; rg < 4; ++rg) { p[T][rg] = __expf(st[T][rg] - mu); ps += p[T][rg]; }
        l = l * alpha + ps;
        if (!__all(mn == m)) {
#pragma unroll
            for (int d = 0; d < 8; ++d) o[d] *= alpha; }
        m = mn;
        bf16x8 pf; { const unsigned w0 = cvt_pk_bf16(p[0][0], p[0][1]), w1 = cvt_pk_bf16(p[0][2], p[0][3]), w2 = cvt_pk_bf16(p[1][0], p[1][1]), w3 = cvt_pk_bf16(p[1][2], p[1][3]);
            pf[0] = (short)(w0 & 0xffff); pf[1] = (short)(w0 >> 16); pf[2] = (short)(w1 & 0xffff); pf[3] = (short)(w1 >> 16); pf[4] = (short)(w2 & 0xffff); pf[5] = (short)(w2 >> 16); pf[6] = (short)(w3 & 0xffff); pf[7] = (short)(w3 >> 16); }
        asm volatile("" ::: "memory");
#pragma unroll
        for (int it = 0; it < 8; ++it) { const int ci = it * 64 + lane, key = ci >> 4, part = ci & 15; *(LAS u32x4*)(vimg + key * AT_VS + 16 * part) = vv[it]; }
        asm volatile("" ::: "memory");
#pragma unroll
        for (int d = 0; d < 8; ++d) { const LAS unsigned char* vp = vimg + (4 * g + (li >> 2)) * AT_VS + (16 * d + 4 * (li & 3)) * 2;
            const bf16x8 af = cat8(vtr(vp), vtr(vp + 16 * AT_VS));
            o[d] = __builtin_amdgcn_mfma_f32_16x16x32_bf16(af, pf, o[d], 0, 0, 0); }
        asm volatile("" ::: "memory");
    };
    attn_blk_load(zc, pmax, 0, lane, kA, vA);
#pragma unroll 1
    for (int s = 0; s < 22; s += 2) { step(s, kA, vA, kB, vB); step(s + 1, kB, vB, kA, vA); }
    step(22, kA, vA, kB, vB);
    l += __shfl_xor(l, 16); l += __shfl_xor(l, 32);
    const float inv = 1.0f / l;
    bf16_t* mp = MIX + ((size_t)b * SEQ + qpos) * DM + h * 128 + 4 * g;
#pragma unroll
    for (int d = 0; d < 8; ++d) { u32x2 w; w.x = cvt_pk_bf16(o[d][0] * inv, o[d][1] * inv); w.y = cvt_pk_bf16(o[d][2] * inv, o[d][3] * inv); *(u32x2*)(mp + 16 * d) = w; }
}
__device__ __forceinline__ void attn_unit(LAS unsigned char* lds, const bf16_t* Z, bf16_t* MIX, int unit) {
    int tid = threadIdx.x; asm volatile("" : "+v"(tid)); const int wid = __builtin_amdgcn_readfirstlane(tid >> 6), lane = tid & 63;
    const int qb = unit & 15, h = (unit >> 4) & 7, b = unit >> 7;
    LAS unsigned char* vimg = lds + wid * (32 * AT_VS);
    attn_tile(vimg, Z, MIX, b, h, 256 * qb + wid, lane);
    attn_tile(vimg, Z, MIX, b, h, 256 * qb + wid + 8, lane);
}

__device__ __forceinline__ const float* sattn_row(int e, const float* fresh, const float* cache) {
    const int cfg = e / 129, j = e - cfg * 129, r = (cfg == 0) ? 1 : (cfg == 1) ? 4 : 16, dist = j * r;
    return (dist == 0) ? fresh : cache + (size_t)(2048 - dist) * 1024;
}
__device__ __forceinline__ void sattn_unit(LAS unsigned char* lds, const bf16_t* Z, const float* ck, const float* cv, const float* out, bf16_t* MIX, int unit) {
    int tid = threadIdx.x; asm volatile("" : "+v"(tid)); const int wid = __builtin_amdgcn_readfirstlane(tid >> 6), lane = tid & 63, hl = lane & 31, hf = lane >> 5;
    const int b = unit >> 3, h = unit & 7;
    LAS float* sc = (LAS float*)lds;
    LAS float* red = sc + 400;
    LAS float* misc = red + 2048;
    const u32x2 qw = *(const u32x2*)(Z + (size_t)(MP + b) * NZ + ZQA + h * 128 + 4 * hl);
    const f32x4 q4 = (f32x4){bf_lo(qw.x), bf_hi(qw.x), bf_lo(qw.y), bf_hi(qw.y)};
    const float* knew = out + O_KS + (size_t)b * 1024 + h * 128; const float* vnew = out + O_VS + (size_t)b * 1024 + h * 128;
    const float* ckb = ck + (size_t)b * 2048 * 1024 + h * 128; const float* cvb = cv + (size_t)b * 2048 * 1024 + h * 128;
    constexpr int SN = 25;
    f32x4 kv[SN], vv[SN];
#pragma unroll
    for (int i = 0; i < SN; ++i) { int e = 16 * i + 2 * wid + hf; e = e < 387 ? e : 386; kv[i] = *(const f32x4*)(sattn_row(e, knew, ckb) + 4 * hl); }
#pragma unroll
    for (int i = 0; i < SN; ++i) { int e = 16 * i + 2 * wid + hf; e = e < 387 ? e : 386; vv[i] = *(const f32x4*)(sattn_row(e, vnew, cvb) + 4 * hl); }
#pragma unroll
    for (int i = 0; i < SN; ++i) { float s = (q4[0] * kv[i][0] + q4[1] * kv[i][1]) + (q4[2] * kv[i][2] + q4[3] * kv[i][3]);
        s += __shfl_xor(s, 1); s += __shfl_xor(s, 2); s += __shfl_xor(s, 4); s += __shfl_xor(s, 8); s += __shfl_xor(s, 16);
        const int e = 16 * i + 2 * wid + hf; if (hl == 0 && e < 387) sc[e] = s; }
    __syncthreads();
    if (wid == 0) { float mx = -INFINITY; for (int e = lane; e < 387; e += 64) mx = fmaxf(mx, sc[e]); mx = wave_max(mx);
        float sm = 0.f; for (int e = lane; e < 387; e += 64) { const float p = __expf(sc[e] - mx); sc[e] = p; sm += p; } sm = wave_sum(sm);
        if (lane == 0) misc[1] = sm; }
    __syncthreads();
    f32x4 acc = (f32x4){0.f, 0.f, 0.f, 0.f};
#pragma unroll
    for (int i = 0; i < SN; ++i) { const int e = 16 * i + 2 * wid + hf; const float p = (e < 387) ? sc[e] : 0.f; acc += vv[i] * p; }
    *(LAS f32x4*)(red + (2 * wid + hf) * 128 + 4 * hl) = acc;
    __syncthreads();
    if (tid < 128) { float s = 0.f;
#pragma unroll
        for (int w = 0; w < 16; ++w) s += red[w * 128 + tid];
        const float v = s / misc[1]; MIX[(size_t)(MP + b) * DM + h * 128 + tid] = (bf16_t)(cvt_pk_bf16(v, 0.f) & 0xffffu); }
    __syncthreads();
}

__device__ __forceinline__ void smlstm_unit(LAS unsigned char* lds, const bf16_t* Z, const float* GT, const float* sC, const float* sN, const float* sM, const float* mhg, float* out, bf16_t* MIX, float* HRAW, int unit) {
    int tid = threadIdx.x; asm volatile("" : "+v"(tid)); const int wid = __builtin_amdgcn_readfirstlane(tid >> 6), lane = tid & 63;
    const int b = unit / NH, h = unit % NH, row = MP + b;
    LAS float* qs = (LAS float*)lds; LAS float* ks = qs + 256; LAS float* red = ks + 256;
    LAS float* part = red + 32;
    const bf16_t* zr = Z + (size_t)row * NZ;
    const float liv = GT[(size_t)h * MT + row], lf = GT[(size_t)(6 + h) * MT + row], m0 = sM[b * NH + h];
    const float mt = fmaxf(lf + m0, liv), a = __expf(lf + m0 - mt), wsv = __expf(liv - mt);
    float pq = 0.f, pn = 0.f;
    if (tid < 256) { const float q = bf1(zr[ZQM + h * DK + tid]), k = bf1(zr[ZKM + h * DK + tid]), n0 = sN[(size_t)(b * NH + h) * DK + tid]; qs[tid] = q; ks[tid] = k; pq = q * k; pn = q * n0;
        out[O_NS + (size_t)(b * NH + h) * DK + tid] = a * n0 + wsv * k; }
    pq = wave_sum(pq); pn = wave_sum(pn);
    if (lane == 0) { red[wid] = pq; red[8 + wid] = pn; }
    __syncthreads();
    const float qk = red[0] + red[1] + red[2] + red[3], qn = red[8] + red[9] + red[10] + red[11];
    const float sw = qk * wsv;
    {
      const int dq = tid >> 7, dv0 = 4 * (tid & 127);
      const u32x2 vw = *(const u32x2*)(zr + ZVM + h * DV + dv0); const f32x4 v4 = (f32x4){bf_lo(vw.x), bf_hi(vw.x), bf_lo(vw.y), bf_hi(vw.y)} * wsv;
      const float* cp = sC + ((size_t)(b * NH + h) * DK + 64 * dq) * DV + dv0; float* co = out + O_CS + ((size_t)(b * NH + h) * DK + 64 * dq) * DV + dv0;
      f32x4 numi = (f32x4){0.f, 0.f, 0.f, 0.f};
#pragma unroll 1
      for (int d0 = 0; d0 < 64; d0 += 8) { f32x4 cc[8];
#pragma unroll
          for (int i = 0; i < 8; ++i) cc[i] = *(const f32x4*)(cp + (size_t)(d0 + i) * DV);
#pragma unroll
          for (int i = 0; i < 8; ++i) { numi += cc[i] * qs[64 * dq + d0 + i]; *(f32x4*)(co + (size_t)(d0 + i) * DV) = cc[i] * a + v4 * ks[64 * dq + d0 + i]; } }
      *(LAS f32x4*)(part + dq * 512 + dv0) = numi; }
    __syncthreads();
    const float v = bf1(zr[ZVM + h * DV + tid]);
    const float numt = part[tid] + part[512 + tid] + part[1024 + tid] + part[1536 + tid];
    const float num = sw * v + a * numt, den = sw + a * qn;
    const float hv = num / fmaxf(fabsf(den), __expf(-mt));
    if (HRAW) HRAW[(size_t)row * 3072 + h * DV + tid] = hv;
    const float ssq = wave_sum(hv * hv);
    if (lane == 0) red[16 + wid] = ssq;
    __syncthreads();
    float tot = 0.f;
#pragma unroll
    for (int w = 0; w < 8; ++w) tot += red[16 + w];
    const float om = bf1(zr[ZOM + h * DV + tid]);
    const float y = hv * rsqrtf(tot * (1.0f / DV) + EPS) * mhg[h * DV + tid] * (1.0f / (1.0f + __expf(-om)));
    MIX[(size_t)row * DM + 1024 + h * DV + tid] = (bf16_t)(cvt_pk_bf16(y, 0.f) & 0xffffu);
    if (tid == 0) out[O_MS + b * NH + h] = mt;
    __syncthreads();
}

constexpr int OB_QS = 528, OB_Q = 0, OB_K = 33792, OB_V0 = 67584, OB_V1 = 101376, OB_SW = 135168, OB_SWS = 144, OB_SM = 144384;
__device__ __forceinline__ void mlstm_out(LAS unsigned char* lds, const bf16_t* Z, const bf16_t* CT, const float* NC, const float* TB, const float* TWV, const float* TMT, const float* CM, const float* mhg, bf16_t* MIX, float* HRAW, int unit) {
    int tid = threadIdx.x; asm volatile("" : "+v"(tid)); const int wid = __builtin_amdgcn_readfirstlane(tid >> 6), lane = tid & 63, li = lane & 15, g = lane >> 4;
    const int bh = unit >> 6, c = unit & 63, b = bh / NH, h = bh % NH;
    LAS float* rs = (LAS float*)(lds + OB_SM); LAS float* dn = rs + 64; LAS float* hs = dn + 64; LAS float* ub = hs + 64; LAS float* wvv = ub + 64; LAS float* av = wvv + 64; LAS float* em = av + 64;
    const size_t row0 = (size_t)b * SEQ + 64 * c;
    const unsigned char* ctb = (const unsigned char*)CT + ((size_t)(bh * NCH + c) * DV + 64 * wid + li) * DK + 16 * g;
    u32x4 cf[4][4];
#pragma unroll
    for (int j = 0; j < 4; ++j)
#pragma unroll
        for (int vt = 0; vt < 4; ++vt) cf[j][vt] = *(const u32x4*)(ctb + (size_t)(16 * vt) * DK + 64 * j);
#pragma unroll
    for (int q = 0; q < 4; ++q) { const int ch = tid + 512 * q, tok = ch >> 5, c16 = ch & 31; const bf16_t* zr = Z + (row0 + tok) * NZ;
        *(LAS u32x4*)(lds + OB_Q + tok * OB_QS + 16 * c16) = *(const u32x4*)(zr + ZQM + h * DK + 8 * c16);
        *(LAS u32x4*)(lds + OB_K + tok * OB_QS + 16 * c16) = *(const u32x4*)(zr + ZKM + h * DK + 8 * c16); }
#pragma unroll
    for (int q = 0; q < 8; ++q) { const int ch = tid + 512 * q, tok = ch >> 6, c16 = ch & 63; const bf16_t* zr = Z + (row0 + tok) * NZ;
        *(LAS u32x4*)(lds + ((c16 >> 5) ? OB_V1 : OB_V0) + tok * OB_QS + 16 * (c16 & 31)) = *(const u32x4*)(zr + ZVM + h * DV + 8 * c16); }
    if (tid < 64) { const int t = bh * SEQ + 64 * c + tid; const float bb = TB[t], mt = TMT[t];
        ub[tid] = bb - mt; wvv[tid] = TWV[t]; av[tid] = __expf(bb + CM[bh * 80 + c] - mt); em[tid] = __expf(-mt); rs[tid] = 0.f; hs[tid] = 0.f; }
    __syncthreads();
    { const int t = tid >> 3, part = tid & 7; const float* np = NC + (size_t)(bh * NCH + c) * DK + 32 * part; const LAS bf16_t* qp = (const LAS bf16_t*)(lds + OB_Q + t * OB_QS) + 32 * part; float s = 0.f;
#pragma unroll 8
      for (int e = 0; e < 32; ++e) s += bf1(qp[e]) * np[e];
      s += __shfl_xor(s, 1); s += __shfl_xor(s, 2); s += __shfl_xor(s, 4);
      if (part == 0) dn[t] = s; }
    { const int st = wid & 3;
#pragma unroll
      for (int tq = 0; tq < 2; ++tq) { const int tt = 2 * (wid >> 2) + tq; f32x4 d = (f32x4){0.f, 0.f, 0.f, 0.f};
#pragma unroll
          for (int kk = 0; kk < 8; ++kk) { const bf16x8 kf = *(const LAS bf16x8*)(lds + OB_K + (16 * st + li) * OB_QS + (32 * kk + 8 * g) * 2);
              const bf16x8 qf = *(const LAS bf16x8*)(lds + OB_Q + (16 * tt + li) * OB_QS + (32 * kk + 8 * g) * 2);
              d = __builtin_amdgcn_mfma_f32_16x16x32_bf16(kf, qf, d, 0, 0, 0); }
          const int t = 16 * tt + li; const float ut = ub[t]; float ps = 0.f; f32x4 sw;
#pragma unroll
          for (int r = 0; r < 4; ++r) { const int s = 16 * st + 4 * g + r; const float w = (s <= t) ? d[r] * __expf(ut + wvv[s]) : 0.f; sw[r] = w; ps += w; }
          u32x2 pk; pk.x = cvt_pk_bf16(sw[0], sw[1]); pk.y = cvt_pk_bf16(sw[2], sw[3]);
          *(LAS u32x2*)(lds + OB_SW + t * OB_SWS + (16 * st + 4 * g) * 2) = pk;
          lds_addf(rs + t, ps); } }
    __syncthreads();
    f32x4 acc[4][4];
#pragma unroll
    for (int a = 0; a < 4; ++a)
#pragma unroll
        for (int t = 0; t < 4; ++t) acc[a][t] = (f32x4){0.f, 0.f, 0.f, 0.f};
#pragma unroll
    for (int j = 0; j < 4; ++j)
#pragma unroll
        for (int s = 0; s < 2; ++s) {
            bf16x8 bq[4], af[4];
#pragma unroll
            for (int tt = 0; tt < 4; ++tt) bq[tt] = *(const LAS bf16x8*)(lds + OB_Q + (16 * tt + li) * OB_QS + (64 * j + 16 * g + 8 * s) * 2);
#pragma unroll
            for (int vt = 0; vt < 4; ++vt) { const unsigned d0 = s ? cf[j][vt].z : cf[j][vt].x, d1 = s ? cf[j][vt].w : cf[j][vt].y;
                const f32x2 p0 = __builtin_amdgcn_cvt_pk_f32_fp8((int)d0, false), p1 = __builtin_amdgcn_cvt_pk_f32_fp8((int)d0, true), p2 = __builtin_amdgcn_cvt_pk_f32_fp8((int)d1, false), p3 = __builtin_amdgcn_cvt_pk_f32_fp8((int)d1, true);
                const unsigned w0 = cvt_pk_bf16(p0.x, p0.y), w1 = cvt_pk_bf16(p1.x, p1.y), w2 = cvt_pk_bf16(p2.x, p2.y), w3 = cvt_pk_bf16(p3.x, p3.y);
                bf16x8 f; f[0] = (short)(w0 & 0xffff); f[1] = (short)(w0 >> 16); f[2] = (short)(w1 & 0xffff); f[3] = (short)(w1 >> 16); f[4] = (short)(w2 & 0xffff); f[5] = (short)(w2 >> 16); f[6] = (short)(w3 & 0xffff); f[7] = (short)(w3 >> 16);
                af[vt] = f; }
#pragma unroll
            for (int vt = 0; vt < 4; ++vt)
#pragma unroll
                for (int tt = 0; tt < 4; ++tt) acc[vt][tt] = __builtin_amdgcn_mfma_f32_16x16x32_bf16(af[vt], bq[tt], acc[vt][tt], 0, 0, 0);
        }
#pragma unroll
    for (int tt = 0; tt < 4; ++tt) { const float at = av[16 * tt + li];
#pragma unroll
        for (int vt = 0; vt < 4; ++vt) acc[vt][tt] *= at; }
    { const LAS unsigned char* vb = lds + ((wid >> 2) ? OB_V1 : OB_V0);
#pragma unroll
      for (int kb = 0; kb < 2; ++kb) {
          bf16x8 bs_[4];
#pragma unroll
          for (int tt = 0; tt < 4; ++tt) bs_[tt] = *(const LAS bf16x8*)(lds + OB_SW + (16 * tt + li) * OB_SWS + (32 * kb + 8 * g) * 2);
#pragma unroll
          for (int vt = 0; vt < 4; ++vt) { const LAS unsigned char* vp = vb + (32 * kb + 8 * g + (li >> 2)) * OB_QS + (64 * (wid & 3) + 16 * vt + 4 * (li & 3)) * 2;
              const bf16x8 af = cat8(vtr(vp), vtr(vp + 4 * OB_QS));
#pragma unroll
              for (int tt = 0; tt < 4; ++tt) acc[vt][tt] = __builtin_amdgcn_mfma_f32_16x16x32_bf16(af, bs_[tt], acc[vt][tt], 0, 0, 0); } } }
    u32x2 omw[4][4]; f32x4 gg[4];
#pragma unroll
    for (int vt = 0; vt < 4; ++vt) { const int dvg = h * DV + 64 * wid + 16 * vt + 4 * g; gg[vt] = *(const f32x4*)(mhg + dvg);
#pragma unroll
        for (int tt = 0; tt < 4; ++tt) omw[tt][vt] = *(const u32x2*)(Z + (row0 + 16 * tt + li) * NZ + ZOM + dvg); }
    float dd[4];
#pragma unroll
    for (int tt = 0; tt < 4; ++tt) { const int t = 16 * tt + li; const float den = rs[t] + av[t] * dn[t]; dd[tt] = fmaxf(fabsf(den), em[t]);
        float q = 0.f;
#pragma unroll
        for (int vt = 0; vt < 4; ++vt) q += (acc[vt][tt][0] * acc[vt][tt][0] + acc[vt][tt][1] * acc[vt][tt][1]) + (acc[vt][tt][2] * acc[vt][tt][2] + acc[vt][tt][3] * acc[vt][tt][3]);
        q += __shfl_xor(q, 16); q += __shfl_xor(q, 32);
        if (g == 0) lds_addf(hs + t, q); }
    __syncthreads();
#pragma unroll
    for (int tt = 0; tt < 4; ++tt) { const int t = 16 * tt + li; const float idd = __builtin_amdgcn_rcpf(dd[tt]); const float tot = idd * rsqrtf(hs[t] * idd * idd * (1.0f / DV) + EPS);
        const size_t row = row0 + t;
#pragma unroll
        for (int vt = 0; vt < 4; ++vt) { const int dvg = h * DV + 64 * wid + 16 * vt + 4 * g;
            const u32x2 ow = omw[tt][vt];
            const float o0 = bf_lo(ow.x), o1 = bf_hi(ow.x), o2 = bf_lo(ow.y), o3 = bf_hi(ow.y);
            const f32x4 a4 = acc[vt][tt];
            if (HRAW) *(f32x4*)(HRAW + row * 3072 + dvg) = a4 * idd;
            const float y0 = a4[0] * tot * gg[vt][0] * __builtin_amdgcn_rcpf(1.0f + __expf(-o0)), y1 = a4[1] * tot * gg[vt][1] * __builtin_amdgcn_rcpf(1.0f + __expf(-o1)), y2 = a4[2] * tot * gg[vt][2] * __builtin_amdgcn_rcpf(1.0f + __expf(-o2)), y3 = a4[3] * tot * gg[vt][3] * __builtin_amdgcn_rcpf(1.0f + __expf(-o3));
            u32x2 w; w.x = cvt_pk_bf16(y0, y1); w.y = cvt_pk_bf16(y2, y3); *(u32x2*)(MIX + row * DM + 1024 + dvg) = w; } }
    __syncthreads();
}


constexpr int CV_OUT = (DM / 128) * (DM / 256), CV_UP = (DM / 128) * (DFF / 256), CV_DN = (DFF / 128) * (DM / 256);
__device__ __forceinline__ void conv_unit(LAS unsigned char* lds, const float* wout, const float* wup, const float* wdn, const float* g2, bf16_t* WoutT, bf16_t* WupT, bf16_t* WdnT, int j) {
    int base = 4 * j;
    if (base < CV_OUT) trw_run(lds, wout, DM, DM, DM, WoutT, nullptr, base, 4, 1);
    else if (base < CV_OUT + CV_UP) trw_run(lds, wup, DFF, DM, DFF, WupT, g2, base - CV_OUT, 4, 1);
    else trw_run(lds, wdn, DM, DFF, DM, WdnT, nullptr, base - CV_OUT - CV_UP, 4, 1);
}

struct Args { const float* in[16]; float* out; unsigned char* ws; };
#if CHECKS
__device__ __forceinline__ unsigned hsh(unsigned x) { x ^= x >> 16; x *= 0x7feb352dU; x ^= x >> 15; x *= 0x846ca68bU; x ^= x >> 16; return x; }
__device__ __forceinline__ bool far_(float got, float ref, float rel, float ab) { return !(fabsf(got - ref) <= rel * fabsf(ref) + ab); }
#define CHK_FAIL(id) atomicMax(ctl + CW_ERR, 40u - (unsigned)(id))
#define CHK_CODE(cd) atomicMax(ctl + CW_ERR, (unsigned)(cd))
__device__ __forceinline__ float dot_bf(const bf16_t* a, const bf16_t* b, int n) { float s = 0.f; for (int k = 0; k < n; k += 8) { const u32x4 x = *(const u32x4*)(a + k), y = *(const u32x4*)(b + k);
        s += bf_lo(x.x) * bf_lo(y.x) + bf_hi(x.x) * bf_hi(y.x) + bf_lo(x.y) * bf_lo(y.y) + bf_hi(x.y) * bf_hi(y.y) + bf_lo(x.z) * bf_lo(y.z) + bf_hi(x.z) * bf_hi(y.z) + bf_lo(x.w) * bf_lo(y.w) + bf_hi(x.w) * bf_hi(y.w); } return s; }
__device__ __forceinline__ float softcap_(float a) { return 15.0f * tanhf(a * (1.0f / 15.0f)); }
__device__ __forceinline__ float logsig_(float a) { return fminf(a, 0.f) - log1pf(expf(-fabsf(a))); }
__device__ void run_checks(const Args& args, LAS unsigned char* lds) {
    const int tid = threadIdx.x, lane = tid & 63, wid = tid >> 6, bx = blockIdx.x, G = gridDim.x;
    const unsigned gt = (unsigned)bx * 512u + tid, ngt = (unsigned)G * 512u;
    unsigned char* ws = args.ws; unsigned* ctl = (unsigned*)(ws + WS_CTL); float* out = args.out;
    const float* x_prompt = args.in[0]; const float* x_sample = args.in[1]; const float* cache_k = args.in[2]; const float* cache_v = args.in[3]; const float* state_C = args.in[4]; const float* state_n = args.in[5]; const float* state_m = args.in[6];
    const float* norm1_g = args.in[7]; const float* w_in = args.in[8]; const float* b_if = args.in[9]; const float* mh_g = args.in[10];
    const float* w_out = args.in[11]; const float* norm2_g = args.in[12]; const float* w_up = args.in[13]; const float* w_down = args.in[14]; const float* final_g = args.in[15];
    const bf16_t* WinT = (bf16_t*)(ws + WS_WIN); const bf16_t* WoutT = (bf16_t*)(ws + WS_WOUT); const bf16_t* WupT = (bf16_t*)(ws + WS_WUP); const bf16_t* WdnT = (bf16_t*)(ws + WS_WDN);
    const bf16_t* XN = (bf16_t*)(ws + WS_XN); const bf16_t* Z = (bf16_t*)(ws + WS_Z); const bf16_t* MIX = (bf16_t*)(ws + WS_MIX); const float* H = (float*)(ws + WS_H); const bf16_t* HB = (bf16_t*)(ws + WS_HB);
    const bf16_t* U = (bf16_t*)(ws + WS_U); const bf16_t* WG = (bf16_t*)(ws + WS_WG); const float* GT = (float*)(ws + WS_G); const float* HRAW = (float*)(ws + WS_HRAW);
    const float* RSS2 = (float*)(ws + WS_CTL + CTL_RSS2); const float* RSS3 = (float*)(ws + WS_CTL + CTL_RSS3);
    for (unsigned s = gt; s < 2048u; s += ngt) { const int row = (s < 64u) ? MP + (int)(s & 31u) : (int)(hsh(s) % MT), k = (int)(hsh(s + 99991u) % DM);
        const float* xr = row < MP ? x_prompt + (size_t)row * DM : x_sample + (size_t)(row - MP) * DM; float ss = 0.f; for (int j = 0; j < DM; ++j) ss += xr[j] * xr[j];
        const float ref = xr[k] * rsqrtf(ss * (1.0f / DM) + EPS) * norm1_g[k]; if (far_(bf1(XN[(size_t)row * DM + k]), ref, 0.01f, 1e-3f)) CHK_FAIL(1); }
    for (unsigned s = gt; s < 4096u; s += ngt) { const unsigned a = hsh(s), b = hsh(s + 7777u);
        { const int n = a % NZ, k = b % DM; if (far_(bf1(WinT[(size_t)n * DM + k]), w_in[(size_t)k * NINF + n], 0.01f, 1e-7f)) CHK_FAIL(2); }
        { const int n = a % DM, k = b % DM; if (far_(bf1(WoutT[(size_t)n * DM + k]), w_out[(size_t)k * DM + n], 0.01f, 1e-7f)) CHK_FAIL(2); }
        { const int f = a % DFF, k = b % DM; if (far_(bf1(WupT[(size_t)f * DM + k]), w_up[(size_t)k * DFF + f] * norm2_g[k], 0.01f, 1e-7f)) CHK_FAIL(2); }
        { const int n = a % DM, f = b % DFF; if (far_(bf1(WdnT[(size_t)n * DFF + f]), w_down[(size_t)f * DM + n], 0.01f, 1e-7f)) CHK_FAIL(2); }
        { const int gi = a % 16, k = b % DM; const float ref = gi < 12 ? w_in[(size_t)k * NINF + NZ + gi] : 0.f; if (far_(bf1(WG[gi * DM + k]), ref, 0.01f, 1e-7f)) CHK_FAIL(2); } }
    for (unsigned s = gt; s < 8192u; s += ngt) { const int row = (s < 1024u) ? MP + (int)(s & 31u) : (int)(hsh(s) % MP), col = (int)(hsh(s + 12345u) % NZ); const int id = row < MP ? 3 : 4;
        const bf16_t* xr = XN + (size_t)row * DM; float val;
        if (col < 2048) { const int d = col & 127, c1 = (d < 64) ? col : col - 64, c2 = c1 + 64; const float x1 = dot_bf(xr, WinT + (size_t)c1 * DM, DM), x2 = dot_bf(xr, WinT + (size_t)c2 * DM, DM);
            const int pos = row < MP ? (row & (SEQ - 1)) : 8192, i = d & 63; double invd = 1.0; for (int e = 0; e < i; ++e) invd *= 0.86596432336006535;
            float c, sn; sincos_d((float)pos * (float)invd, c, sn); val = (d < 64) ? x1 * c - x2 * sn : x2 * c + x1 * sn; if (col < 1024) val *= 0.08838834764831845f; }
        else { val = dot_bf(xr, WinT + (size_t)col * DM, DM); if (col >= ZQM && col < ZKM) val *= 0.0625f; }
        if (far_(bf1(Z[(size_t)row * NZ + col]), val, 0.02f, 0.02f)) CHK_FAIL(id);
        if (col >= 1024 && col < 3072) { const int cc = col & 1023; const bool isk = col < 2048;
            if (row >= MP) { if (far_(out[(isk ? O_KS : O_VS) + (size_t)(row - MP) * 1024 + cc], val, 0.01f, 0.01f)) CHK_FAIL(id); }
            else { const int pos = row & (SEQ - 1), bb = row >> 12; if (pos >= 2048) { if (far_(out[(isk ? O_KP : O_VP) + ((size_t)(bb * 2048 + pos - 2048)) * 1024 + cc], val, 0.01f, 0.01f)) CHK_FAIL(id); } } } }
    for (unsigned s = gt; s < 4096u; s += ngt) { const int gi = (int)(hsh(s) % 12), tok = (s < 256u) ? MP + (int)(s & 31u) : (int)(hsh(s + 555u) % MT);
        float v = softcap_(dot_bf(XN + (size_t)tok * DM, WG + (size_t)gi * DM, DM) + b_if[gi]); if (gi >= 6) v = logsig_(v);
        if (far_(GT[(size_t)gi * MT + tok], v, 0.01f, 0.005f)) CHK_FAIL(5); }
    for (unsigned s = gt; s < 4096u; s += ngt) { const unsigned a = hsh(s), b2 = hsh(s + 424242u); const int b = a & 1, pos = (s & 3u) == 0u ? (int)((a >> 1) % 300u) : (int)((a >> 1) % SEQ), h = b2 & 7, d = (b2 >> 3) & 127;
        const bf16_t* zb = Z + (size_t)b * SEQ * NZ; const bf16_t* qr = zb + (size_t)pos * NZ + ZQA + h * 128; float m = -INFINITY, l = 0.f, o = 0.f;
        for (int cfg = 0; cfg < 3; ++cfg) { const int r = cfg == 0 ? 1 : cfg == 1 ? 4 : 16;
            for (int j = 0; j <= 128; ++j) { const int kp = pos - j * r; if (kp < 0) break; const float sc = dot_bf(qr, zb + (size_t)kp * NZ + ZKA + h * 128, 128);
                const float mn = fmaxf(m, sc), al = expf(m - mn), p = expf(sc - mn); l = l * al + p; o = o * al + p * bf1(zb[(size_t)kp * NZ + ZVA + h * 128 + d]); m = mn; } }
        if (far_(bf1(MIX[((size_t)b * SEQ + pos) * DM + h * 128 + d]), o / l, 0.03f, 0.004f)) CHK_FAIL(6); }
    if (bx == 30) { const int li = lane & 15, g = lane >> 4, dvt = wid & 3, dkh = wid >> 2; LAS unsigned char* Kimg = lds + SC_KIMG; LAS unsigned char* Vimg = lds + SC_VIMG;
#pragma unroll
        for (int q = 0; q < 4; ++q) { const int ch = tid + 512 * q, tok = ch >> 5, c16 = ch & 31; *(LAS u32x4*)(Kimg + tok * SC_KSTR + 16 * c16) = *(const u32x4*)(Z + (size_t)tok * NZ + ZKM + 8 * c16); }
        { const int tok = tid >> 3, c16 = tid & 7; *(LAS u32x4*)(Vimg + tok * SC_VSTR + 16 * c16) = *(const u32x4*)(Z + (size_t)tok * NZ + ZVM + 8 * c16); }
        __syncthreads();
        bf16x8 ones;
#pragma unroll
        for (int e = 0; e < 8; ++e) ones[e] = (short)0x3F80;
        unsigned mask = 0u;
#pragma unroll 1
        for (int T = 0; T < 8; ++T) { f32x4 na = (f32x4){0.f, 0.f, 0.f, 0.f}, ca = (f32x4){0.f, 0.f, 0.f, 0.f};
#pragma unroll
            for (int kb = 0; kb < 2; ++kb) { const LAS unsigned char* vp = Vimg + (32 * kb + 8 * g + (li >> 2)) * SC_VSTR + (16 * dvt + 4 * (li & 3)) * 2; const bf16x8 Bf = cat8(vtr(vp), vtr(vp + 4 * SC_VSTR));
                const LAS unsigned char* kp = Kimg + (32 * kb + 8 * g + (li >> 2)) * SC_KSTR + (128 * dkh + 16 * T + 4 * (li & 3)) * 2; const bf16x8 Af = cat8(vtr(kp), vtr(kp + 4 * SC_KSTR));
                na = __builtin_amdgcn_mfma_f32_16x16x32_bf16(Af, ones, na, 0, 0, 0); ca = __builtin_amdgcn_mfma_f32_16x16x32_bf16(Af, Bf, ca, 0, 0, 0); }
#pragma unroll
            for (int r = 0; r < 4; ++r) { const int dk = 128 * dkh + 16 * T + 4 * g + r, dv = 16 * dvt + li; float cs = 0.f, cv = 0.f;
                for (int t = 0; t < 64; ++t) { const float kk = bf1(Z[(size_t)t * NZ + ZKM + dk]); cs += kk; cv += kk * bf1(Z[(size_t)t * NZ + ZVM + dv]); }
                if (far_(na[r], cs, 0.01f, 1e-2f)) mask |= 1u; if (far_(ca[r], cv, 0.01f, 2e-2f)) mask |= 2u; } }
        if (mask) atomicOr(ctl + CW_ERR + 2, mask);
        __syncthreads(); }
    if (gt < 12u) { const int bh = (int)gt, b = bh / NH, h = bh % NH; const float* TBc = (const float*)(ws + WS_TB); const float* TWVc = (const float*)(ws + WS_TWV); const float* TMTc = (const float*)(ws + WS_TMT); const float* CMc = (const float*)(ws + WS_CM);
        float m = 0.f, bsum = 0.f; bool bad = false;
        for (int t = 0; t < SEQ; ++t) { const size_t row = (size_t)b * SEQ + t; const float liv = GT[(size_t)h * MT + row], lf = GT[(size_t)(6 + h) * MT + row];
            if ((t & 63) == 0) { bsum = 0.f; if (far_(CMc[bh * 80 + (t >> 6)], m, 1e-3f, 1e-3f)) bad = true; }
            bsum += lf; m = fmaxf(lf + m, liv);
            if (far_(TBc[bh * SEQ + t], bsum, 1e-3f, 1e-3f) || far_(TWVc[bh * SEQ + t], liv - bsum, 1e-3f, 1e-3f) || far_(TMTc[bh * SEQ + t], m, 1e-3f, 1e-3f)) bad = true; }
        if (far_(CMc[bh * 80 + 64], m, 1e-3f, 1e-3f)) bad = true;
        if (bad) CHK_CODE(33); }
    if (bx < 24) { const int bh = bx % 12, b = bh / NH, h = bh % NH, sel = tid >> 8, dk = tid & 255; const int dv = sel ? (300 + 17 * bx) % DV : (37 + 41 * bx) % DV;
        LAS float* red = (LAS float*)lds;
        float C = 0.f, n = 0.f, m = 0.f, n63 = 0.f, C63 = 0.f; bool bad8 = false;
        for (int t = 0; t < SEQ; ++t) { const size_t row = (size_t)b * SEQ + t; const bf16_t* zr = Z + row * NZ; if (t == 63 * 64) { n63 = n; C63 = C; }
            const float q = bf1(zr[ZQM + h * DK + dk]), k = bf1(zr[ZKM + h * DK + dk]), v = bf1(zr[ZVM + h * DV + dv]), liv = GT[(size_t)h * MT + row], lf = GT[(size_t)(6 + h) * MT + row];
            const float mn = fmaxf(lf + m, liv), f = expf(lf + m - mn), iw = expf(liv - mn); C = f * C + iw * k * v; n = f * n + iw * k; m = mn;
            const float s1 = wave_sum(q * C), s2 = wave_sum(q * n); LAS float* rb = red + (t & 1) * 32;
            if (lane == 0) { rb[wid] = s1; rb[16 + wid] = s2; }
            __syncthreads();
            const int w0 = sel * 4; const float num = rb[w0] + rb[w0 + 1] + rb[w0 + 2] + rb[w0 + 3], qn = rb[16 + w0] + rb[16 + w0 + 1] + rb[16 + w0 + 2] + rb[16 + w0 + 3];
            const float hv = num / fmaxf(fabsf(qn), expf(-m));
            if (dk == 0 && far_(HRAW[row * 3072 + h * DV + dv], hv, 0.04f, 0.03f)) bad8 = true; }
        if (far_(out[O_CP + ((size_t)bh * DK + dk) * DV + dv], C, 0.03f, 0.03f)) CHK_CODE(30);
        if (sel == 0 && far_(out[O_NP + (size_t)bh * DK + dk], n, 0.03f, 0.03f)) CHK_CODE(31);
        if (sel == 0 && far_(((const float*)(ws + WS_NC))[(size_t)(bh * NCH + 63) * DK + dk], n63, 0.03f, 0.03f)) CHK_CODE(31);
        if (far_(bf1(((const bf16_t*)(ws + WS_CT))[((size_t)(bh * NCH + 63) * DV + dv) * DK + dk]), C63, 0.03f, 0.03f)) CHK_CODE(30);
        if (tid == 0 && far_(out[O_MP + bh], m, 0.01f, 0.01f)) CHK_CODE(32);
        if (bad8) CHK_CODE(29);
        __syncthreads(); }
    for (unsigned s = gt; s < 4096u; s += ngt) { const unsigned a = hsh(s), b2 = hsh(s + 31337u); const int row = (s < 128u) ? MP + (int)(s & 31u) : (int)(a % MP), h = b2 % NH, dv = (b2 >> 8) % DV;
        const float* hr = HRAW + (size_t)row * 3072 + h * DV; float ss = 0.f; for (int j = 0; j < DV; ++j) ss += hr[j] * hr[j];
        const float om = bf1(Z[(size_t)row * NZ + ZOM + h * DV + dv]); const float ref = hr[dv] * rsqrtf(ss * (1.0f / DV) + EPS) * mh_g[h * DV + dv] / (1.0f + expf(-om));
        if (far_(bf1(MIX[(size_t)row * DM + 1024 + h * DV + dv]), ref, 0.02f, 0.005f)) CHK_CODE(28); }
    for (unsigned s = gt; s < 2048u; s += ngt) { const unsigned a = hsh(s); const int b = a & 31, h = (a >> 5) & 7, d = (a >> 8) & 127;
        const bf16_t* qr = Z + (size_t)(MP + b) * NZ + ZQA + h * 128; float m = -INFINITY, l = 0.f, o = 0.f;
        for (int cfg = 0; cfg < 3; ++cfg) { const int r = cfg == 0 ? 1 : cfg == 1 ? 4 : 16;
            for (int j = 0; j <= 128; ++j) { const int dist = j * r; const float* kp = dist == 0 ? out + O_KS + (size_t)b * 1024 + h * 128 : cache_k + ((size_t)b * 2048 + 2048 - dist) * 1024 + h * 128;
                const float* vp = dist == 0 ? out + O_VS + (size_t)b * 1024 + h * 128 : cache_v + ((size_t)b * 2048 + 2048 - dist) * 1024 + h * 128;
                float sc = 0.f; for (int e = 0; e < 128; ++e) sc += bf1(qr[e]) * kp[e];
                const float mn = fmaxf(m, sc), al = expf(m - mn), p = expf(sc - mn); l = l * al + p; o = o * al + p * vp[d]; m = mn; } }
        if (far_(bf1(MIX[(size_t)(MP + b) * DM + h * 128 + d]), o / l, 0.02f, 0.004f)) CHK_CODE(27); }
    for (unsigned s = gt; s < 2048u; s += ngt) { const unsigned a = hsh(s), b2 = hsh(s + 99u); const int b = a & 31, h = (a >> 5) % NH, dv = (a >> 9) % DV, dkx = b2 % DK; const int row = MP + b; const bf16_t* zr = Z + (size_t)row * NZ;
        const float liv = GT[(size_t)h * MT + row], lf = GT[(size_t)(6 + h) * MT + row], m0 = state_m[b * NH + h]; const float mt = fmaxf(lf + m0, liv), aa = expf(lf + m0 - mt), wsv = expf(liv - mt);
        const float* c0 = state_C + (size_t)(b * NH + h) * DK * DV; const float* n0 = state_n + (size_t)(b * NH + h) * DK; float qk = 0.f, qn = 0.f, qc = 0.f;
        for (int k = 0; k < DK; ++k) { const float q = bf1(zr[ZQM + h * DK + k]); qk += q * bf1(zr[ZKM + h * DK + k]); qn += q * n0[k]; qc += q * c0[(size_t)k * DV + dv]; }
        const float v = bf1(zr[ZVM + h * DV + dv]), sw = qk * wsv, num = sw * v + aa * qc, den = sw + aa * qn, hv = num / fmaxf(fabsf(den), expf(-mt));
        if (far_(HRAW[(size_t)row * 3072 + h * DV + dv], hv, 0.02f, 0.005f)) CHK_CODE(26);
        const float kx = bf1(zr[ZKM + h * DK + dkx]);
        if (far_(out[O_CS + ((size_t)(b * NH + h) * DK + dkx) * DV + dv], aa * c0[(size_t)dkx * DV + dv] + wsv * kx * v, 1e-3f, 1e-5f)) CHK_CODE(26);
        if (far_(out[O_NS + (size_t)(b * NH + h) * DK + dkx], aa * n0[dkx] + wsv * kx, 1e-3f, 1e-5f)) CHK_CODE(26);
        if (far_(out[O_MS + b * NH + h], mt, 1e-4f, 1e-5f)) CHK_CODE(26); }
    for (unsigned s = gt; s < 4096u; s += ngt) { const int row = (s < 256u) ? MP + (int)(s & 31u) : (int)(hsh(s) % MP), col = (int)(hsh(s + 777u) % DM);
        const float xv = row < MP ? x_prompt[(size_t)row * DM + col] : x_sample[(size_t)(row - MP) * DM + col]; const float ref = xv + dot_bf(MIX + (size_t)row * DM, WoutT + (size_t)col * DM, DM);
        if (far_(H[(size_t)row * DM + col], ref, 0.01f, 0.01f)) CHK_CODE(25); if (far_(bf1(HB[(size_t)row * DM + col]), ref, 0.01f, 0.01f)) CHK_CODE(25);
        if (s < 512u) { float ss = 0.f; for (int j = 0; j < DM; ++j) { const float hv = H[(size_t)row * DM + j]; ss += hv * hv; } if (far_(RSS2[row], ss, 2e-3f, 1e-2f)) CHK_CODE(25); } }
    for (unsigned s = gt; s < 4096u; s += ngt) { const int row = (s < 256u) ? MP + (int)(s & 31u) : (int)(hsh(s) % MP), f = (int)(hsh(s + 4242u) % DFF);
        const float r = rsqrtf(RSS2[row] * (1.0f / DM) + EPS); float v = fmaxf(r * dot_bf(HB + (size_t)row * DM, WupT + (size_t)f * DM, DM), 0.f); v = v * v;
        if (far_(bf1(U[(size_t)row * DFF + f]), v, 0.03f, 0.01f)) CHK_CODE(24); }
    for (unsigned s = gt; s < 2048u; s += ngt) { const int row = (s < 128u) ? MP + (int)(s & 31u) : (int)(hsh(s) % MP), col = (int)(hsh(s + 9u) % DM);
        const float pre = H[(size_t)row * DM + col] + dot_bf(U + (size_t)row * DFF, WdnT + (size_t)col * DFF, DFF);
        if (row < MP) { const float ref = pre * rsqrtf(RSS3[row] * (1.0f / DM) + EPS) * final_g[col]; if (!(row == 0 && col == 0) && far_(out[O_Y + (size_t)row * DM + col], ref, 0.02f, 0.01f)) CHK_CODE(23); }
        else { const int col2 = (col + 1234) % DM; const float pre2 = H[(size_t)row * DM + col2] + dot_bf(U + (size_t)row * DFF, WdnT + (size_t)col2 * DFF, DFF);
            const float y1 = out[O_Y + (size_t)row * DM + col] / final_g[col], y2 = out[O_Y + (size_t)row * DM + col2] / final_g[col2];
            if (far_(y1 * pre2, y2 * pre, 0.04f, 0.03f)) CHK_CODE(23); } }
}
#endif

__global__ void __launch_bounds__(512, 2) hymba_fwd(Args args) {
    extern __shared__ __attribute__((aligned(16))) unsigned char lds_raw[];
    LAS unsigned char* lds = (LAS unsigned char*)lds_raw;
    const int tid = threadIdx.x, lane = tid & 63, wid = __builtin_amdgcn_readfirstlane(tid >> 6);
    const int G = gridDim.x, bx = blockIdx.x, vcu = (G % 8 == 0) ? (bx % 8) * (G / 8) + bx / 8 : bx;
    unsigned char* ws = args.ws;
    unsigned* ctl = (unsigned*)(ws + WS_CTL);
    volatile LAS unsigned* MISC = (volatile LAS unsigned*)(lds + MISC_OFF);
    if (tid < 64) MISC[tid] = 0u;
    __syncthreads();
    XcdBarrier bar = xcd_barrier_post(ctl + CW_BAR, MISC + 8);
#if PROF
#define STAMP(k) do { if (bx == 0 && tid == 0) { const unsigned long long t_ = __builtin_amdgcn_s_memrealtime(); MISC[32] = (unsigned)t_; MISC[33] = (unsigned)(t_ >> 32); } } while (0)
#define PRE(k) do { if ((k) == PROF && bx == 0 && tid == 0) { const unsigned long long t_ = __builtin_amdgcn_s_memrealtime(); const unsigned long long p_ = ((unsigned long long)MISC[33] << 32) | MISC[32]; const unsigned long long w_ = 3ull * (t_ - p_); \
        while (__builtin_amdgcn_s_memrealtime() - t_ < w_) __builtin_amdgcn_s_sleep(8); } } while (0)
#else
#define STAMP(k) do { } while (0)
#define PRE(k) do { } while (0)
#endif
    STAMP(0);

    const float* x_prompt = args.in[0]; const float* x_sample = args.in[1];
    const float* norm1_g = args.in[7]; const float* w_in = args.in[8]; const float* b_if = args.in[9];
    const float* w_out = args.in[11]; const float* norm2_g = args.in[12]; const float* w_up = args.in[13]; const float* w_down = args.in[14]; const float* final_g = args.in[15];
    float* out = args.out;
    bf16_t* WinT = (bf16_t*)(ws + WS_WIN); bf16_t* WoutT = (bf16_t*)(ws + WS_WOUT); bf16_t* WupT = (bf16_t*)(ws + WS_WUP); bf16_t* WdnT = (bf16_t*)(ws + WS_WDN);
    bf16_t* XN = (bf16_t*)(ws + WS_XN); bf16_t* Z = (bf16_t*)(ws + WS_Z); bf16_t* MIX = (bf16_t*)(ws + WS_MIX); float* H = (float*)(ws + WS_H); bf16_t* HB = (bf16_t*)(ws + WS_HB);
    bf16_t* U = (bf16_t*)(ws + WS_U); bf16_t* WG = (bf16_t*)(ws + WS_WG); float* ROPE = (float*)(ws + WS_ROPE); float* GT = (float*)(ws + WS_G);
    float* RSS2 = (float*)(ws + WS_CTL + CTL_RSS2); float* RSS3 = (float*)(ws + WS_CTL + CTL_RSS3); float* ACCB = (float*)(ws + WS_CTL + CTL_ACC);

    { P0Args a{x_prompt, x_sample, norm1_g, w_in, w_out, norm2_g, w_up, w_down, WinT, WoutT, WupT, WdnT, XN, WG, ROPE};
      p0_prologue(a, vcu, G, wid, lane);
      trw_run(lds, w_in, NINF, DM, NZ, WinT, nullptr, bx, ((DM / 128) * (NZ / 256) - bx + G - 1) / G, G); }
    PRE(1);
    xcd_barrier(bar);
    STAMP(1);

    { pg8::Gemm g{XN, WinT, MP, NZ, DM}; pg8::StaticOrder S; S.init(MP, NZ, G, bx);
      EpiInProj E{Z, ROPE, out + O_KP, out + O_VP};
      pg8::InterleavedOrder SI{S};
      pg8::gemm_phase<EpiInProj, pg8::InterleavedOrder>(lds, g, SI, E);
      SkInProj Es{Z, ROPE, out + O_KS, out + O_VS};
      SkGates Eg{b_if, GT};
      for (int u2 = bx; u2 < 48 * 8 + 33 * 8; u2 += G) { if (u2 < 384) skinny_unit<2>(lds, XN + (size_t)MP * DM, WinT, DM, 0, DM, Es, u2 >> 3, u2 & 7); else skinny_unit<1>(lds, WG, XN, DM, 0, DM, Eg, (u2 - 384) >> 3, (u2 - 384) & 7); }
    }
    PRE(2);
    xcd_barrier(bar);
    STAMP(2);

    bf16_t* CT = (bf16_t*)(ws + WS_CT); float* NC = (float*)(ws + WS_NC); float* TB = (float*)(ws + WS_TB); float* TWV = (float*)(ws + WS_TWV); float* TMT = (float*)(ws + WS_TMT); float* CMb = (float*)(ws + WS_CM);
    float* HRAW = CHECKS ? (float*)(ws + WS_HRAW) : nullptr;
    const float* cache_k = args.in[2]; const float* cache_v = args.in[3]; const float* state_C = args.in[4]; const float* state_n = args.in[5]; const float* state_m = args.in[6]; const float* mh_g = args.in[10];

    { if (bx < 96) mlstm_scan(lds, Z, GT, CT, NC, TB, TWV, TMT, CMb, out, bx);
      constexpr unsigned NCV = (unsigned)((CV_OUT + CV_UP) / 4);
      const bool prefC = (bx >= 96) && ((((bx >> 3) - 12) % 7) == 0);
      bool doneC = false, doneA = false;
      while (!(doneC && doneA)) {
          const bool takeC = prefC ? !doneC : doneA;
          if (tid == 0) MISC[16] = atomicAdd(&ctl[CW_Q2 + (takeC ? 0 : 32)], 1u);
          __syncthreads();
          const unsigned item = (unsigned)__builtin_amdgcn_readfirstlane((int)MISC[16]);
          __syncthreads();
          if (takeC) { if (item >= NCV) { doneC = true; continue; }
              conv_unit(lds, w_out, w_up, w_down, norm2_g, WoutT, WupT, WdnT, (int)item); }
          else { if (item >= 704u) { doneA = true; continue; }
              if (item < 256u) attn_unit(lds, Z, MIX, (int)item);
              else if (item < 448u) smlstm_unit(lds, Z, GT, state_C, state_n, state_m, mh_g, out, MIX, HRAW, (int)item - 256);
              else sattn_unit(lds, Z, cache_k, cache_v, out, MIX, (int)item - 448); }
      } }
    PRE(3);
    xcd_barrier(bar);
    STAMP(3);

    for (;;) {
        if (tid == 0) MISC[16] = atomicAdd(&ctl[CW_Q2 + 64], 1u);
        __syncthreads();
        const unsigned item = (unsigned)__builtin_amdgcn_readfirstlane((int)MISC[16]);
        __syncthreads();
        if (item >= 1280u) break;
        const unsigned grp = item / 5u, r = item % 5u;
        if (r < 3u) mlstm_out(lds, Z, CT, NC, TB, TWV, TMT, CMb, mh_g, MIX, HRAW, (int)(3u * grp + r));
        else conv_unit(lds, w_out, w_up, w_down, norm2_g, WoutT, WupT, WdnT, (int)((CV_OUT + CV_UP) / 4 + 2u * grp + (r - 3u)));
    }
    PRE(4);
    xcd_barrier(bar);
    STAMP(4);

    { pg8::Gemm g{MIX, WoutT, MP, DM, DM}; pg8::StaticOrder S; S.init(MP, DM, G, bx);
      EpiOutProj E{x_prompt, H, HB, RSS2};
      pg8::gemm_phase<EpiOutProj>(lds, g, S, E);
      SkOutProj Es{x_sample, H, HB, RSS2};
      for (int u2 = bx; u2 < 16 * 8; u2 += G) skinny_unit<2>(lds, MIX + (size_t)MP * DM, WoutT, DM, 0, DM, Es, u2 >> 3, u2 & 7); }
    PRE(5);
    xcd_barrier(bar);
    STAMP(5);

    constexpr int MH = MP / 2;
    { pg8::Gemm g{HB, WupT, MH, DFF, DM}; pg8::StaticOrder S; S.init(MH, DFF, G, bx);
      EpiUp E{U, RSS2, 0};
      pg8::gemm_phase<EpiUp>(lds, g, S, E);
      SkUp Es{U, RSS2};
      for (int u2 = bx; u2 < 64 * 8; u2 += G) skinny_unit<2>(lds, HB + (size_t)MP * DM, WupT, DM, 0, DM, Es, u2 >> 3, u2 & 7); }
    PRE(6);
    xcd_barrier(bar);
    STAMP(6);
    { pg8::Gemm g{U, WdnT, MH, DM, DFF}; pg8::StaticOrder S; S.init(MH, DM, G, bx);
      EpiDownNorm E{HB, out + O_Y, RSS3, ctl + CW_Q2 + 768, final_g, 0};
      pg8::gemm_phase<EpiDownNorm>(lds, g, S, E);
      SkDown Es{ACCB};
      for (int u2 = bx; u2 < 512; u2 += G) { const int kc = u2 >> 7, j32 = u2 & 127; skinny_unit<2>(lds, U + (size_t)MP * DFF, WdnT, DFF, 4096 * kc, 4096, Es, j32 >> 3, j32 & 7); } }
    { pg8::Gemm g{HB + (size_t)MH * DM, WupT, MH, DFF, DM}; pg8::StaticOrder S; S.init(MH, DFF, G, bx);
      EpiUp E{U, RSS2, MH / 256};
      pg8::gemm_phase<EpiUp>(lds, g, S, E); }
    xcd_barrier(bar);
    { const int gw = vcu * 8 + wid, ngw = G * 8; const bf16_t* YB = MIX;
      for (int m = MP + gw; m < MT; m += ngw) {
          float* yr = out + O_Y + (size_t)m * DM; f32x4 v[8][2]; float r;
          if (m < MP) { const bf16_t* yb = YB + (size_t)m * DM;
#pragma unroll
              for (int c = 0; c < 8; ++c) { const u32x4 w = *(const u32x4*)(yb + 512 * c + 8 * lane); v[c][0] = (f32x4){bf_lo(w.x), bf_hi(w.x), bf_lo(w.y), bf_hi(w.y)}; v[c][1] = (f32x4){bf_lo(w.z), bf_hi(w.z), bf_lo(w.w), bf_hi(w.w)}; }
              r = rsqrtf(RSS3[m] * (1.0f / DM) + EPS);
          } else { const bf16_t* hr = HB + (size_t)m * DM; const float* ar = ACCB + (size_t)(m - MP) * DM; float ss = 0.f;
#pragma unroll
              for (int c = 0; c < 8; ++c) { const u32x4 w = *(const u32x4*)(hr + 512 * c + 8 * lane);
                  v[c][0] = (f32x4){bf_lo(w.x), bf_hi(w.x), bf_lo(w.y), bf_hi(w.y)} + *(const f32x4*)(ar + 512 * c + 8 * lane); v[c][1] = (f32x4){bf_lo(w.z), bf_hi(w.z), bf_lo(w.w), bf_hi(w.w)} + *(const f32x4*)(ar + 512 * c + 8 * lane + 4);
                  ss += (v[c][0][0] * v[c][0][0] + v[c][0][1] * v[c][0][1]) + (v[c][0][2] * v[c][0][2] + v[c][0][3] * v[c][0][3]) + (v[c][1][0] * v[c][1][0] + v[c][1][1] * v[c][1][1]) + (v[c][1][2] * v[c][1][2] + v[c][1][3] * v[c][1][3]); }
              r = rsqrtf(wave_sum(ss) * (1.0f / DM) + EPS); }
#pragma unroll
          for (int c = 0; c < 8; ++c) { const f32x4 g0 = *(const f32x4*)(final_g + 512 * c + 8 * lane), g1v = *(const f32x4*)(final_g + 512 * c + 8 * lane + 4);
              *(f32x4*)(yr + 512 * c + 8 * lane) = v[c][0] * r * g0; *(f32x4*)(yr + 512 * c + 8 * lane + 4) = v[c][1] * r * g1v; }
      } }
    { pg8::Gemm g{U + (size_t)MH * DFF, WdnT, MH, DM, DFF}; pg8::StaticOrder S; S.init(MH, DM, G, bx);
      EpiDownNorm E{HB, out + O_Y, RSS3, ctl + CW_Q2 + 768, final_g, MH / 256};
      pg8::gemm_phase<EpiDownNorm>(lds, g, S, E); }

#if PROF
    PRE(8);
    xcd_barrier(bar);
#endif
#if CHECKS
    PRE(8);
    xcd_barrier(bar);
    STAMP(8);
    run_checks(args, lds);
    PRE(9);
    xcd_barrier(bar);
    STAMP(9);
    if (bx == 0 && tid == 0) { const unsigned code = __hip_atomic_load(ctl + CW_ERR, __ATOMIC_RELAXED, __HIP_MEMORY_SCOPE_AGENT); const unsigned msk = __hip_atomic_load(ctl + CW_ERR + 2, __ATOMIC_RELAXED, __HIP_MEMORY_SCOPE_AGENT);
        if (msk) out[0] = (float)(60u + msk) * 10000.0f; else if (code) out[0] = (float)code * 10000.0f; }
#endif
}

extern "C" void kernel_launch(void* const* d_in, const int* in_sizes, int n_in, void* d_out, int out_size, void* d_ws, size_t ws_size, hipStream_t stream) {
    static int grid = 0;
    if (grid == 0) {
        if (n_in != 16 || out_size != (int)O_END || ws_size < WS_NEED) { fprintf(stderr, "kernel_launch: unexpected shapes (n_in %d, out %d, ws %zu)\n", n_in, out_size, ws_size); grid = -1; return; }
        int dev = 0, cus = 0, per_cu = 0;
        if (hipGetDevice(&dev) != hipSuccess || hipDeviceGetAttribute(&cus, hipDeviceAttributeMultiprocessorCount, dev) != hipSuccess) { grid = -1; return; }
        if (hipFuncSetAttribute((const void*)hymba_fwd, hipFuncAttributeMaxDynamicSharedMemorySize, LDS_BYTES) != hipSuccess) { fprintf(stderr, "kernel_launch: hipFuncSetAttribute failed\n"); grid = -1; return; }
        if (hipOccupancyMaxActiveBlocksPerMultiprocessor(&per_cu, (const void*)hymba_fwd, 512, LDS_BYTES) != hipSuccess || per_cu < 1) { fprintf(stderr, "kernel_launch: occupancy query says %d\n", per_cu); }
        (void)hipGetLastError();
        grid = cus;
    }
    if (grid < 0) return;
    (void)in_sizes;
    hipMemsetAsync((char*)d_ws + WS_CTL, 0, CTL_ZERO_BYTES, stream);
    Args a{};
    for (int i = 0; i < 16; ++i) a.in[i] = (const float*)d_in[i];
    a.out = (float*)d_out; a.ws = (unsigned char*)d_ws;
    hipLaunchKernelGGL(hymba_fwd, dim3(grid), dim3(512), LDS_BYTES, stream, a);
}
```
